# Optimizing an MI355X kernel written in HIP

```python
import math
import jax, jax.numpy as jnp
from jax import lax
import numpy as np

D_MODEL = 1024
BATCH = 4
SEQ = 4096
DEPTH = 1

A_HEADS = 8
A_V_DIM = 64
A_WIDTH = A_HEADS * A_V_DIM
QK_NOPE_DIM = 64
QK_ROPE_DIM = 32
QK_DIM = QK_NOPE_DIM + QK_ROPE_DIM
Q_LORA_RANK = 256
KV_LORA_RANK = 128
ROPE_THETA = 10000.0
Q_BLOCK = 128
B_HEADS = 8
B_HEAD_DIM = 64
B_WIDTH = B_HEADS * B_HEAD_DIM
CHUNK = 128
D_MIX = A_WIDTH + B_WIDTH

IN_SPLITS = (Q_LORA_RANK, KV_LORA_RANK, QK_ROPE_DIM, A_WIDTH, B_WIDTH, B_WIDTH, B_WIDTH)
D_IN = Q_LORA_RANK + KV_LORA_RANK + QK_ROPE_DIM + A_WIDTH + 3 * B_WIDTH
EPS = 1e-6

kernel_name = "hybrid_mla_gmlp_parallel_groups"


def rms_norm(x, g):
    xf = x.astype(jnp.float32)
    y = xf * lax.rsqrt(jnp.mean(xf * xf, axis=-1, keepdims=True) + EPS)
    return (y * g.astype(jnp.float32)).astype(x.dtype)


def rope_cos_sin(positions):
    inv_freq = 1.0 / (ROPE_THETA ** (jnp.arange(0, QK_ROPE_DIM, 2, dtype=jnp.float32) / QK_ROPE_DIM))
    ang = positions.astype(jnp.float32)[..., None] * inv_freq
    return jnp.cos(ang)[:, :, None, :], jnp.sin(ang)[:, :, None, :]


def apply_rope(t, cos, sin):
    tf = t.astype(jnp.float32)
    t1, t2 = jnp.split(tf, 2, axis=-1)
    out = jnp.concatenate([t1 * cos - t2 * sin, t2 * cos + t1 * sin], axis=-1)
    return out.astype(t.dtype)


def split_cols(t, sizes):
    offs = np.cumsum(sizes)[:-1].tolist()
    return jnp.split(t, offs, axis=-1)


def setup_inputs(seed: int = 0) -> dict:
    key = jax.random.key(seed)
    ks = jax.random.split(key, 18)
    f32 = jnp.float32
    x = jax.random.normal(ks[0], (BATCH, SEQ, D_MODEL), f32)
    offset = jax.random.randint(ks[1], (BATCH, 1), 0, 1024, dtype=jnp.int32)
    positions = (jnp.arange(SEQ, dtype=jnp.int32)[None, :] + offset).astype(jnp.int32)
    gain = lambda k, shape: 1.0 + 0.02 * jax.random.normal(k, shape, f32)
    return {
        "x": x,
        "positions": positions,
        "norm_in_g": gain(ks[2], (D_MODEL,)),
        "w_in": jax.random.normal(ks[3], (D_MODEL, D_IN), f32) * D_MODEL ** -0.5,
        "q_lora_g": gain(ks[4], (Q_LORA_RANK,)),
        "w_uq": jax.random.normal(ks[5], (Q_LORA_RANK, A_HEADS * QK_DIM), f32) * Q_LORA_RANK ** -0.5,
        "kv_lora_g": gain(ks[6], (KV_LORA_RANK,)),
        "w_ukv": jax.random.normal(ks[7], (KV_LORA_RANK, A_HEADS * (QK_NOPE_DIM + A_V_DIM)), f32) * KV_LORA_RANK ** -0.5,
        "q_head_g": gain(ks[8], (QK_DIM,)),
        "k_head_g": gain(ks[9], (QK_DIM,)),
        "v_gate_g": gain(ks[10], (B_HEADS, B_HEAD_DIM)),
        "w_s": jax.random.normal(ks[11], (B_HEADS, CHUNK, CHUNK), f32) * CHUNK ** -0.5,
        "b_s": 0.02 * jax.random.normal(ks[12], (B_HEADS, CHUNK), f32),
        "out_a_g": gain(ks[13], (A_WIDTH,)),
        "out_b_g": gain(ks[14], (B_WIDTH,)),
        "w_out": jax.random.normal(ks[15], (D_MIX, D_MODEL), f32) * D_MIX ** -0.5,
    }


def mla_group(c_q, c_kv, k_rope, cos, sin, q_lora_g, w_uq, kv_lora_g, w_ukv, q_head_g, k_head_g):
    B, S, _ = c_q.shape
    q = (rms_norm(c_q, q_lora_g) @ w_uq).reshape(B, S, A_HEADS, QK_DIM)
    q_nope, q_pe = q[..., :QK_NOPE_DIM], q[..., QK_NOPE_DIM:]
    q = jnp.concatenate([q_nope, apply_rope(q_pe, cos, sin)], axis=-1)
    kv = (rms_norm(c_kv, kv_lora_g) @ w_ukv).reshape(B, S, A_HEADS, QK_NOPE_DIM + A_V_DIM)
    k_nope, v = kv[..., :QK_NOPE_DIM], kv[..., QK_NOPE_DIM:]
    k_pe = apply_rope(k_rope[:, :, None, :], cos, sin)
    k = jnp.concatenate([k_nope, jnp.broadcast_to(k_pe, (B, S, A_HEADS, QK_ROPE_DIM))], axis=-1)
    q = rms_norm(q, q_head_g)
    k = rms_norm(k, k_head_g)
    q = jnp.transpose(q, (0, 2, 1, 3))
    k = jnp.transpose(k, (0, 2, 1, 3))
    v = jnp.transpose(v, (0, 2, 1, 3))
    scale = 1.0 / math.sqrt(QK_DIM)
    n_blk = S // Q_BLOCK
    q_blocks = jnp.moveaxis(q.reshape(B, A_HEADS, n_blk, Q_BLOCK, QK_DIM), 2, 0)

    def attend(qb):
        s = jnp.einsum("bhqd,bhkd->bhqk", qb, k).astype(jnp.float32) * scale
        p = jax.nn.softmax(s, axis=-1).astype(v.dtype)
        return jnp.einsum("bhqk,bhkd->bhqd", p, v)

    o = lax.map(attend, q_blocks)
    o = jnp.transpose(o, (1, 0, 3, 2, 4)).reshape(B, S, A_WIDTH)
    return o


def gmlp_group(u, v, v_gate_g, w_s, b_s):
    B, S, _ = u.shape
    n_chunk = S // CHUNK
    u = jax.nn.gelu(u)
    v = rms_norm(jax.nn.gelu(v).reshape(B, S, B_HEADS, B_HEAD_DIM), v_gate_g)
    v = v.reshape(B, n_chunk, CHUNK, B_HEADS, B_HEAD_DIM)
    sv = jnp.einsum("hij,bcjhd->bcihd", w_s, v) + jnp.transpose(b_s)[None, None, :, :, None]
    out = u.reshape(B, n_chunk, CHUNK, B_HEADS, B_HEAD_DIM) * sv
    return out.reshape(B, S, B_WIDTH)


def reference(x, positions, norm_in_g, w_in, q_lora_g, w_uq, kv_lora_g, w_ukv, q_head_g, k_head_g,
              v_gate_g, w_s, b_s, out_a_g, out_b_g, w_out):
    cos, sin = rope_cos_sin(positions)
    for _ in range(DEPTH):
        h = rms_norm(x, norm_in_g)
        proj = h @ w_in
        c_q, c_kv, k_rope, z_a, u, v, z_b = split_cols(proj, IN_SPLITS)
        o_a = mla_group(c_q, c_kv, k_rope, cos, sin, q_lora_g, w_uq, kv_lora_g, w_ukv, q_head_g, k_head_g)
        o_b = gmlp_group(u, v, v_gate_g, w_s, b_s)
        o_a = rms_norm(o_a, out_a_g) * jax.nn.silu(z_a)
        o_b = rms_norm(o_b, out_b_g) * jax.nn.silu(z_b)
        x = x + jnp.concatenate([o_a, o_b], axis=-1) @ w_out
    return x
```

```cpp
#include <hip/hip_runtime.h>
#include <stdint.h>
#include <stdio.h>
#include <hip/hip_cooperative_groups.h>
namespace cg = cooperative_groups;

#define DI __device__ __forceinline__
#define LAS __attribute__((address_space(3)))
typedef unsigned short bf16_t;

constexpr int T = 16384, SEQ = 4096, NB = 4, DM = 1024, NH = 8, QK = 96, DV = 64;
constexpr int NP = 2048;
constexpr float EPS = 1e-6f;
constexpr float QSCALE = 0.10206207261596575f * 1.4426950408889634f;

constexpr size_t MiB = 1u << 20;
constexpr size_t WS_CTL = 0;
constexpr size_t WS_XB = 1 * MiB;
constexpr size_t WS_RSTDX = 33 * MiB;
constexpr size_t WS_COS = 34 * MiB;
constexpr size_t WS_SIN = 35 * MiB;
constexpr size_t WS_WINT = 36 * MiB;
constexpr size_t WS_WUQT = 41 * MiB;
constexpr size_t WS_WUKVT = 42 * MiB;
constexpr size_t WS_WOUTT = 43 * MiB;
constexpr size_t WS_WSB = 45 * MiB;
constexpr size_t WS_SSQA = 46 * MiB;
constexpr size_t WS_SSQB = 47 * MiB;
constexpr size_t WS_CQ = 48 * MiB;
constexpr size_t WS_CKV = 56 * MiB;
constexpr size_t WS_Z = 62 * MiB;
constexpr size_t WS_QIMG = 126 * MiB;
constexpr size_t WS_KIMG = 150 * MiB;
constexpr size_t WS_VIMG = 174 * MiB;
constexpr size_t WS_AMIX = 190 * MiB;
constexpr size_t WS_END = 222 * MiB;

DI float bf2f(bf16_t b) { return __uint_as_float(((unsigned)b) << 16); }
DI bf16_t f2bf(float f) { unsigned u = __float_as_uint(f); return (bf16_t)((u + 0x7fffu + ((u >> 16) & 1u)) >> 16); }
DI float gelu_tanh(float x) {
    const float y = x * (0.7978845608028654f + 0.035677408136300125f * x * x);
    return x * __builtin_amdgcn_rcpf(1.f + __builtin_amdgcn_exp2f(-2.885390081777927f * y));
}
DI float silu(float x) { return x * __builtin_amdgcn_rcpf(1.f + __builtin_amdgcn_exp2f(-1.4426950408889634f * x)); }
DI float rsqrt_fast(float x) { return __builtin_amdgcn_rsqf(x); }

DI size_t cq_idx(int t, int k) { return ((((size_t)(t >> 5) * 32 + (k >> 3)) * 32 + (t & 31)) << 3) + (k & 7); }
DI size_t ckv_idx(int t, int k) { return ((((size_t)(t >> 5) * 20 + (k >> 3)) * 32 + (t & 31)) << 3) + (k & 7); }
DI size_t qimg_idx(int bh, int s, int d) {
    const int qb = s >> 5, r = s & 31, kk = d >> 4, e = d & 15, h = (e >> 2) & 1, j = 4 * (e >> 3) + (e & 3);
    return (((((size_t)bh * 128 + qb) * 6 + kk) * 64 + (h * 32 + r)) << 3) + j;
}
DI size_t kimg_idx(int bh, int s, int d) {
    const int tile = s >> 6, c = (s >> 5) & 1, r = s & 31, kk = d >> 4, e = d & 15, h = (e >> 2) & 1, j = 4 * (e >> 3) + (e & 3);
    return ((((((size_t)bh * 64 + tile) * 6 + kk) * 2 + c) * 64 + (h * 32 + r)) << 3) + j;
}
DI size_t vimg_idx(int bh, int s, int d) {
    const int tile = s >> 6, kin = s & 63, c = kin >> 5, s2 = (kin >> 4) & 1, e = kin & 15, h = (e >> 2) & 1, j = 4 * (e >> 3) + (e & 3), dt = d >> 5, r = d & 31;
    return (((((((size_t)bh * 64 + tile) * 2 + c) * 2 + s2) * 2 + dt) * 64 + (h * 32 + r)) << 3) + j;
}

struct Ptrs {
    const float *x; const int* pos; const float *g_in, *w_in, *g_ql, *w_uq, *g_kvl, *w_ukv, *g_qh, *g_kh, *g_vg, *w_s, *b_s, *g_oa, *g_ob, *w_out;
    float* out; unsigned char* ws;
};

typedef float f32x4_t __attribute__((ext_vector_type(4)));
DI void p1_fused_q_a(const f32x4_t (&acc)[2][2][4][2], int pm, int wr, int wc, int fr, int fq, LAS unsigned char* lds, const Ptrs* pp);
DI void p1_fused_kv_a(const f32x4_t (&acc)[2][2][4][2], int pm, int wr, int wc, int fr, int fq, LAS unsigned char* lds, const Ptrs* pp);
DI void p1_fused_q_b(int pm, LAS unsigned char* lds, const Ptrs* pp, int wid, int lane);
DI void p1_fused_kv_b(int pm, LAS unsigned char* lds, const Ptrs* pp, int wid, int lane);
namespace pg8 {
#define PG8_LAS __attribute__((address_space(3)))
typedef short bf16x8 __attribute__((ext_vector_type(8)));
typedef float f32x4 __attribute__((ext_vector_type(4)));
typedef unsigned u32x4 __attribute__((ext_vector_type(4)));
constexpr int BM = 256, BK = 64, HALF = 128, HTB = HALF * BK * 2  , STAGE_BYTES = 8 * HTB, NXCD = 8, WGM = 8;

__host__ __device__ __forceinline__ int lds_byte(int r, int c) { const int st = (r >> 4) * 2 + (c >> 5), rr = r & 15, cc = c & 31, ob = rr * 64 + cc * 2; return st * 1024 + (ob ^ (((ob >> 9) & 1) << 5)); }
__host__ __device__ __forceinline__ void stage_rc(int b, int& R, int& C) { const int st = b / 1024, sb = b % 1024, swz = sb ^ (((sb >> 9) & 1) << 5); R = (st >> 1) * 16 + swz / 64; C = (st & 1) * 32 + (swz % 64) / 2; }
__host__ __device__ __forceinline__ int perm32(int rho) { const int n = rho >> 4, i = rho & 15; return 8 * (i >> 2) + 4 * n + (i & 3); }

struct Unit { int pm, pn; };
struct Gemm { const bf16_t* A; const bf16_t* Bt; int M, N, K; };

struct StaticOrder {
    int nM, nN, nwg, G, c;
    __host__ __device__ void init(int M, int N, int G_, int c_) { nM = M / BM; nN = N / BM; nwg = nM * nN; G = G_; c = c_; }
    __host__ __device__ bool next(int i, Unit& u) const {
        const long L = (long)i * G + c; if (L >= nwg) return false;
        int wgid = (int)L; { const int q = nwg / NXCD, r = nwg % NXCD, xcd = wgid % NXCD, off = wgid / NXCD; wgid = (xcd < r ? xcd * (q + 1) : r * (q + 1) + (xcd - r) * q) + off; }
        const int nig = WGM * nN, gid = wgid / nig, fm = gid * WGM, gsz = (nM - fm) < WGM ? (nM - fm) : WGM;
        u.pm = fm + ((wgid % nig) % gsz); u.pn = (wgid % nig) / gsz; return true;
    }
    __device__ __forceinline__ void a_ready(const Unit&) const {}
    __device__ __forceinline__ void done(const Unit&) const {}
};
__device__ __forceinline__ unsigned cvt_pk_bf16(float lo, float hi) { unsigned r; asm volatile("v_cvt_pk_bf16_f32 %0, %1, %2" : "=v"(r) : "v"(lo), "v"(hi)); return r; }

struct OneUnit { int pm, pn;
    __device__ __forceinline__ bool next(int i, Unit& u) const { if (i) return false; u.pm = pm; u.pn = pn; return true; }
    __device__ __forceinline__ void a_ready(const Unit&) const {}
    __device__ __forceinline__ void done(const Unit&) const {}
};
struct P1Order { StaticOrder S;
    __host__ __device__ void init(int M, int N, int G_, int c_) { S.init(M, N, G_, c_); }
    __host__ __device__ bool next(int i, Unit& u) const {
        if (i < 2) return S.next(i, u);
        if (i == 2 && S.c >= 128) { S.next(1, u); u.pn += 2; return true; }
        return false; }
    __device__ __forceinline__ void a_ready(const Unit&) const {}
    __device__ __forceinline__ void done(const Unit&) const {}
};
struct EpiProj {
    static constexpr bool PERM = true, AFTER_DRAIN = false, HAS_MID = false, FUSE_LAST = true; static constexpr int MID_T = -1, NSTORE = 16;
    bf16_t *Z; const PG8_LAS float* rtab; const Ptrs* pp;
    __device__ __forceinline__ bool fused_unit(const Unit& u) const { return u.pn == 4 || u.pn == 5; }
    __device__ __forceinline__ void fused(const f32x4 (&acc)[2][2][4][2], const Unit& u, int wr, int wc, int fr, int fq, PG8_LAS unsigned char* lds, int wid, int lane) const {
        if (u.pn == 4) p1_fused_q_a(acc, u.pm, wr, wc, fr, fq, lds, pp); else p1_fused_kv_a(acc, u.pm, wr, wc, fr, fq, lds, pp);
        asm volatile("s_waitcnt lgkmcnt(0)\n\ts_barrier" ::: "memory");
        if (u.pn == 4) p1_fused_q_b(u.pm, lds, pp, wid, lane); else p1_fused_kv_b(u.pm, lds, pp, wid, lane); }
    __device__ __forceinline__ void mid(f32x4 (&)[2][2][4][2], int, int, PG8_LAS unsigned char*) const {}
    __device__ __forceinline__ void operator()(const f32x4 (&acc)[2][2][4][2], const Unit& u, int wr, int wc, int fr, int fq) const {
        const int row0 = u.pm * BM + wr * 64 + fr;
        const int zc = (u.pn < 4 ? 512 + u.pn * BM : u.pn < 8 ? u.pn * BM : (u.pn - 8) * BM);
        float rsv[2][4];
#pragma unroll
        for (int ai = 0; ai < 2; ++ai)
#pragma unroll
            for (int m = 0; m < 4; ++m) rsv[ai][m] = rtab[wr * 64 + fr + ai * HALF + m * 16];
#pragma unroll
        for (int ai = 0; ai < 2; ++ai)
#pragma unroll
            for (int m = 0; m < 4; ++m) { const int row = row0 + ai * HALF + m * 16; const float rs = rsv[ai][m];
#pragma unroll
                for (int bj = 0; bj < 2; ++bj) { const int lc = bj * HALF + wc * 32 + 8 * fq;
                    const f32x4 v0 = acc[ai][bj][m][0] * rs, v1 = acc[ai][bj][m][1] * rs;
                    u32x4 w; w.x = cvt_pk_bf16(v0[0], v0[1]); w.y = cvt_pk_bf16(v0[2], v0[3]); w.z = cvt_pk_bf16(v1[0], v1[1]); w.w = cvt_pk_bf16(v1[2], v1[3]);
                    *(u32x4*)(Z + (size_t)row * 2048 + zc + lc) = w; } }

    }
};
struct EpiOut {
    static constexpr bool PERM = false, AFTER_DRAIN = true, HAS_MID = true, FUSE_LAST = false; static constexpr int MID_T = 8, NSTORE = 0;
    __device__ __forceinline__ bool fused_unit(const Unit&) const { return false; }
    __device__ __forceinline__ void fused(const f32x4 (&acc)[2][2][4][2], const Unit& u, int wr, int wc, int fr, int fq, PG8_LAS unsigned char* lds, int wid, int lane) const {
        typedef float nt4 __attribute__((ext_vector_type(4)));
        const PG8_LAS float* rstdb = (const PG8_LAS float*)(lds + STAGE_BYTES + 1024);
#pragma unroll
        for (int ai = 0; ai < 2; ++ai) {
            const size_t g0 = (size_t)(u.pm * BM + ai * HALF + wid * 16) * 1024 + u.pn * BM + 4 * lane;
            typedef unsigned nt2 __attribute__((ext_vector_type(2)));
            nt2 xv[16];
#pragma unroll
            for (int i = 0; i < 16; ++i) xv[i] = __builtin_nontemporal_load((const nt2*)(xb + g0 + (size_t)i * 1024));
#pragma unroll
            for (int m = 0; m < 4; ++m) { const int r = wr * 64 + m * 16 + fr; const float rb = rstdb[ai * HALF + r];
#pragma unroll
                for (int bj = 0; bj < 2; ++bj)
#pragma unroll
                    for (int n = 0; n < 2; ++n) { const int c = bj * 32 + wc * 8 + n * 4 + fq;
                        *(PG8_LAS f32x4*)(lds + r * 1024 + ((c ^ (r & 15)) << 4)) = acc[ai][bj][m][n] * rb; } }
            asm volatile("s_waitcnt lgkmcnt(0)\n\ts_barrier" ::: "memory");
#pragma unroll
            for (int i = 0; i < 16; ++i) { const f32x4 v = *(const PG8_LAS f32x4*)(lds + (wid * 16 + i) * 1024 + ((lane ^ i) << 4));
                const f32x4 xr = {__builtin_bit_cast(float, xv[i].x << 16), __builtin_bit_cast(float, xv[i].x & 0xffff0000u), __builtin_bit_cast(float, xv[i].y << 16), __builtin_bit_cast(float, xv[i].y & 0xffff0000u)};
                __builtin_nontemporal_store(xr + v, (nt4*)(out + g0 + (size_t)i * 1024)); }
            if (ai == 0) asm volatile("s_waitcnt lgkmcnt(0)\n\ts_barrier" ::: "memory");
        }
    }
    const float* x; float* out; PG8_LAS unsigned char* ldsb; const bf16_t* xb;
    __device__ __forceinline__ void mid(f32x4 (&acc)[2][2][4][2], int wr, int fr, PG8_LAS unsigned char* lds) const {
        const PG8_LAS float* ratio = (const PG8_LAS float*)(lds + STAGE_BYTES);
#pragma unroll
        for (int ai = 0; ai < 2; ++ai)
#pragma unroll
            for (int m = 0; m < 4; ++m) { const float r = ratio[ai * HALF + wr * 64 + m * 16 + fr];
#pragma unroll
                for (int bj = 0; bj < 2; ++bj)
#pragma unroll
                    for (int n = 0; n < 2; ++n) acc[ai][bj][m][n] = acc[ai][bj][m][n] * r; }
    }
    __device__ __forceinline__ void operator()(const f32x4 (&acc)[2][2][4][2], const Unit& u, int wr, int wc, int fr, int fq) const {
        const PG8_LAS float* rstdb = (const PG8_LAS float*)(ldsb + STAGE_BYTES + 1024);
        const int row0 = u.pm * BM + wr * 64 + fr, col0 = u.pn * BM + wc * 32 + 4 * fq;
#pragma unroll
        for (int ai = 0; ai < 2; ++ai) {
            f32x4 xv[4][2][2]; float rb[4];
#pragma unroll
            for (int m = 0; m < 4; ++m) { rb[m] = rstdb[ai * HALF + wr * 64 + m * 16 + fr]; const size_t off = (size_t)(row0 + ai * HALF + m * 16) * 1024 + col0;
#pragma unroll
                for (int bj = 0; bj < 2; ++bj)
#pragma unroll
                    for (int n = 0; n < 2; ++n) xv[m][bj][n] = __builtin_nontemporal_load((const f32x4*)(x + off + bj * HALF + n * 16)); }
#pragma unroll
            for (int m = 0; m < 4; ++m) { const size_t off = (size_t)(row0 + ai * HALF + m * 16) * 1024 + col0;
#pragma unroll
                for (int bj = 0; bj < 2; ++bj)
#pragma unroll
                    for (int n = 0; n < 2; ++n) __builtin_nontemporal_store(xv[m][bj][n] + acc[ai][bj][m][n] * rb[m], (f32x4*)(out + off + bj * HALF + n * 16)); }
        }
    }
};
template <class Epi, class Sched, bool ALIGN_EPI = false, bool SP2 = false>
__device__ __forceinline__ void gemm_phase(PG8_LAS unsigned char* lds, const Gemm g, const Sched& S, const Epi& E) {
    const int tid = threadIdx.x, wid = __builtin_amdgcn_readfirstlane(tid >> 6), lane = tid & 63, wr = wid >> 2, wc = wid & 3, fr = lane & 15, fq = lane >> 4;
    const int K = g.K, nt = K / BK;
    unsigned voffA[2], voffB[2];
#pragma unroll
    for (int i = 0; i < 2; ++i) { int R, C; stage_rc(tid * 16 + i * 8192, R, C); const int Rb = Epi::PERM ? ((R & ~31) + perm32(R & 31)) : R;
        voffA[i] = (unsigned)(R * K + C) * 2u; voffB[i] = (unsigned)(Rb * K + C) * 2u; }
    const size_t kstep = (size_t)(BK * 2);
    const size_t hstep = (size_t)HALF * K * 2;
    const size_t tstep = 2 * hstep;
    const unsigned ldsw = (unsigned)wid * 1024u;
    const int aoff = lds_byte(wr * 64 + fr, fq * 8), boff = lds_byte(wc * 32 + fr, fq * 8);
#define PG8_SA(b, h) (((b) * 2 + (h)) * HTB)
#define PG8_SB(b, h) ((4 + (b) * 2 + (h)) * HTB)
#define PG8_STAGE(bufoff, gbase, voff) do { _Pragma("unroll") for (int _i = 0; _i < 2; ++_i) \
        __builtin_amdgcn_global_load_lds((const unsigned*)((const char*)(gbase) + (voff)[_i]), (PG8_LAS unsigned*)(lds + (bufoff) + ldsw + _i * 8192), 16, 0, 0); } while (0)
#define PG8_LDA(dst, b, h) do { _Pragma("unroll") for (int m = 0; m < 4; ++m) _Pragma("unroll") for (int k = 0; k < 2; ++k) dst[m][k] = *(const PG8_LAS bf16x8*)(lds + PG8_SA(b, h) + aoff + m * 2048 + k * 1024); } while (0)
#define PG8_LDB(dst, b, h) do { _Pragma("unroll") for (int n = 0; n < 2; ++n) _Pragma("unroll") for (int k = 0; k < 2; ++k) dst[n][k] = *(const PG8_LAS bf16x8*)(lds + PG8_SB(b, h) + boff + n * 2048 + k * 1024); } while (0)
#define PG8_MMA(ai, bj, At, Bt) do { __builtin_amdgcn_s_setprio(1); _Pragma("unroll") for (int m = 0; m < 4; ++m) _Pragma("unroll") for (int n = 0; n < 2; ++n) _Pragma("unroll") for (int k = 0; k < 2; ++k) \
        acc[ai][bj][m][n] = __builtin_amdgcn_mfma_f32_16x16x32_bf16(Bt[n][k], At[m][k], acc[ai][bj][m][n], 0, 0, 0); __builtin_amdgcn_s_setprio(0); } while (0)
#define PG8_WAIT_V(n) asm volatile("s_waitcnt vmcnt(" #n ")" ::: "memory")
#define PG8_WAIT_L(n) asm volatile("s_waitcnt lgkmcnt(" #n ")" ::: "memory")
#define PG8_BAR __builtin_amdgcn_s_barrier()
#define PG8_SCHED __builtin_amdgcn_sched_barrier(0)
    Unit cur, nxt; int ui = 0;
    if (!S.next(0, cur)) return;
    f32x4 acc[2][2][4][2];
#pragma unroll
    for (int a = 0; a < 2; ++a)
#pragma unroll
        for (int b = 0; b < 2; ++b)
#pragma unroll
            for (int m = 0; m < 4; ++m)
#pragma unroll
                for (int n = 0; n < 2; ++n) acc[a][b][m][n] = (f32x4){0.f, 0.f, 0.f, 0.f};
    bf16x8 At[4][2], B0[2][2], B1[2][2];
    const char* cA = (const char*)g.A + (size_t)cur.pm * tstep; const char* cB = (const char*)g.Bt + (size_t)cur.pn * tstep;
    S.a_ready(cur);
    if constexpr (SP2) {
        PG8_STAGE(PG8_SB(0, 0), cB, voffB); PG8_STAGE(PG8_SB(0, 1), cB + hstep, voffB); PG8_STAGE(PG8_SA(0, 0), cA, voffA); PG8_STAGE(PG8_SA(0, 1), cA + hstep, voffA);
        if (wr == 1) PG8_BAR;
        PG8_WAIT_V(2); PG8_BAR;
        PG8_STAGE(PG8_SB(1, 0), cB + kstep, voffB); PG8_STAGE(PG8_SA(1, 0), cA + kstep, voffA); PG8_STAGE(PG8_SB(1, 1), cB + hstep + kstep, voffB);
        PG8_WAIT_V(6); PG8_BAR;
    } else {
        PG8_STAGE(PG8_SB(0, 0), cB, voffB); PG8_STAGE(PG8_SA(0, 0), cA, voffA); PG8_STAGE(PG8_SB(0, 1), cB + hstep, voffB); PG8_STAGE(PG8_SA(0, 1), cA + hstep, voffA);
        if (wr == 1) PG8_BAR;
        PG8_WAIT_V(4); PG8_BAR;
        PG8_STAGE(PG8_SB(1, 0), cB + kstep, voffB); PG8_STAGE(PG8_SA(1, 0), cA + kstep, voffA); PG8_STAGE(PG8_SB(1, 1), cB + hstep + kstep, voffB);
        PG8_WAIT_V(6); PG8_BAR;
    }
    for (;;) {
        const bool has_next = S.next(ui + 1, nxt);
        const char* nA = has_next ? (const char*)g.A + (size_t)nxt.pm * tstep : cA; const char* nB = has_next ? (const char*)g.Bt + (size_t)nxt.pn * tstep : cB;
        for (int t = 0; t < nt; t += 2) {
            const bool last = (t == nt - 2);
            const char* a1 = cA + (size_t)(t + 1) * kstep;
            const char* a2 = last ? nA : cA + (size_t)(t + 2) * kstep; const char* b2 = last ? nB : cB + (size_t)(t + 2) * kstep;
            const char* a3 = a2 + kstep; const char* b3 = b2 + kstep;
            if (last && has_next) S.a_ready(nxt);
            if constexpr (Epi::HAS_MID) { if (t == Epi::MID_T) { PG8_SCHED; E.mid(acc, wr, fr, lds); PG8_SCHED; } }
            if constexpr (SP2) {
            const bool fresh = Epi::NSTORE > 0 && ui > 0 && t == 0;
#define PG8_WAIT_VF() do { if (fresh) asm volatile("s_waitcnt vmcnt(%0)" :: "n"(8 + Epi::NSTORE) : "memory"); else PG8_WAIT_V(8); } while (0)
            PG8_LDB(B0, 0, 0); PG8_LDB(B1, 0, 1); PG8_SCHED; PG8_LDA(At, 0, 0); if (!fresh) PG8_STAGE(PG8_SA(1, 1), a1 + hstep, voffA);
            PG8_WAIT_VF(); PG8_WAIT_L(0); PG8_BAR; PG8_MMA(0, 0, At, B0); PG8_MMA(0, 1, At, B1); PG8_BAR; PG8_SCHED;
            PG8_LDA(At, 0, 1); PG8_STAGE(PG8_SB(0, 0), b2, voffB); PG8_STAGE(PG8_SB(0, 1), b2 + hstep, voffB); PG8_STAGE(PG8_SA(0, 0), a2, voffA);
            PG8_WAIT_VF(); PG8_WAIT_L(0); PG8_BAR; PG8_MMA(1, 0, At, B0); PG8_MMA(1, 1, At, B1); PG8_BAR; PG8_SCHED;
            PG8_LDB(B0, 1, 0); PG8_LDB(B1, 1, 1); PG8_SCHED; PG8_LDA(At, 1, 0); PG8_STAGE(PG8_SA(0, 1), a2 + hstep, voffA);
            PG8_WAIT_VF(); PG8_WAIT_L(0); PG8_BAR; PG8_MMA(0, 0, At, B0); PG8_MMA(0, 1, At, B1); PG8_BAR; PG8_SCHED;
#undef PG8_WAIT_VF
            PG8_LDA(At, 1, 1); PG8_STAGE(PG8_SB(1, 0), b3, voffB); PG8_STAGE(PG8_SB(1, 1), b3 + hstep, voffB); PG8_STAGE(PG8_SA(1, 0), a3, voffA);
            PG8_WAIT_V(8); PG8_WAIT_L(0); PG8_BAR; PG8_MMA(1, 0, At, B0); PG8_MMA(1, 1, At, B1); PG8_BAR; PG8_SCHED;
            } else {
            PG8_LDB(B0, 0, 0); PG8_SCHED; PG8_LDA(At, 0, 0); PG8_STAGE(PG8_SA(1, 1), a1 + hstep, voffA);
            PG8_WAIT_L(8); PG8_BAR; PG8_WAIT_L(0); PG8_MMA(0, 0, At, B0); PG8_BAR; PG8_SCHED;
            PG8_LDB(B1, 0, 1); PG8_STAGE(PG8_SB(0, 0), b2, voffB);
            PG8_BAR; PG8_WAIT_L(0); PG8_MMA(0, 1, At, B1); PG8_BAR;
            PG8_LDA(At, 0, 1); PG8_STAGE(PG8_SA(0, 0), a2, voffA);
            PG8_BAR; PG8_WAIT_L(0); PG8_MMA(1, 0, At, B0); PG8_BAR; PG8_SCHED;
            PG8_STAGE(PG8_SB(0, 1), b2 + hstep, voffB);
            PG8_WAIT_V(6); PG8_BAR; PG8_MMA(1, 1, At, B1); PG8_BAR;
            PG8_LDB(B0, 1, 0); PG8_SCHED; PG8_LDA(At, 1, 0); PG8_STAGE(PG8_SA(0, 1), a2 + hstep, voffA);
            PG8_WAIT_L(8); PG8_BAR; PG8_WAIT_L(0); PG8_MMA(0, 0, At, B0); PG8_BAR; PG8_SCHED;
            PG8_LDB(B1, 1, 1); PG8_STAGE(PG8_SB(1, 0), b3, voffB);
            PG8_BAR; PG8_WAIT_L(0); PG8_MMA(0, 1, At, B1); PG8_BAR;
            PG8_LDA(At, 1, 1); PG8_STAGE(PG8_SA(1, 0), a3, voffA);
            PG8_BAR; PG8_WAIT_L(0); PG8_MMA(1, 0, At, B0); PG8_BAR; PG8_SCHED;
            PG8_STAGE(PG8_SB(1, 1), b3 + hstep, voffB);
            PG8_WAIT_V(6); PG8_BAR; PG8_MMA(1, 1, At, B1); PG8_BAR;
            }
        }
        if constexpr (SP2 && Epi::NSTORE > 0) { if (has_next) PG8_STAGE(PG8_SA(1, 1), nA + kstep + hstep, voffA); }
        if constexpr (ALIGN_EPI) { if (wr == 0) PG8_BAR; }
        if constexpr (Epi::FUSE_LAST) { if (has_next || !E.fused_unit(cur)) E(acc, cur, wr, wc, fr, fq); S.done(cur); }
        else if constexpr (!Epi::AFTER_DRAIN) { E(acc, cur, wr, wc, fr, fq); S.done(cur); }
        if (!has_next) break;
#pragma unroll
        for (int a = 0; a < 2; ++a)
#pragma unroll
            for (int b = 0; b < 2; ++b)
#pragma unroll
                for (int m = 0; m < 4; ++m)
#pragma unroll
                    for (int n = 0; n < 2; ++n) acc[a][b][m][n] = (f32x4){0.f, 0.f, 0.f, 0.f};
        cur = nxt; cA = nA; cB = nB; ++ui;
        if constexpr (ALIGN_EPI) { if (wr == 1) PG8_BAR; }
    }
    PG8_WAIT_V(0);
    if constexpr (!ALIGN_EPI) { if (wr == 0) PG8_BAR; }
    PG8_BAR;
    if constexpr (Epi::FUSE_LAST) { if (E.fused_unit(cur)) E.fused(acc, cur, wr, wc, fr, fq, lds, wid, lane); }
    else if constexpr (Epi::AFTER_DRAIN) { E.fused(acc, cur, wr, wc, fr, fq, lds, wid, lane); S.done(cur); }
#undef PG8_SA
#undef PG8_SB
#undef PG8_STAGE
#undef PG8_LDA
#undef PG8_LDB
#undef PG8_MMA
#undef PG8_WAIT_V
#undef PG8_WAIT_L
#undef PG8_BAR
#undef PG8_SCHED
}
}


namespace att {
typedef short bf16x8 __attribute__((ext_vector_type(8)));
typedef float f32x16 __attribute__((ext_vector_type(16)));
typedef float f32x2_t __attribute__((ext_vector_type(2))); typedef __bf16 bf16x2_t __attribute__((ext_vector_type(2)));
DI unsigned cvtpk(float lo, float hi) { f32x2_t v = {lo, hi}; bf16x2_t b = __builtin_convertvector(v, bf16x2_t); return __builtin_bit_cast(unsigned, b); }
DI void glds16(const void* gsrc, unsigned lds_dst) { unsigned keep;
    asm volatile("s_mov_b32 %0, m0\n\ts_mov_b32 m0, %2\n\ts_nop 0\n\tglobal_load_lds_dwordx4 %1, off\n\ts_mov_b32 m0, %0" : "=&s"(keep) : "v"(gsrc), "s"(lds_dst) : "memory"); }
constexpr int SLOTB = 20480, KBYTES = 12288, VBYTES = 8192;
#define MFMA32(a, b, c) __builtin_amdgcn_mfma_f32_32x32x16_bf16((a), (b), (c), 0, 0, 0)
DI void attn_epi64(const Ptrs& p, const f32x16& o0, const f32x16& o1, float lsum, int bh, int q0, int lane) {
    const int r = lane & 31, h = lane >> 5;
    lsum += __shfl_xor(lsum, 32);
    const float rl = __builtin_amdgcn_rcpf(lsum);
    const int b = bh >> 3, hd = bh & 7, t = b * SEQ + q0 + r;
    const bf16_t* Z = (const bf16_t*)(p.ws + WS_Z) + (size_t)t * 2048 + hd * 64 + 4 * h;
    bf16_t* A = (bf16_t*)(p.ws + WS_AMIX) + (size_t)t * 1024 + hd * 64 + 4 * h;
    float sq = 0.f;
    uint2 zld[2][4];
#pragma unroll
    for (int dt = 0; dt < 2; ++dt)
#pragma unroll
        for (int g = 0; g < 4; ++g) zld[dt][g] = *(const uint2*)(Z + 32 * dt + 8 * g);
#pragma unroll
    for (int dt = 0; dt < 2; ++dt)
#pragma unroll
        for (int g = 0; g < 4; ++g) {
            const uint2 zz2 = zld[dt][g];
            float ov[4];
#pragma unroll
            for (int e = 0; e < 4; ++e) { ov[e] = (dt ? o1[4 * g + e] : o0[4 * g + e]) * rl; sq += ov[e] * ov[e]; }
            const float z0 = __uint_as_float(zz2.x << 16), z1 = __uint_as_float(zz2.x & 0xffff0000u), z2 = __uint_as_float(zz2.y << 16), z3 = __uint_as_float(zz2.y & 0xffff0000u);
            uint2 w; w.x = cvtpk(ov[0] * silu(z0), ov[1] * silu(z1)); w.y = cvtpk(ov[2] * silu(z2), ov[3] * silu(z3));
            *(uint2*)(A + 32 * dt + 8 * g) = w;
        }
    sq += __shfl_xor(sq, 32);
    if (h == 0) ((float*)(p.ws + WS_SSQA))[(size_t)hd * T + t] = sq;
}
DI void attn_unit64(LAS unsigned char* lds, const Ptrs& p, int bh, int qb512, int wid, int lane) {
    const unsigned lds0 = (unsigned)(uintptr_t)lds;
    const unsigned char* Kg = p.ws + WS_KIMG + (size_t)bh * 64 * KBYTES + lane * 16;
    const unsigned char* Vg = p.ws + WS_VIMG + (size_t)bh * 64 * VBYTES + lane * 16;
    const bf16x8* Qg = (const bf16x8*)(p.ws + WS_QIMG + ((size_t)(bh * 128 + qb512 * 16 + 2 * wid) * 6 * 64 + lane) * 16);
    bf16x8 qa[6], qb[6];
#pragma unroll
    for (int kk = 0; kk < 6; ++kk) { qa[kk] = Qg[kk * 64]; qb[kk] = Qg[(6 + kk) * 64]; }
#define ATT_DMA(t, slotoff) do { const unsigned char* kt_ = Kg + (size_t)(t) * KBYTES; const unsigned char* vt_ = Vg + (size_t)(t) * VBYTES; \
        glds16(kt_ + wid * 1024, (unsigned)__builtin_amdgcn_readfirstlane(lds0 + (slotoff) + wid * 1024)); \
        if (wid < 4) { glds16(kt_ + (wid + 8) * 1024, (unsigned)__builtin_amdgcn_readfirstlane(lds0 + (slotoff) + (wid + 8) * 1024)); \
                       glds16(vt_ + (wid + 4) * 1024, (unsigned)__builtin_amdgcn_readfirstlane(lds0 + (slotoff) + KBYTES + (wid + 4) * 1024)); } \
        else glds16(vt_ + (wid - 4) * 1024, (unsigned)__builtin_amdgcn_readfirstlane(lds0 + (slotoff) + KBYTES + (wid - 4) * 1024)); } while (0)
#define ATT_WAIT_MINE() do { if (wid < 4) asm volatile("s_waitcnt vmcnt(3) lgkmcnt(0)\n\ts_barrier" ::: "memory"); else asm volatile("s_waitcnt vmcnt(2) lgkmcnt(0)\n\ts_barrier" ::: "memory"); } while (0)
#define ATT_WAIT_ALL() asm volatile("s_waitcnt vmcnt(0) lgkmcnt(0)\n\ts_barrier" ::: "memory")
#define SBAR() __builtin_amdgcn_sched_barrier(0)
#define EX(v) __builtin_amdgcn_exp2f(v)
#define LD(ptr) (*(const LAS bf16x8*)(ptr))
#define MF(a, b, c) MFMA32((a), (b), (c))
    ATT_DMA(0, 0); ATT_DMA(1, SLOTB); ATT_DMA(2, 2 * SLOTB); ATT_DMA(3, 3 * SLOTB);
    ATT_WAIT_ALL();
    f32x16 OA0, OA1, OB0, OB1, SA0, SA1, SB0, SB1, zz;
#pragma unroll
    for (int i = 0; i < 16; ++i) { OA0[i] = 0.f; OA1[i] = 0.f; OB0[i] = 0.f; OB1[i] = 0.f; zz[i] = 0.f; }
    float lsA = 0.f, lsB = 0.f;
    uint4 pA0_0, pA0_1, pA1_0, pA1_1, pB0_0, pB0_1, pB1_0, pB1_1;
    bf16x8 fr0, fr1, fr2, fr3;
    {
        const LAS unsigned char* kp0 = lds + lane * 16;
        SA0 = zz; SA1 = zz; SB0 = zz; SB1 = zz;
#pragma unroll
        for (int kk = 0; kk < 6; ++kk) { const bf16x8 k0 = LD(kp0 + (2 * kk) * 1024), k1 = LD(kp0 + (2 * kk + 1) * 1024);
            SA0 = MFMA32(k0, qa[kk], SA0); SA1 = MFMA32(k1, qa[kk], SA1); SB0 = MFMA32(k0, qb[kk], SB0); SB1 = MFMA32(k1, qb[kk], SB1); }
#pragma unroll
        for (int i = 0; i < 16; ++i) { SA0[i] = EX(SA0[i]); SB0[i] = EX(SB0[i]); lsA += SA0[i]; lsB += SB0[i]; }
        pA0_0 = make_uint4(cvtpk(SA0[0], SA0[1]), cvtpk(SA0[2], SA0[3]), cvtpk(SA0[4], SA0[5]), cvtpk(SA0[6], SA0[7]));
        pA0_1 = make_uint4(cvtpk(SA0[8], SA0[9]), cvtpk(SA0[10], SA0[11]), cvtpk(SA0[12], SA0[13]), cvtpk(SA0[14], SA0[15]));
        pB0_0 = make_uint4(cvtpk(SB0[0], SB0[1]), cvtpk(SB0[2], SB0[3]), cvtpk(SB0[4], SB0[5]), cvtpk(SB0[6], SB0[7]));
        pB0_1 = make_uint4(cvtpk(SB0[8], SB0[9]), cvtpk(SB0[10], SB0[11]), cvtpk(SB0[12], SB0[13]), cvtpk(SB0[14], SB0[15]));
        fr0 = LD(kp0 + SLOTB + 0 * 1024); fr1 = LD(kp0 + SLOTB + 2 * 1024);
        pA1_0 = pA0_0; pA1_1 = pA0_1; pB1_0 = pB0_0; pB1_1 = pB0_1; fr2 = fr0; fr3 = fr1;
    }
    int off_v = 0, off_k1 = SLOTB, off_k2 = 2 * SLOTB, off_d = 4 * SLOTB, off_d2 = 5 * SLOTB;
#define A64H_STEP(LAST, ODD) do { \
        if (!(ODD)) { if (t + 4 < 64) ATT_DMA(t + 4, off_d); if (t + 5 < 64) ATT_DMA(t + 5, off_d2); } \
        const LAS unsigned char* vp_ = lds + off_v + KBYTES + lane * 16; const LAS unsigned char* kp_ = lds + off_k1 + lane * 16; const LAS unsigned char* kn_ = lds + off_k2 + lane * 16; \
        float la_ = 0.f, lb_ = 0.f; SBAR(); \
        if (!(LAST)) SA0 = MF(fr0, qa[0], zz); fr2 = LD(kp_ + 4096); SA1[0] = EX(SA1[0]); SA1[1] = EX(SA1[1]); SA1[2] = EX(SA1[2]); SBAR(); \
        if (!(LAST)) SB0 = MF(fr0, qb[0], zz); SA1[3] = EX(SA1[3]); SA1[4] = EX(SA1[4]); SA1[5] = EX(SA1[5]); SBAR(); \
        if (!(LAST)) SA0 = MF(fr1, qa[1], SA0); fr3 = LD(kp_ + 6144); SA1[6] = EX(SA1[6]); SA1[7] = EX(SA1[7]); SA1[8] = EX(SA1[8]); SBAR(); \
        if (!(LAST)) SB0 = MF(fr1, qb[1], SB0); SA1[9] = EX(SA1[9]); SA1[10] = EX(SA1[10]); SA1[11] = EX(SA1[11]); SBAR(); \
        if (!(LAST)) SA0 = MF(fr2, qa[2], SA0); fr0 = LD(kp_ + 8192); SA1[12] = EX(SA1[12]); SA1[13] = EX(SA1[13]); SA1[14] = EX(SA1[14]); SBAR(); \
        if (!(LAST)) SB0 = MF(fr2, qb[2], SB0); SA1[15] = EX(SA1[15]); SB1[0] = EX(SB1[0]); SB1[1] = EX(SB1[1]); SBAR(); \
        if (!(LAST)) SA0 = MF(fr3, qa[3], SA0); fr1 = LD(kp_ + 10240); SB1[2] = EX(SB1[2]); SB1[3] = EX(SB1[3]); SB1[4] = EX(SB1[4]); SBAR(); \
        if (!(LAST)) SB0 = MF(fr3, qb[3], SB0); SB1[5] = EX(SB1[5]); SB1[6] = EX(SB1[6]); SB1[7] = EX(SB1[7]); SBAR(); \
        if (!(LAST)) SA0 = MF(fr0, qa[4], SA0); fr2 = LD(vp_ + 0); SB1[8] = EX(SB1[8]); SB1[9] = EX(SB1[9]); SBAR(); \
        if (!(LAST)) SB0 = MF(fr0, qb[4], SB0); SB1[10] = EX(SB1[10]); SB1[11] = EX(SB1[11]); SBAR(); \
        if (!(LAST)) SA0 = MF(fr1, qa[5], SA0); fr3 = LD(vp_ + 1024); SB1[12] = EX(SB1[12]); SB1[13] = EX(SB1[13]); SBAR(); \
        if (!(LAST)) SB0 = MF(fr1, qb[5], SB0); SB1[14] = EX(SB1[14]); SB1[15] = EX(SB1[15]); SBAR(); \
        OA0 = MF(fr2, __builtin_bit_cast(bf16x8, pA0_0), OA0); fr0 = LD(vp_ + 2048); pA1_0.x = cvtpk(SA1[0], SA1[1]); pA1_0.y = cvtpk(SA1[2], SA1[3]); la_ += SA1[0]; la_ += SA1[1]; la_ += SA1[2]; la_ += SA1[3]; asm volatile("" : "+v"(la_), "+v"(lb_)); SBAR(); \
        OB0 = MF(fr2, __builtin_bit_cast(bf16x8, pB0_0), OB0); pA1_0.z = cvtpk(SA1[4], SA1[5]); pA1_0.w = cvtpk(SA1[6], SA1[7]); la_ += SA1[4]; la_ += SA1[5]; la_ += SA1[6]; la_ += SA1[7]; asm volatile("" : "+v"(la_), "+v"(lb_)); SBAR(); \
        OA1 = MF(fr3, __builtin_bit_cast(bf16x8, pA0_0), OA1); fr1 = LD(vp_ + 3072); pA1_1.x = cvtpk(SA1[8], SA1[9]); pA1_1.y = cvtpk(SA1[10], SA1[11]); la_ += SA1[8]; la_ += SA1[9]; la_ += SA1[10]; la_ += SA1[11]; asm volatile("" : "+v"(la_), "+v"(lb_)); SBAR(); \
        OB1 = MF(fr3, __builtin_bit_cast(bf16x8, pB0_0), OB1); pA1_1.z = cvtpk(SA1[12], SA1[13]); pA1_1.w = cvtpk(SA1[14], SA1[15]); la_ += SA1[12]; la_ += SA1[13]; la_ += SA1[14]; la_ += SA1[15]; asm volatile("" : "+v"(la_), "+v"(lb_)); SBAR(); \
        OA0 = MF(fr0, __builtin_bit_cast(bf16x8, pA0_1), OA0); fr2 = LD(kp_ + 1024); pB1_0.x = cvtpk(SB1[0], SB1[1]); pB1_0.y = cvtpk(SB1[2], SB1[3]); lb_ += SB1[0]; lb_ += SB1[1]; lb_ += SB1[2]; lb_ += SB1[3]; asm volatile("" : "+v"(la_), "+v"(lb_)); SBAR(); \
        OB0 = MF(fr0, __builtin_bit_cast(bf16x8, pB0_1), OB0); pB1_0.z = cvtpk(SB1[4], SB1[5]); pB1_0.w = cvtpk(SB1[6], SB1[7]); lb_ += SB1[4]; lb_ += SB1[5]; lb_ += SB1[6]; lb_ += SB1[7]; asm volatile("" : "+v"(la_), "+v"(lb_)); SBAR(); \
        OA1 = MF(fr1, __builtin_bit_cast(bf16x8, pA0_1), OA1); fr3 = LD(kp_ + 3072); pB1_1.x = cvtpk(SB1[8], SB1[9]); pB1_1.y = cvtpk(SB1[10], SB1[11]); lb_ += SB1[8]; lb_ += SB1[9]; lb_ += SB1[10]; lb_ += SB1[11]; asm volatile("" : "+v"(la_), "+v"(lb_)); SBAR(); \
        OB1 = MF(fr1, __builtin_bit_cast(bf16x8, pB0_1), OB1); pB1_1.z = cvtpk(SB1[12], SB1[13]); pB1_1.w = cvtpk(SB1[14], SB1[15]); lb_ += SB1[12]; lb_ += SB1[13]; lb_ += SB1[14]; lb_ += SB1[15]; asm volatile("" : "+v"(la_), "+v"(lb_)); SBAR(); \
        if (!(LAST)) SA1 = MF(fr2, qa[0], zz); fr0 = LD(kp_ + 5120); if (!(LAST)) { SA0[0] = EX(SA0[0]); SA0[1] = EX(SA0[1]); SA0[2] = EX(SA0[2]); } SBAR(); \
        if (!(LAST)) SB1 = MF(fr2, qb[0], zz); if (!(LAST)) { SA0[3] = EX(SA0[3]); SA0[4] = EX(SA0[4]); SA0[5] = EX(SA0[5]); } SBAR(); \
        if (!(LAST)) SA1 = MF(fr3, qa[1], SA1); fr1 = LD(kp_ + 7168); if (!(LAST)) { SA0[6] = EX(SA0[6]); SA0[7] = EX(SA0[7]); SA0[8] = EX(SA0[8]); } SBAR(); \
        if (!(LAST)) SB1 = MF(fr3, qb[1], SB1); if (!(LAST)) { SA0[9] = EX(SA0[9]); SA0[10] = EX(SA0[10]); SA0[11] = EX(SA0[11]); } SBAR(); \
        if (!(LAST)) SA1 = MF(fr0, qa[2], SA1); fr2 = LD(kp_ + 9216); if (!(LAST)) { SA0[12] = EX(SA0[12]); SA0[13] = EX(SA0[13]); SA0[14] = EX(SA0[14]); } SBAR(); \
        if (!(LAST)) SB1 = MF(fr0, qb[2], SB1); if (!(LAST)) { SA0[15] = EX(SA0[15]); SB0[0] = EX(SB0[0]); SB0[1] = EX(SB0[1]); } SBAR(); \
        if (!(LAST)) SA1 = MF(fr1, qa[3], SA1); fr3 = LD(kp_ + 11264); if (!(LAST)) { SB0[2] = EX(SB0[2]); SB0[3] = EX(SB0[3]); SB0[4] = EX(SB0[4]); } SBAR(); \
        if (!(LAST)) SB1 = MF(fr1, qb[3], SB1); if (!(LAST)) { SB0[5] = EX(SB0[5]); SB0[6] = EX(SB0[6]); SB0[7] = EX(SB0[7]); } SBAR(); \
        if (!(LAST)) SA1 = MF(fr2, qa[4], SA1); fr0 = LD(vp_ + 4096); if (!(LAST)) { SB0[8] = EX(SB0[8]); SB0[9] = EX(SB0[9]); } SBAR(); \
        if (!(LAST)) SB1 = MF(fr2, qb[4], SB1); if (!(LAST)) { SB0[10] = EX(SB0[10]); SB0[11] = EX(SB0[11]); } SBAR(); \
        if (!(LAST)) SA1 = MF(fr3, qa[5], SA1); fr1 = LD(vp_ + 5120); if (!(LAST)) { SB0[12] = EX(SB0[12]); SB0[13] = EX(SB0[13]); } SBAR(); \
        if (!(LAST)) SB1 = MF(fr3, qb[5], SB1); if (!(LAST)) { SB0[14] = EX(SB0[14]); SB0[15] = EX(SB0[15]); } SBAR(); \
        OA0 = MF(fr0, __builtin_bit_cast(bf16x8, pA1_0), OA0); fr2 = LD(vp_ + 6144); if (!(LAST)) { pA0_0.x = cvtpk(SA0[0], SA0[1]); pA0_0.y = cvtpk(SA0[2], SA0[3]); la_ += SA0[0]; la_ += SA0[1]; la_ += SA0[2]; la_ += SA0[3]; asm volatile("" : "+v"(la_), "+v"(lb_), "+v"(pA0_0.x), "+v"(pA0_0.y)); } SBAR(); \
        OB0 = MF(fr0, __builtin_bit_cast(bf16x8, pB1_0), OB0); if (!(LAST)) { pA0_0.z = cvtpk(SA0[4], SA0[5]); pA0_0.w = cvtpk(SA0[6], SA0[7]); la_ += SA0[4]; la_ += SA0[5]; la_ += SA0[6]; la_ += SA0[7]; asm volatile("" : "+v"(la_), "+v"(lb_), "+v"(pA0_0.z), "+v"(pA0_0.w)); } SBAR(); \
        OA1 = MF(fr1, __builtin_bit_cast(bf16x8, pA1_0), OA1); fr3 = LD(vp_ + 7168); if (!(LAST)) { pA0_1.x = cvtpk(SA0[8], SA0[9]); pA0_1.y = cvtpk(SA0[10], SA0[11]); la_ += SA0[8]; la_ += SA0[9]; la_ += SA0[10]; la_ += SA0[11]; asm volatile("" : "+v"(la_), "+v"(lb_), "+v"(pA0_1.x), "+v"(pA0_1.y)); } SBAR(); \
        OB1 = MF(fr1, __builtin_bit_cast(bf16x8, pB1_0), OB1); if (!(LAST)) { pA0_1.z = cvtpk(SA0[12], SA0[13]); pA0_1.w = cvtpk(SA0[14], SA0[15]); la_ += SA0[12]; la_ += SA0[13]; la_ += SA0[14]; la_ += SA0[15]; asm volatile("" : "+v"(la_), "+v"(lb_), "+v"(pA0_1.z), "+v"(pA0_1.w)); } SBAR(); \
        OA0 = MF(fr2, __builtin_bit_cast(bf16x8, pA1_1), OA0); if (!(LAST) || 20 < 20) fr0 = LD(kn_ + 0); if (!(LAST)) { pB0_0.x = cvtpk(SB0[0], SB0[1]); pB0_0.y = cvtpk(SB0[2], SB0[3]); lb_ += SB0[0]; lb_ += SB0[1]; lb_ += SB0[2]; lb_ += SB0[3]; asm volatile("" : "+v"(la_), "+v"(lb_), "+v"(pB0_0.x), "+v"(pB0_0.y)); } SBAR(); \
        OB0 = MF(fr2, __builtin_bit_cast(bf16x8, pB1_1), OB0); if (!(LAST)) { pB0_0.z = cvtpk(SB0[4], SB0[5]); pB0_0.w = cvtpk(SB0[6], SB0[7]); lb_ += SB0[4]; lb_ += SB0[5]; lb_ += SB0[6]; lb_ += SB0[7]; asm volatile("" : "+v"(la_), "+v"(lb_), "+v"(pB0_0.z), "+v"(pB0_0.w)); } SBAR(); \
        OA1 = MF(fr3, __builtin_bit_cast(bf16x8, pA1_1), OA1); if (!(LAST) || 21 < 20) fr1 = LD(kn_ + 2048); if (!(LAST)) { pB0_1.x = cvtpk(SB0[8], SB0[9]); pB0_1.y = cvtpk(SB0[10], SB0[11]); lb_ += SB0[8]; lb_ += SB0[9]; lb_ += SB0[10]; lb_ += SB0[11]; asm volatile("" : "+v"(la_), "+v"(lb_), "+v"(pB0_1.x), "+v"(pB0_1.y)); } SBAR(); \
        OB1 = MF(fr3, __builtin_bit_cast(bf16x8, pB1_1), OB1); if (!(LAST)) { pB0_1.z = cvtpk(SB0[12], SB0[13]); pB0_1.w = cvtpk(SB0[14], SB0[15]); lb_ += SB0[12]; lb_ += SB0[13]; lb_ += SB0[14]; lb_ += SB0[15]; asm volatile("" : "+v"(la_), "+v"(lb_), "+v"(pB0_1.z), "+v"(pB0_1.w)); } SBAR(); \
        lsA += la_; lsB += lb_; \
        if (ODD) ATT_WAIT_ALL(); \
        off_v = off_k1; off_k1 = off_k2; off_k2 = (off_k2 == 5 * SLOTB) ? 0 : off_k2 + SLOTB; off_d = off_d2; off_d2 = (off_d2 == 5 * SLOTB) ? 0 : off_d2 + SLOTB; \
    } while (0)
    int t = 0;
    for (; t < 62; t += 2) { A64H_STEP(false, false); A64H_STEP(false, true); }
    A64H_STEP(false, false); A64H_STEP(true, true);
    const int q0 = qb512 * 512 + wid * 64;
    attn_epi64(p, OA0, OA1, lsA, bh, q0, lane);
    attn_epi64(p, OB0, OB1, lsB, bh, q0 + 32, lane);
    asm volatile("s_waitcnt vmcnt(0) lgkmcnt(0)\n\ts_barrier" ::: "memory");
#undef ATT_DMA
#undef ATT_WAIT_MINE
#undef ATT_WAIT_ALL
#undef A64H_STEP
#undef SBAR
#undef EX
#undef LD
#undef MF
}
DI void attn_phase64(LAS unsigned char* lds, const Ptrs& p, int vcu, int G) {
    const int lane = threadIdx.x & 63, wid = __builtin_amdgcn_readfirstlane(threadIdx.x >> 6);
    for (int U = vcu; U < 256; U += G) attn_unit64(lds, p, U >> 3, U & 7, wid, lane);
}
}


namespace p2 {
typedef short bf16x8 __attribute__((ext_vector_type(8)));
typedef short s16x4 __attribute__((ext_vector_type(4)));
typedef unsigned u32x4v __attribute__((ext_vector_type(4)));
typedef float f32x16 __attribute__((ext_vector_type(16)));
using att::cvtpk; using att::glds16;
DI int crow(int i, int h) { return (i & 3) + 8 * (i >> 2) + 4 * h; }
DI float lo16(unsigned u) { return __uint_as_float(u << 16); }
DI float hi16(unsigned u) { return __uint_as_float(u & 0xffff0000u); }
DI float frag_ssq(const bf16x8& f) { const uint4 u = __builtin_bit_cast(uint4, f); float s = 0.f;
    s += lo16(u.x) * lo16(u.x) + hi16(u.x) * hi16(u.x); s += lo16(u.y) * lo16(u.y) + hi16(u.y) * hi16(u.y);
    s += lo16(u.z) * lo16(u.z) + hi16(u.z) * hi16(u.z); s += lo16(u.w) * lo16(u.w) + hi16(u.w) * hi16(u.w); return s; }
DI bf16x8 frag_scale(const bf16x8& f, float sc) { const uint4 u = __builtin_bit_cast(uint4, f); uint4 o;
    o.x = cvtpk(lo16(u.x) * sc, hi16(u.x) * sc); o.y = cvtpk(lo16(u.y) * sc, hi16(u.y) * sc); o.z = cvtpk(lo16(u.z) * sc, hi16(u.z) * sc); o.w = cvtpk(lo16(u.w) * sc, hi16(u.w) * sc);
    return __builtin_bit_cast(bf16x8, o); }
DI uint4 pack8(const f32x16& a, int g, float sc, const float (&gv)[16]) {
    float v[8];
#pragma unroll
    for (int j = 0; j < 8; ++j) v[j] = a[8 * g + j] * sc * gv[8 * g + j];
    uint4 o; o.x = cvtpk(v[0], v[1]); o.y = cvtpk(v[2], v[3]); o.z = cvtpk(v[4], v[5]); o.w = cvtpk(v[6], v[7]); return o;
}
DI uint4 pack8n(const f32x16& a, int g, float sc) {
    uint4 o; o.x = cvtpk(a[8 * g + 0] * sc, a[8 * g + 1] * sc); o.y = cvtpk(a[8 * g + 2] * sc, a[8 * g + 3] * sc); o.z = cvtpk(a[8 * g + 4] * sc, a[8 * g + 5] * sc); o.w = cvtpk(a[8 * g + 6] * sc, a[8 * g + 7] * sc); return o;
}
DI s16x4 vtr(const LAS unsigned char* q) { return __builtin_bit_cast(s16x4, __builtin_amdgcn_ds_read_tr16_b64_v4i16((LAS s16x4*)q)); }
DI void glds16s(const void* sbase, unsigned voff, unsigned lds_dst) { unsigned keep;
    asm volatile("s_mov_b32 %0, m0\n\ts_mov_b32 m0, %3\n\ts_nop 0\n\tglobal_load_lds_dwordx4 %1, %2\n\ts_mov_b32 m0, %0" : "=&s"(keep) : "v"(voff), "s"(sbase), "s"(lds_dst) : "memory"); }
template <int NP8> DI void dma_copy(const unsigned char* gsrc, unsigned lds_dst, int wid, int lane) {
    const unsigned voff = (unsigned)(wid * 1024 + lane * 16);
#pragma unroll
    for (int i = 0; i < NP8; ++i) glds16s(gsrc + (size_t)i * 8192, voff, (unsigned)__builtin_amdgcn_readfirstlane(lds_dst + (i * 8 + wid) * 1024));
}
#define P2_BAR_V(N) asm volatile("s_waitcnt vmcnt(" #N ") lgkmcnt(0)\n\ts_barrier" ::: "memory")

DI void q_head(const Ptrs& p, const LAS unsigned char* wb, const bf16x8 (&cf)[16], float rq, const float (&cs)[8], const float (&sn)[8], int bh, int qblk, int lane) {
    const int h = lane >> 5;
    f32x16 acc[3];
#pragma unroll
    for (int nt = 0; nt < 3; ++nt) {
#pragma unroll
        for (int i = 0; i < 16; ++i) acc[nt][i] = 0.f;
#pragma unroll
        for (int ks = 0; ks < 16; ++ks) acc[nt] = MFMA32(*(const LAS bf16x8*)(wb + (nt * 16 + ks) * 1024 + lane * 16), cf[ks], acc[nt]);
    }
#pragma unroll
    for (int nt = 0; nt < 3; ++nt)
#pragma unroll
        for (int i = 0; i < 16; ++i) acc[nt][i] *= rq;
#pragma unroll
    for (int i = 0; i < 8; ++i) { const float a = acc[2][i], bb = acc[2][i + 8]; acc[2][i] = a * cs[i] - bb * sn[i]; acc[2][i + 8] = bb * cs[i] + a * sn[i]; }
    float sh = 0.f;
#pragma unroll
    for (int nt = 0; nt < 3; ++nt)
#pragma unroll
        for (int i = 0; i < 16; ++i) sh += acc[nt][i] * acc[nt][i];
    sh += __shfl_xor(sh, 32);
    const float rh = QSCALE * rsqrt_fast(sh * (1.f / 96.f) + EPS);
    uint4* dst = (uint4*)(p.ws + WS_QIMG) + ((size_t)(bh * 128 + qblk) * 6) * 64 + lane;
#pragma unroll
    for (int nt = 0; nt < 3; ++nt)
#pragma unroll
        for (int g = 0; g < 2; ++g) dst[(2 * nt + g) * 64] = pack8n(acc[nt], g, rh);
}
DI void kv_head(const Ptrs& p, const LAS unsigned char* wb, const bf16x8 (&cf)[8], const f32x16& kpe, float sspe, const float (&gk)[3][16], int bh, int tile, int c, int lane) {
    const int h = lane >> 5;
    f32x16 acc[2];
#pragma unroll
    for (int nt = 0; nt < 2; ++nt) {
#pragma unroll
        for (int i = 0; i < 16; ++i) acc[nt][i] = 0.f;
#pragma unroll
        for (int ks = 0; ks < 8; ++ks) acc[nt] = MFMA32(*(const LAS bf16x8*)(wb + (nt * 8 + ks) * 1024 + lane * 16), cf[ks], acc[nt]);
    }
    float sk = sspe;
#pragma unroll
    for (int nt = 0; nt < 2; ++nt)
#pragma unroll
        for (int i = 0; i < 16; ++i) sk += acc[nt][i] * acc[nt][i];
    sk += __shfl_xor(sk, 32);
    const float rk = rsqrt_fast(sk * (1.f / 96.f) + EPS);
    uint4* kd = (uint4*)(p.ws + WS_KIMG) + (size_t)(bh * 64 + tile) * 6 * 2 * 64 + c * 64 + lane;
#pragma unroll
    for (int nt = 0; nt < 2; ++nt)
#pragma unroll
        for (int g = 0; g < 2; ++g) kd[(2 * nt + g) * 128] = pack8(acc[nt], g, rk, gk[nt]);
#pragma unroll
    for (int g = 0; g < 2; ++g) kd[(4 + g) * 128] = pack8(kpe, g, rk, gk[2]);
    uint4* vd = (uint4*)(p.ws + WS_VIMG) + (size_t)(bh * 64 + tile) * 8 * 64 + c * 4 * 64 + lane;
#pragma unroll
    for (int dt = 0; dt < 2; ++dt) {
        f32x16 av;
#pragma unroll
        for (int i = 0; i < 16; ++i) av[i] = 0.f;
#pragma unroll
        for (int ks = 0; ks < 8; ++ks) av = MFMA32(cf[ks], *(const LAS bf16x8*)(wb + ((2 + dt) * 8 + ks) * 1024 + lane * 16), av);
#pragma unroll
        for (int s = 0; s < 2; ++s) { uint4 o; o.x = cvtpk(av[8 * s + 0], av[8 * s + 1]); o.y = cvtpk(av[8 * s + 2], av[8 * s + 3]); o.z = cvtpk(av[8 * s + 4], av[8 * s + 5]); o.w = cvtpk(av[8 * s + 6], av[8 * s + 7]);
            vd[(s * 2 + dt) * 64] = o; }
    }
}
DI uint4 pack8l(const f32x16& a, int g, float sc, const LAS float* G) {
    const f32x4_t g0 = *(const LAS f32x4_t*)(G + 16 * g), g1 = *(const LAS f32x4_t*)(G + 16 * g + 8);
    uint4 o; o.x = cvtpk(a[8 * g + 0] * sc * g0[0], a[8 * g + 1] * sc * g0[1]); o.y = cvtpk(a[8 * g + 2] * sc * g0[2], a[8 * g + 3] * sc * g0[3]);
    o.z = cvtpk(a[8 * g + 4] * sc * g1[0], a[8 * g + 5] * sc * g1[1]); o.w = cvtpk(a[8 * g + 6] * sc * g1[2], a[8 * g + 7] * sc * g1[3]); return o;
}
DI void kv_head_l(const Ptrs& p, const LAS unsigned char* wb, const bf16x8 (&cf)[8], const f32x16& kpe, float sspe, const LAS float* G, int bh, int tile, int c, int lane) {
    f32x16 acc[2];
#pragma unroll
    for (int nt = 0; nt < 2; ++nt) {
#pragma unroll
        for (int i = 0; i < 16; ++i) acc[nt][i] = 0.f;
#pragma unroll
        for (int ks = 0; ks < 8; ++ks) acc[nt] = MFMA32(*(const LAS bf16x8*)(wb + (nt * 8 + ks) * 1024 + lane * 16), cf[ks], acc[nt]);
    }
    float sk = sspe;
#pragma unroll
    for (int nt = 0; nt < 2; ++nt)
#pragma unroll
        for (int i = 0; i < 16; ++i) sk += acc[nt][i] * acc[nt][i];
    sk += __shfl_xor(sk, 32);
    const float rk = rsqrt_fast(sk * (1.f / 96.f) + EPS);
    uint4* kd = (uint4*)(p.ws + WS_KIMG) + (size_t)(bh * 64 + tile) * 6 * 2 * 64 + c * 64 + lane;
#pragma unroll
    for (int nt = 0; nt < 2; ++nt)
#pragma unroll
        for (int g = 0; g < 2; ++g) kd[(2 * nt + g) * 128] = pack8l(acc[nt], g, rk, G + 32 * nt);
#pragma unroll
    for (int g = 0; g < 2; ++g) kd[(4 + g) * 128] = pack8l(kpe, g, rk, G + 64);
    uint4* vd = (uint4*)(p.ws + WS_VIMG) + (size_t)(bh * 64 + tile) * 8 * 64 + c * 4 * 64 + lane;
#pragma unroll
    for (int dt = 0; dt < 2; ++dt) {
        f32x16 av;
#pragma unroll
        for (int i = 0; i < 16; ++i) av[i] = 0.f;
#pragma unroll
        for (int ks = 0; ks < 8; ++ks) av = MFMA32(cf[ks], *(const LAS bf16x8*)(wb + ((2 + dt) * 8 + ks) * 1024 + lane * 16), av);
#pragma unroll
        for (int s = 0; s < 2; ++s) { uint4 o; o.x = cvtpk(av[8 * s + 0], av[8 * s + 1]); o.y = cvtpk(av[8 * s + 2], av[8 * s + 3]); o.z = cvtpk(av[8 * s + 4], av[8 * s + 5]); o.w = cvtpk(av[8 * s + 6], av[8 * s + 7]);
            vd[(s * 2 + dt) * 64] = o; }
    }
}
template <bool DO_QKV, bool DO_GMLP>
DI void wg_item(LAS unsigned char* lds, const Ptrs& p, int tg, int hp, int wid, int lane) {
    const int r = lane & 31, h = lane >> 5;
    const unsigned lds0 = (unsigned)(uintptr_t)lds, ldsA = lds0, ldsB = lds0 + 65536;
    const LAS unsigned char* bufA = lds; const LAS unsigned char* bufB = lds + 65536;
    const unsigned char* WqF = p.ws + WS_WUQT; const unsigned char* WkvF = p.ws + WS_WUKVT; const unsigned char* WsF = p.ws + WS_WSB;
    const int hA = 2 * hp, tb = tg * 8 + wid, t = tb * 32 + r, b = t >> 12, s0 = (tb * 32) & 4095, qblk = s0 >> 5, tile = s0 >> 6, c = (s0 >> 5) & 1;
    if constexpr (DO_QKV) {
    const bf16_t* CQ = (const bf16_t*)(p.ws + WS_CQ);
    bf16x8 cf[16];
#pragma unroll
    for (int ks = 0; ks < 16; ++ks) cf[ks] = *(const bf16x8*)(CQ + (((size_t)(tb * 32 + 2 * ks + h) * 32 + r) << 3));
    float cs[8], sn[8];
    { const float* ct = (const float*)(p.ws + WS_COS) + t * 16; const float* st = (const float*)(p.ws + WS_SIN) + t * 16;
#pragma unroll
      for (int i = 0; i < 8; ++i) { cs[i] = ct[crow(i, h)]; sn[i] = st[crow(i, h)]; } }
    dma_copy<6>(WqF + (size_t)hA * 49152, ldsA, wid, lane);
    dma_copy<6>(WqF + (size_t)(hA + 1) * 49152, ldsB, wid, lane);
    float ss = 0.f;
#pragma unroll
    for (int ks = 0; ks < 16; ++ks) ss += frag_ssq(cf[ks]);
    ss += __shfl_xor(ss, 32);
    const float rq = rsqrt_fast(ss * (1.f / 256.f) + EPS);
    P2_BAR_V(6);
    q_head(p, bufA, cf, rq, cs, sn, b * 8 + hA, qblk, lane);
    P2_BAR_V(0);
    dma_copy<8>(WkvF + (size_t)hA * 32768, ldsA, wid, lane);
    q_head(p, bufB, cf, rq, cs, sn, b * 8 + hA + 1, qblk, lane);
    const bf16_t* CKV = (const bf16_t*)(p.ws + WS_CKV);
    bf16x8 kf[8]; float ssk = 0.f;
#pragma unroll
    for (int ks = 0; ks < 8; ++ks) { kf[ks] = *(const bf16x8*)(CKV + (((size_t)(tb * 20 + 2 * ks + h) * 32 + r) << 3)); ssk += frag_ssq(kf[ks]); }
    ssk += __shfl_xor(ssk, 32);
    const float rkv = rsqrt_fast(ssk * (1.f / 128.f) + EPS);
#pragma unroll
    for (int ks = 0; ks < 8; ++ks) kf[ks] = frag_scale(kf[ks], rkv);
    f32x16 kpe; float sspe = 0.f;
    {
        float kr[16];
#pragma unroll
        for (int g = 0; g < 4; ++g) { const uint2 w = *(const uint2*)(CKV + (((size_t)(tb * 20 + 16 + g) * 32 + r) << 3) + 4 * h);
            kr[4 * g + 0] = lo16(w.x); kr[4 * g + 1] = hi16(w.x); kr[4 * g + 2] = lo16(w.y); kr[4 * g + 3] = hi16(w.y); }
#pragma unroll
        for (int i = 0; i < 8; ++i) { const float a = kr[i], bb = kr[i + 8];
            kpe[i] = a * cs[i] - bb * sn[i]; kpe[i + 8] = bb * cs[i] + a * sn[i]; sspe += kpe[i] * kpe[i] + kpe[i + 8] * kpe[i + 8]; }
    }
    float gk[3][16];
#pragma unroll
    for (int nt = 0; nt < 3; ++nt)
#pragma unroll
        for (int i = 0; i < 16; ++i) gk[nt][i] = p.g_kh[32 * nt + crow(i, h)] * p.g_qh[32 * nt + crow(i, h)];
    P2_BAR_V(0);
    if constexpr (DO_GMLP) dma_copy<8>(WsF + (size_t)hA * 32768, ldsB, wid, lane);
    kv_head(p, bufA, kf, kpe, sspe, gk, b * 8 + hA, tile, c, lane);
    kv_head(p, bufA + 32768, kf, kpe, sspe, gk, b * 8 + hA + 1, tile, c, lane);
    P2_BAR_V(0);
    } else { if constexpr (DO_GMLP) dma_copy<8>(WsF + (size_t)hA * 32768, ldsB, wid, lane); }
    if constexpr (DO_GMLP) {
    const bf16_t* Z = (const bf16_t*)(p.ws + WS_Z);
    const int pair = wid >> 1, cl = pair >> 1, hl = pair & 1, hd = hA + hl, tc0 = (2 * tg + cl) * 128;
    uint2 uld[2][2][4], zld[2][2][4];
#pragma unroll
    for (int ii = 0; ii < 2; ++ii) { const bf16_t* zr = Z + (size_t)(tc0 + 32 * (2 * (wid & 1) + ii) + r) * 2048 + hd * 64 + 4 * h;
#pragma unroll
        for (int nt = 0; nt < 2; ++nt)
#pragma unroll
            for (int g = 0; g < 4; ++g) { uld[ii][nt][g] = *(const uint2*)(zr + 512 + 32 * nt + 8 * g); zld[ii][nt][g] = *(const uint2*)(zr + 1536 + 32 * nt + 8 * g); } }
    {
        const int j = 64 * (wid & 1) + lane;
        const uint4* srcv = (const uint4*)(Z + (size_t)(tc0 + j) * 2048 + 1024 + hd * 64);
        float gv[64]; float sg = 0.f;
#pragma unroll
        for (int c8 = 0; c8 < 8; ++c8) { const uint4 u = srcv[c8];
            gv[8 * c8 + 0] = gelu_tanh(lo16(u.x)); gv[8 * c8 + 1] = gelu_tanh(hi16(u.x)); gv[8 * c8 + 2] = gelu_tanh(lo16(u.y)); gv[8 * c8 + 3] = gelu_tanh(hi16(u.y));
            gv[8 * c8 + 4] = gelu_tanh(lo16(u.z)); gv[8 * c8 + 5] = gelu_tanh(hi16(u.z)); gv[8 * c8 + 6] = gelu_tanh(lo16(u.w)); gv[8 * c8 + 7] = gelu_tanh(hi16(u.w)); }
#pragma unroll
        for (int d = 0; d < 64; ++d) sg += gv[d] * gv[d];
        const float rv = rsqrt_fast(sg * (1.f / 64.f) + EPS);
        const float* gg = p.g_vg + hd * 64;
        LAS unsigned char* img = lds + pair * 16384;
#pragma unroll
        for (int c8 = 0; c8 < 8; ++c8) { u32x4v o;
            o.x = cvtpk(gv[8 * c8 + 0] * rv * gg[8 * c8 + 0], gv[8 * c8 + 1] * rv * gg[8 * c8 + 1]); o.y = cvtpk(gv[8 * c8 + 2] * rv * gg[8 * c8 + 2], gv[8 * c8 + 3] * rv * gg[8 * c8 + 3]);
            o.z = cvtpk(gv[8 * c8 + 4] * rv * gg[8 * c8 + 4], gv[8 * c8 + 5] * rv * gg[8 * c8 + 5]); o.w = cvtpk(gv[8 * c8 + 6] * rv * gg[8 * c8 + 6], gv[8 * c8 + 7] * rv * gg[8 * c8 + 7]);
            *(LAS u32x4v*)(img + (c8 >> 2) * 8192 + j * 64 + (c8 & 3) * 16) = o; }
    }
    P2_BAR_V(0);
    {
        bf16x8 vf[8][2];
        { const int q = (lane & 15) >> 2, pp = lane & 3, blk = (lane >> 4) & 1;
          const LAS unsigned char* base = bufA + pair * 16384 + (8 * h + q) * 64 + (16 * blk + 4 * pp) * 2;
#pragma unroll
          for (int ks = 0; ks < 8; ++ks)
#pragma unroll
              for (int nt = 0; nt < 2; ++nt) { const s16x4 lo = vtr(base + nt * 8192 + ks * 1024), hi = vtr(base + nt * 8192 + ks * 1024 + 256);
                  vf[ks][nt] = __builtin_shufflevector(lo, hi, 0, 1, 2, 3, 4, 5, 6, 7); } }
#pragma unroll
        for (int ii = 0; ii < 2; ++ii) { const int it = 2 * (wid & 1) + ii;
            f32x16 acc[2];
#pragma unroll
            for (int i = 0; i < 16; ++i) { acc[0][i] = 0.f; acc[1][i] = 0.f; }
            const LAS unsigned char* wsb = bufB + hl * 32768 + it * 8192 + lane * 16;
#pragma unroll
            for (int ks = 0; ks < 8; ++ks) { const bf16x8 wf = *(const LAS bf16x8*)(wsb + ks * 1024); acc[0] = MFMA32(vf[ks][0], wf, acc[0]); acc[1] = MFMA32(vf[ks][1], wf, acc[1]); }
            const int tt = tc0 + 32 * it + r; const float bs = p.b_s[hd * 128 + 32 * it + r];
            bf16_t* ar = (bf16_t*)(p.ws + WS_AMIX) + (size_t)tt * 1024 + 512 + hd * 64 + 4 * h;
            float sq = 0.f;
#pragma unroll
            for (int nt = 0; nt < 2; ++nt)
#pragma unroll
                for (int g = 0; g < 4; ++g) { const uint2 uu = uld[ii][nt][g], zz = zld[ii][nt][g];
                    const float uv[4] = {lo16(uu.x), hi16(uu.x), lo16(uu.y), hi16(uu.y)}, zv[4] = {lo16(zz.x), hi16(zz.x), lo16(zz.y), hi16(zz.y)}; float a[4];
#pragma unroll
                    for (int e = 0; e < 4; ++e) { const float o = gelu_tanh(uv[e]) * (acc[nt][4 * g + e] + bs); sq += o * o; a[e] = o * silu(zv[e]); }
                    uint2 w; w.x = cvtpk(a[0], a[1]); w.y = cvtpk(a[2], a[3]); *(uint2*)(ar + 32 * nt + 8 * g) = w; }
            sq += __shfl_xor(sq, 32);
            if (h == 0) ((float*)(p.ws + WS_SSQB))[(size_t)hd * T + tt] = sq;
        }
    }
    P2_BAR_V(0);
    }
}
#undef P2_BAR_V
}


typedef unsigned f_u32x2 __attribute__((ext_vector_type(2)));
#define F_BAR_V(N) asm volatile("s_waitcnt vmcnt(" #N ") lgkmcnt(0)\n\ts_barrier" ::: "memory")
#define F_BAR_L() asm volatile("s_waitcnt lgkmcnt(0)\n\ts_barrier" ::: "memory")
DI void p1_fused_q_a(const f32x4_t (&acc)[2][2][4][2], int pm, int wr, int wc, int fr, int fq, LAS unsigned char* lds, const Ptrs* pp) {
    using namespace p2;
    const Ptrs& p = *pp;
    const LAS float* rsx = (const LAS float*)(lds + 131072 + 4096 + 2048);
    LAS float* tab = (LAS float*)(lds + 131072);
#pragma unroll
    for (int ai = 0; ai < 2; ++ai)
#pragma unroll
        for (int m = 0; m < 4; ++m) {
            const int row = ai * 128 + wr * 64 + m * 16 + fr; const float rs = rsx[row]; float part = 0.f;
#pragma unroll
            for (int bj = 0; bj < 2; ++bj) { const f32x4_t v0 = acc[ai][bj][m][0] * rs, v1 = acc[ai][bj][m][1] * rs;
                part += (v0[0] * v0[0] + v0[1] * v0[1]) + (v0[2] * v0[2] + v0[3] * v0[3]) + (v1[0] * v1[0] + v1[1] * v1[1]) + (v1[2] * v1[2] + v1[3] * v1[3]);
                u32x4v w; w.x = cvtpk(v0[0], v0[1]); w.y = cvtpk(v0[2], v0[3]); w.z = cvtpk(v1[0], v1[1]); w.w = cvtpk(v1[2], v1[3]);
                const int chunk = 16 * bj + 4 * wc + fq;
                *(LAS u32x4v*)(lds + ((((row >> 5) * 16 + (chunk >> 1)) * 64 + (chunk & 1) * 32 + (row & 31)) << 4)) = w; }
            part += __shfl_xor(part, 16); part += __shfl_xor(part, 32);
            if (fq == 0) tab[row * 4 + wc] = part;
        }
}
DI void p1_fused_q_b(int pm, LAS unsigned char* lds, const Ptrs* pp, int wid, int lane) {
    using namespace p2;
    const Ptrs& p = *pp;
    const int r = lane & 31, h = lane >> 5;
    const LAS float* tab = (const LAS float*)(lds + 131072);
    bf16x8 cf[16];
#pragma unroll
    for (int ks = 0; ks < 16; ++ks) cf[ks] = *(const LAS bf16x8*)(lds + (((wid * 16 + ks) * 64 + lane) << 4));
    const int row = 32 * wid + r, t = pm * 256 + row, b = t >> 12, s0 = (pm * 256 + 32 * wid) & 4095, qblk = s0 >> 5;
    const float rq = rsqrt_fast((tab[row * 4] + tab[row * 4 + 1] + tab[row * 4 + 2] + tab[row * 4 + 3]) * (1.f / 256.f) + EPS);
    float cs[8], sn[8];
    { const float* ct = (const float*)(p.ws + WS_COS) + t * 16; const float* st = (const float*)(p.ws + WS_SIN) + t * 16;
#pragma unroll
      for (int i = 0; i < 8; ++i) { cs[i] = ct[crow(i, h)]; sn[i] = st[crow(i, h)]; } }
    F_BAR_L();
    const unsigned lds0 = (unsigned)(uintptr_t)lds, ldsA = lds0, ldsB = lds0 + 65536;
    const LAS unsigned char* bufA = lds; const LAS unsigned char* bufB = lds + 65536;
    const unsigned char* WqF = p.ws + WS_WUQT;
    dma_copy<6>(WqF, ldsA, wid, lane);
    dma_copy<6>(WqF + 49152, ldsB, wid, lane);
#pragma nounroll
    for (int hp = 0; hp < 4; ++hp) {
        F_BAR_V(6);
        q_head(p, bufA, cf, rq, cs, sn, b * 8 + 2 * hp, qblk, lane);
        F_BAR_V(0);
        if (hp < 3) dma_copy<6>(WqF + (size_t)(2 * hp + 2) * 49152, ldsA, wid, lane);
        q_head(p, bufB, cf, rq, cs, sn, b * 8 + 2 * hp + 1, qblk, lane);
        F_BAR_L();
        if (hp < 3) dma_copy<6>(WqF + (size_t)(2 * hp + 3) * 49152, ldsB, wid, lane);
    }
    F_BAR_V(0);
}
DI void p1_fused_kv_a(const f32x4_t (&acc)[2][2][4][2], int pm, int wr, int wc, int fr, int fq, LAS unsigned char* lds, const Ptrs* pp) {
    using namespace p2;
    const Ptrs& p = *pp;
    const LAS float* rsx = (const LAS float*)(lds + 131072 + 4096 + 2048);
    LAS float* tab = (LAS float*)(lds + 131072);
#pragma unroll
    for (int ai = 0; ai < 2; ++ai)
#pragma unroll
        for (int m = 0; m < 4; ++m) {
            const int row = ai * 128 + wr * 64 + m * 16 + fr; const float rs = rsx[row];
            { const f32x4_t v0 = acc[ai][0][m][0] * rs, v1 = acc[ai][0][m][1] * rs;
              float part = (v0[0] * v0[0] + v0[1] * v0[1]) + (v0[2] * v0[2] + v0[3] * v0[3]) + (v1[0] * v1[0] + v1[1] * v1[1]) + (v1[2] * v1[2] + v1[3] * v1[3]);
              u32x4v w; w.x = cvtpk(v0[0], v0[1]); w.y = cvtpk(v0[2], v0[3]); w.z = cvtpk(v1[0], v1[1]); w.w = cvtpk(v1[2], v1[3]);
              const int chunk = 4 * wc + fq;
              *(LAS u32x4v*)(lds + ((((row >> 5) * 8 + (chunk >> 1)) * 64 + (chunk & 1) * 32 + (row & 31)) << 4)) = w;
              part += __shfl_xor(part, 16); part += __shfl_xor(part, 32);
              if (fq == 0) tab[row * 4 + wc] = part; }
            if (wc == 0) { const f32x4_t v0 = acc[ai][1][m][0] * rs, v1 = acc[ai][1][m][1] * rs;
              u32x4v w; w.x = cvtpk(v0[0], v0[1]); w.y = cvtpk(v0[2], v0[3]); w.z = cvtpk(v1[0], v1[1]); w.w = cvtpk(v1[2], v1[3]);
              *(LAS u32x4v*)(lds + 65536 + ((((row >> 5) * 4 + fq) * 32 + (row & 31)) << 4)) = w; }
        }
}
DI void p1_fused_kv_b(int pm, LAS unsigned char* lds, const Ptrs* pp, int wid, int lane) {
    using namespace p2;
    const Ptrs& p = *pp;
    const int r = lane & 31, h = lane >> 5;
    LAS float* tab = (LAS float*)(lds + 131072);
    bf16x8 kf[8];
#pragma unroll
    for (int ks = 0; ks < 8; ++ks) kf[ks] = *(const LAS bf16x8*)(lds + (((wid * 8 + ks) * 64 + lane) << 4));
    const int row = 32 * wid + r, t = pm * 256 + row, b = t >> 12, s0 = (pm * 256 + 32 * wid) & 4095, tile = s0 >> 6, c = (s0 >> 5) & 1;
    const float rkv = rsqrt_fast((tab[row * 4] + tab[row * 4 + 1] + tab[row * 4 + 2] + tab[row * 4 + 3]) * (1.f / 128.f) + EPS);
#pragma unroll
    for (int ks = 0; ks < 8; ++ks) kf[ks] = frag_scale(kf[ks], rkv);
    f32x16 kpe; float sspe = 0.f;
    {
        float kr[16];
#pragma unroll
        for (int g = 0; g < 4; ++g) { const f_u32x2 w = *(const LAS f_u32x2*)(lds + 65536 + (((wid * 4 + g) * 32 + r) << 4) + 8 * h);
            kr[4 * g + 0] = lo16(w.x); kr[4 * g + 1] = hi16(w.x); kr[4 * g + 2] = lo16(w.y); kr[4 * g + 3] = hi16(w.y); }
        const float* ct = (const float*)(p.ws + WS_COS) + t * 16; const float* st = (const float*)(p.ws + WS_SIN) + t * 16;
#pragma unroll
        for (int i = 0; i < 8; ++i) { const float a = kr[i], bb = kr[i + 8], cc = ct[crow(i, h)], sv = st[crow(i, h)];
            kpe[i] = a * cc - bb * sv; kpe[i + 8] = bb * cc + a * sv; sspe += kpe[i] * kpe[i] + kpe[i + 8] * kpe[i + 8]; }
    }
    const float gprod = (wid == 0 && lane < 48) ? p.g_kh[lane] * p.g_qh[lane] : 0.f, gprod2 = (wid == 0 && lane < 48) ? p.g_kh[lane + 48] * p.g_qh[lane + 48] : 0.f;
    F_BAR_L();
    if (wid == 0 && lane < 48) { tab[lane] = gprod; tab[lane + 48] = gprod2; }
    const LAS float* G = tab + 4 * h;
    const unsigned lds0 = (unsigned)(uintptr_t)lds, ldsA = lds0, ldsB = lds0 + 65536;
    const LAS unsigned char* bufA = lds; const LAS unsigned char* bufB = lds + 65536;
    const unsigned char* WkvF = p.ws + WS_WUKVT;
    dma_copy<8>(WkvF, ldsA, wid, lane);
    dma_copy<8>(WkvF + 65536, ldsB, wid, lane);
#pragma nounroll
    for (int hq = 0; hq < 2; ++hq) {
        F_BAR_V(8);
        kv_head_l(p, bufA, kf, kpe, sspe, G, b * 8 + 4 * hq, tile, c, lane);
        kv_head_l(p, bufA + 32768, kf, kpe, sspe, G, b * 8 + 4 * hq + 1, tile, c, lane);
        F_BAR_V(0);
        if (hq == 0) dma_copy<8>(WkvF + 2 * 65536, ldsA, wid, lane);
        kv_head_l(p, bufB, kf, kpe, sspe, G, b * 8 + 4 * hq + 2, tile, c, lane);
        kv_head_l(p, bufB + 32768, kf, kpe, sspe, G, b * 8 + 4 * hq + 3, tile, c, lane);
        F_BAR_L();
        if (hq == 0) dma_copy<8>(WkvF + 3 * 65536, ldsB, wid, lane);
    }
    F_BAR_V(0);
}
#undef F_BAR_V
#undef F_BAR_L

#define FB_V(k)      (0x5EED0000u + (unsigned)(k))
#define FB_OK(f, k)  ((((f) & 0xFFFFF0FFu) - FB_V(k)) <= 1u)
#define FB_SPIN_CAP  (1u << 22)
__device__ __forceinline__ unsigned xb_ld(unsigned* p)              { return __hip_atomic_load(p, __ATOMIC_RELAXED, __HIP_MEMORY_SCOPE_AGENT); }
__device__ __forceinline__ void xb_st(unsigned* p, unsigned v)      { __hip_atomic_store(p, v, __ATOMIC_RELAXED, __HIP_MEMORY_SCOPE_AGENT); }
__device__ __forceinline__ unsigned xb_xcc_id() { return (unsigned)__builtin_amdgcn_s_getreg((3 << 11) | 20) & 0xFu; }
__device__ __forceinline__ void flag_barrier(unsigned* bar, volatile LAS unsigned* st, int k) {
    asm volatile("s_waitcnt vmcnt(0)" ::: "memory");
    __syncthreads();
    if (threadIdx.x < 64) {
        const unsigned lane = threadIdx.x, bx = blockIdx.x, x = xb_xcc_id();
        __builtin_amdgcn_s_waitcnt(0);
        if (lane == 0) xb_st(&bar[bx], FB_V(k) | (x << 8));
        unsigned f0, f1, f2, f3, sp = 0u, m; bool leader;
        if (k == 0) {
            for (;;) {
                f0 = xb_ld(&bar[lane]); f1 = xb_ld(&bar[64 + lane]); f2 = xb_ld(&bar[128 + lane]); f3 = xb_ld(&bar[192 + lane]);
                if (__all(FB_OK(f0, k) && FB_OK(f1, k) && FB_OK(f2, k) && FB_OK(f3, k))) break;
                __builtin_amdgcn_s_sleep(2);
                if (++sp > FB_SPIN_CAP) break;
            }
            const unsigned x0 = (f0 >> 8) & 15u, x1 = (f1 >> 8) & 15u, x2 = (f2 >> 8) & 15u, x3 = (f3 >> 8) & 15u;
            const bool lower = (x0 == x && lane < bx) || (x1 == x && 64u + lane < bx) || (x2 == x && 128u + lane < bx) || (x3 == x && 192u + lane < bx);
            leader = !__any(lower);
            m = (1u << x0) | (1u << x1) | (1u << x2) | (1u << x3);
#pragma unroll
            for (int o = 1; o < 64; o <<= 1) m |= __shfl_xor(m, o);
            st[16 + lane] = (x0 == x ? 1u : 0u) | (x1 == x ? 2u : 0u) | (x2 == x ? 4u : 0u) | (x3 == x ? 8u : 0u);
            if (lane == 0) { st[0] = leader ? 1u : 0u; st[1] = m; }
        } else {
            leader = st[0] != 0u; m = st[1];
            if (leader) {
                const unsigned loc = st[16 + lane];
                for (;;) {
                    f0 = (loc & 1u) ? xb_ld(&bar[lane]) : FB_V(k); f1 = (loc & 2u) ? xb_ld(&bar[64 + lane]) : FB_V(k); f2 = (loc & 4u) ? xb_ld(&bar[128 + lane]) : FB_V(k); f3 = (loc & 8u) ? xb_ld(&bar[192 + lane]) : FB_V(k);
                    if (__all(FB_OK(f0, k) && FB_OK(f1, k) && FB_OK(f2, k) && FB_OK(f3, k))) break;
                    __builtin_amdgcn_s_sleep(1);
                    if (++sp > FB_SPIN_CAP) break;
                }
            }
        }
        if (leader) {
            __builtin_amdgcn_fence(__ATOMIC_RELEASE, "agent");
            asm volatile("s_waitcnt vmcnt(0)" ::: "memory");
            if (lane == 0) xb_st(&bar[256 + x], FB_V(k));
        }
        for (sp = 0u;;) {
            const unsigned t = lane < 16u ? xb_ld(&bar[256 + lane]) : 0u;
            const bool need = lane < 16u && ((m >> lane) & 1u);
            if (__all(!need || FB_OK(t, k))) break;
            __builtin_amdgcn_s_sleep(2);
            if (++sp > FB_SPIN_CAP) break;
        }
        __builtin_amdgcn_fence(__ATOMIC_ACQUIRE, "agent");
        asm volatile("s_waitcnt vmcnt(0)" ::: "memory");
    }
    __syncthreads();
}

constexpr int LDS_BYTES = 147456;
constexpr int NPHASE = 5;
constexpr int MISC_OFF = 131072 + 4096;
struct Args { Ptrs p; int ph_lo, ph_hi; };

DI size_t frag_off(int n, int k, int K) { return ((((size_t)(n >> 5) * (K >> 4) + (k >> 4)) * 64 + ((k >> 3) & 1) * 32 + (n & 31)) << 3) + (k & 7); }
template <bool FRAG>
DI void p0_transpose_item(const float* W, int K, int Nsrc, const float* gain, bf16_t* WT, int dst_row0, LAS float* scr, int k0, int n0, int lane) {
#pragma unroll 8
    for (int i = 0; i < 32; ++i) { const int kk = 2 * i + (lane >> 5); scr[kk * 33 + (lane & 31)] = W[(size_t)(k0 + kk) * Nsrc + n0 + (lane & 31)] * gain[k0 + kk]; }
    asm volatile("s_waitcnt lgkmcnt(0)" ::: "memory");
#pragma unroll
    for (int j = 0; j < 4; ++j) {
        const int c = FRAG ? (lane >> 5) + 2 * j : (lane & 7), n = FRAG ? (lane & 31) : (lane >> 3) + 8 * j; const LAS float* s = scr + (8 * c) * 33 + n;
        uint4 o; o.x = f2bf(s[0 * 33]) | ((unsigned)f2bf(s[1 * 33]) << 16); o.y = f2bf(s[2 * 33]) | ((unsigned)f2bf(s[3 * 33]) << 16);
        o.z = f2bf(s[4 * 33]) | ((unsigned)f2bf(s[5 * 33]) << 16); o.w = f2bf(s[6 * 33]) | ((unsigned)f2bf(s[7 * 33]) << 16);
        if (FRAG) *(uint4*)(WT + frag_off(dst_row0 + n, k0 + 8 * c, K)) = o; else *(uint4*)(WT + (size_t)(dst_row0 + n) * K + k0 + 8 * c) = o; }
    asm volatile("s_waitcnt lgkmcnt(0)" ::: "memory");
}
DI void p0_prologue(const Ptrs& p, LAS unsigned char* lds, int vcu, int G) {
    const int tid = threadIdx.x, lane = tid & 63, wave = __builtin_amdgcn_readfirstlane(tid >> 6);
    const int gw = vcu * 8 + wave, NGW = G * 8;
    LAS float* scr = (LAS float*)(lds + wave * 16384);
    bf16_t* WinT = (bf16_t*)(p.ws + WS_WINT); bf16_t* WuqT = (bf16_t*)(p.ws + WS_WUQT); bf16_t* WukvT = (bf16_t*)(p.ws + WS_WUKVT);
    bf16_t* WoutT = (bf16_t*)(p.ws + WS_WOUTT); bf16_t* Wsb = (bf16_t*)(p.ws + WS_WSB);
    {
    bf16_t* xb = (bf16_t*)(p.ws + WS_XB); float* rs = (float*)(p.ws + WS_RSTDX);
    for (int row = gw; row < T; row += NGW) {
        typedef float f32x4v __attribute__((ext_vector_type(4)));
        const f32x4v* xr = (const f32x4v*)(p.x + (size_t)row * DM) + lane;
        float s = 0.f; f32x4v v[4];
#pragma unroll
        for (int j = 0; j < 4; ++j) { v[j] = __builtin_nontemporal_load(xr + 64 * j); s += v[j].x * v[j].x + v[j].y * v[j].y + v[j].z * v[j].z + v[j].w * v[j].w; }
#pragma unroll
        for (int o = 1; o < 64; o <<= 1) s += __shfl_xor(s, o);
        if (lane == 0) rs[row] = rsqrt_fast(s * (1.f / DM) + EPS);
        uint2* o8 = (uint2*)(xb + (size_t)row * DM) + lane;
#pragma unroll
        for (int j = 0; j < 4; ++j) { uint2 w; w.x = f2bf(v[j].x) | ((unsigned)f2bf(v[j].y) << 16); w.y = f2bf(v[j].z) | ((unsigned)f2bf(v[j].w) << 16); o8[64 * j] = w; }
    }
    }
    constexpr int I_IN = 16 * 77, I_UQ = 4 * 24, I_UKV = 2 * 32, I_OUT = 16 * 32, NITEMS = I_IN + I_UQ + I_UKV + I_OUT;
    for (int it = gw; it < NITEMS; it += NGW) {
        int r = it;
        if (r < I_IN) { const int kb = r / 77, nb = r % 77; p0_transpose_item<false>(p.w_in, 1024, 2464, p.g_in, WinT, nb < 8 ? 1024 + 32 * nb : nb < 13 ? 1280 + 32 * (nb - 8) : nb < 29 ? 2048 + 32 * (nb - 13) : nb < 61 ? 32 * (nb - 29) : 1536 + 32 * (nb - 61), scr, 64 * kb, 32 * nb, lane);   continue; } r -= I_IN;
        if (r < I_UQ) { const int kb = r / 24, nb = r % 24; p0_transpose_item<true>(p.w_uq, 256, 768, p.g_ql, WuqT, 32 * nb, scr, 64 * kb, 32 * nb, lane); continue; } r -= I_UQ;
        if (r < I_UKV) { const int kb = r / 32, nb = r % 32; p0_transpose_item<true>(p.w_ukv, 128, 1024, p.g_kvl, WukvT, 32 * nb, scr, 64 * kb, 32 * nb, lane); continue; } r -= I_UKV;
        { const int kb = r / 32, nb = r % 32; p0_transpose_item<false>(p.w_out, 1024, 1024, kb < 8 ? p.g_oa : p.g_ob - 512, WoutT, 32 * nb, scr, 64 * kb, 32 * nb, lane); }
    }
    const size_t gid = (size_t)vcu * 512 + tid, gsz = (size_t)G * 512;
    for (size_t i = gid; i < (size_t)96 * 1024 / 8; i += gsz) ((uint4*)(WinT + (size_t)1440 * 1024))[i] = make_uint4(0u, 0u, 0u, 0u);
    for (size_t i = gid; i < (size_t)8 * 128 * 16; i += gsz) { const int n = (int)(i >> 4), kc = (int)(i & 15); const float4 a = *(const float4*)(p.w_s + (size_t)n * 128 + 8 * kc), bq = *(const float4*)(p.w_s + (size_t)n * 128 + 8 * kc + 4);
        uint4 o; o.x = f2bf(a.x) | ((unsigned)f2bf(a.y) << 16); o.y = f2bf(a.z) | ((unsigned)f2bf(a.w) << 16); o.z = f2bf(bq.x) | ((unsigned)f2bf(bq.y) << 16); o.w = f2bf(bq.z) | ((unsigned)f2bf(bq.w) << 16);
        *(uint4*)(Wsb + frag_off(n, 8 * kc, 128)) = o; }
    float* ct = (float*)(p.ws + WS_COS); float* st = (float*)(p.ws + WS_SIN);
    for (size_t i = gid; i < (size_t)T * 16; i += gsz) { const int t = (int)(i >> 4), f = (int)(i & 15);
        const float invf = 1.0f / powf(10000.0f, (float)(2 * f) / 32.0f);
        const float ang = (float)p.pos[t] * invf;
        const double rev = (double)ang * 0.15915494309189535; const float fr = (float)(rev - rint(rev));
        ct[i] = __builtin_amdgcn_cosf(fr); st[i] = __builtin_amdgcn_sinf(fr); }
}

__global__ void __launch_bounds__(512, 2) mega(Args a) {
    extern __shared__ __attribute__((aligned(16))) unsigned char lds_all[];
    LAS unsigned char* lds = (LAS unsigned char*)lds_all;
    cg::grid_group grid = cg::this_grid();
    const Ptrs& p = a.p;
#define GRID_BAR(k) flag_barrier((unsigned*)(p.ws + WS_CTL) + 1024, (volatile LAS unsigned*)(lds + MISC_OFF), (k))
    if (a.ph_lo > 1000) grid.sync();
    const int lo = a.ph_lo, hi = a.ph_hi, G = gridDim.x, bx = blockIdx.x;
    const int vcu = (G % 8 == 0) ? (bx % 8) * (G / 8) + bx / 8 : bx;
#define IN(k) (lo <= (k) && (k) < hi)
#define BOTH(k) (IN(k) && IN((k) + 1))
    if (IN(0)) { p0_prologue(p, lds, vcu, G); if (BOTH(0)) GRID_BAR(0); }
    if (IN(1)) {
        {
        __syncthreads();
        pg8::Gemm g{(const bf16_t*)(p.ws + WS_XB), (const bf16_t*)(p.ws + WS_WINT), T, NP + 512, DM}; pg8::P1Order S; S.init(T, NP, G, bx);
        { pg8::Unit u0; S.next(0, u0); if (threadIdx.x < 256) ((LAS float*)(lds + MISC_OFF + 2048))[threadIdx.x] = ((const float*)(p.ws + WS_RSTDX))[u0.pm * 256 + threadIdx.x];
          asm volatile("s_waitcnt vmcnt(0) lgkmcnt(0)" ::: "memory"); __syncthreads(); }
        pg8::EpiProj E{(bf16_t*)(p.ws + WS_Z), (const LAS float*)(lds + MISC_OFF + 2048), &p};
        pg8::gemm_phase<pg8::EpiProj, pg8::P1Order, true, true>(lds, g, S, E);
        }
        if (BOTH(1)) GRID_BAR(1);
    }
    if (IN(2)) {
        const int lane = threadIdx.x & 63, wid = __builtin_amdgcn_readfirstlane(threadIdx.x >> 6);
        __syncthreads();
        p2::wg_item<false, true>(lds, p, 8 * (bx & 7) + ((bx >> 3) & 7), bx >> 6, wid, lane);
        asm volatile("s_waitcnt vmcnt(0) lgkmcnt(0)" ::: "memory");
    }
    if (IN(3)) { __syncthreads(); att::attn_phase64(lds, p, vcu, G); if (BOTH(3)) GRID_BAR(2); }
    if (IN(4)) {
        {
        __syncthreads();
        pg8::StaticOrder S; S.init(T, DM, G, bx); pg8::Unit u0;
        if (S.next(0, u0) && threadIdx.x < 256) {
            const float* ssqa = (const float*)(p.ws + WS_SSQA); const float* ssqb = (const float*)(p.ws + WS_SSQB); const int t = u0.pm * 256 + threadIdx.x;
            float sa = 0.f, sb = 0.f;
#pragma unroll
            for (int h = 0; h < 8; ++h) { sa += ssqa[(size_t)h * T + t]; sb += ssqb[(size_t)h * T + t]; }
            const float ra = rsqrt_fast(sa * (1.f / 512.f) + EPS), rb = rsqrt_fast(sb * (1.f / 512.f) + EPS);
            ((LAS float*)(lds + pg8::STAGE_BYTES))[threadIdx.x] = ra / rb; ((LAS float*)(lds + pg8::STAGE_BYTES + 1024))[threadIdx.x] = rb;
        }
        asm volatile("s_waitcnt vmcnt(0) lgkmcnt(0)" ::: "memory"); __syncthreads();
        pg8::Gemm g{(const bf16_t*)(p.ws + WS_AMIX), (const bf16_t*)(p.ws + WS_WOUTT), T, DM, DM};
        pg8::EpiOut E{p.x, p.out, lds, (const bf16_t*)(p.ws + WS_XB)};
        pg8::gemm_phase<pg8::EpiOut, pg8::StaticOrder, false, true>(lds, g, S, E);
        }
    }
#undef IN
#undef BOTH
}

static int g_grid = 0;
static void launch_mega(const Ptrs& p, int lo, int hi, hipStream_t stream) {
    if (g_grid == 0) {
        int dev = 0, cus = 0, per_cu = 0;
        hipGetDevice(&dev); hipDeviceGetAttribute(&cus, hipDeviceAttributeMultiprocessorCount, dev);
        hipFuncSetAttribute((const void*)mega, hipFuncAttributeMaxDynamicSharedMemorySize, LDS_BYTES);
        hipOccupancyMaxActiveBlocksPerMultiprocessor(&per_cu, (const void*)mega, 512, LDS_BYTES);
        g_grid = cus;
        if (per_cu < 1 || cus != 256) { fprintf(stderr, "mega: built for 256 CUs x 1 resident workgroup; device has %d CUs, occupancy query says %d per CU; nothing launched\n", cus, per_cu); g_grid = -1; }
    }
    if (g_grid < 0) return;
    Args a{}; a.p = p; a.ph_lo = lo; a.ph_hi = hi;
    void* args[] = {&a};
    hipError_t e = hipLaunchCooperativeKernel((const void*)mega, dim3(g_grid), dim3(512), args, LDS_BYTES, stream);
    if (e != hipSuccess) fprintf(stderr, "cooperative launch failed: %s (grid %d)\n", hipGetErrorString(e), g_grid);
}
extern "C" void kernel_launch(void* const* d_in, const int* in_sizes, int n_in, void* d_out, int out_size, void* d_ws, size_t ws_size, hipStream_t stream) {
    if (n_in != 16 || out_size != T * DM || ws_size < WS_END) { fprintf(stderr, "kernel_launch: unexpected shapes n_in %d out %d ws %zu\n", n_in, out_size, ws_size); return; }
    Ptrs p{};
    p.x = (const float*)d_in[0]; p.pos = (const int*)d_in[1]; p.g_in = (const float*)d_in[2]; p.w_in = (const float*)d_in[3]; p.g_ql = (const float*)d_in[4]; p.w_uq = (const float*)d_in[5];
    p.g_kvl = (const float*)d_in[6]; p.w_ukv = (const float*)d_in[7]; p.g_qh = (const float*)d_in[8]; p.g_kh = (const float*)d_in[9]; p.g_vg = (const float*)d_in[10]; p.w_s = (const float*)d_in[11];
    p.b_s = (const float*)d_in[12]; p.g_oa = (const float*)d_in[13]; p.g_ob = (const float*)d_in[14]; p.w_out = (const float*)d_in[15];
    p.out = (float*)d_out; p.ws = (unsigned char*)d_ws;
    launch_mega(p, 0, 5, stream);
}
```

```cpp
#include <hip/hip_runtime.h>
#include <stdint.h>
#include <stdio.h>
#include <hip/hip_cooperative_groups.h>
namespace cg = cooperative_groups;

#define DI __device__ __forceinline__
#define LAS __attribute__((address_space(3)))
typedef unsigned short bf16_t;

constexpr int T = 16384, SEQ = 4096, NB = 4, DM = 1024, NH = 8, QK = 96, DV = 64;
constexpr int NP = 2048;
constexpr float EPS = 1e-6f;
constexpr float QSCALE = 0.10206207261596575f * 1.4426950408889634f;

constexpr size_t MiB = 1u << 20;
constexpr size_t WS_CTL = 0;
constexpr size_t WS_XB = 1 * MiB;
constexpr size_t WS_RSTDX = 33 * MiB;
constexpr size_t WS_COS = 34 * MiB;
constexpr size_t WS_SIN = 35 * MiB;
constexpr size_t WS_WINT = 36 * MiB;
constexpr size_t WS_WUQT = 41 * MiB;
constexpr size_t WS_WUKVT = 42 * MiB;
constexpr size_t WS_WOUTT = 43 * MiB;
constexpr size_t WS_WSB = 45 * MiB;
constexpr size_t WS_SSQA = 46 * MiB;
constexpr size_t WS_SSQB = 47 * MiB;
constexpr size_t WS_CQ = 48 * MiB;
constexpr size_t WS_CKV = 56 * MiB;
constexpr size_t WS_Z = 62 * MiB;
constexpr size_t WS_QIMG = 126 * MiB;
constexpr size_t WS_KIMG = 150 * MiB;
constexpr size_t WS_VIMG = 174 * MiB;
constexpr size_t WS_AMIX = 190 * MiB;
constexpr size_t WS_END = 222 * MiB;

DI float bf2f(bf16_t b) { return __uint_as_float(((unsigned)b) << 16); }
DI bf16_t f2bf(float f) { unsigned u = __float_as_uint(f); return (bf16_t)((u + 0x7fffu + ((u >> 16) & 1u)) >> 16); }
DI float gelu_tanh(float x) {
    const float y = x * (0.7978845608028654f + 0.035677408136300125f * x * x);
    return x * __builtin_amdgcn_rcpf(1.f + __builtin_amdgcn_exp2f(-2.885390081777927f * y));
}
DI float silu(float x) { return x * __builtin_amdgcn_rcpf(1.f + __builtin_amdgcn_exp2f(-1.4426950408889634f * x)); }
DI float rsqrt_fast(float x) { return __builtin_amdgcn_rsqf(x); }

DI size_t cq_idx(int t, int k) { return ((((size_t)(t >> 5) * 32 + (k >> 3)) * 32 + (t & 31)) << 3) + (k & 7); }
DI size_t ckv_idx(int t, int k) { return ((((size_t)(t >> 5) * 20 + (k >> 3)) * 32 + (t & 31)) << 3) + (k & 7); }
DI size_t qimg_idx(int bh, int s, int d) {
    const int qb = s >> 5, r = s & 31, kk = d >> 4, e = d & 15, h = (e >> 2) & 1, j = 4 * (e >> 3) + (e & 3);
    return (((((size_t)bh * 128 + qb) * 6 + kk) * 64 + (h * 32 + r)) << 3) + j;
}
DI size_t kimg_idx(int bh, int s, int d) {
    const int tile = s >> 6, c = (s >> 5) & 1, r = s & 31, kk = d >> 4, e = d & 15, h = (e >> 2) & 1, j = 4 * (e >> 3) + (e & 3);
    return ((((((size_t)bh * 64 + tile) * 6 + kk) * 2 + c) * 64 + (h * 32 + r)) << 3) + j;
}
DI size_t vimg_idx(int bh, int s, int d) {
    const int tile = s >> 6, kin = s & 63, c = kin >> 5, s2 = (kin >> 4) & 1, e = kin & 15, h = (e >> 2) & 1, j = 4 * (e >> 3) + (e & 3), dt = d >> 5, r = d & 31;
    return (((((((size_t)bh * 64 + tile) * 2 + c) * 2 + s2) * 2 + dt) * 64 + (h * 32 + r)) << 3) + j;
}

struct Ptrs {
    const float *x; const int* pos; const float *g_in, *w_in, *g_ql, *w_uq, *g_kvl, *w_ukv, *g_qh, *g_kh, *g_vg, *w_s, *b_s, *g_oa, *g_ob, *w_out;
    float* out; unsigned char* ws;
};

typedef float f32x4_t __attribute__((ext_vector_type(4)));
DI void p1_fused_q_a(const f32x4_t (&acc)[2][2][4][2], int pm, int wr, int wc, int fr, int fq, LAS unsigned char* lds, const Ptrs* pp);
DI void p1_fused_kv_a(const f32x4_t (&acc)[2][2][4][2], int pm, int wr, int wc, int fr, int fq, LAS unsigned char* lds, const Ptrs* pp);
DI void p1_fused_q_b(int pm, LAS unsigned char* lds, const Ptrs* pp, int wid, int lane);
DI void p1_fused_kv_b(int pm, LAS unsigned char* lds, const Ptrs* pp, int wid, int lane);
namespace pg8 {
#define PG8_LAS __attribute__((address_space(3)))
typedef short bf16x8 __attribute__((ext_vector_type(8)));
typedef float f32x4 __attribute__((ext_vector_type(4)));
typedef unsigned u32x4 __attribute__((ext_vector_type(4)));
constexpr int BM = 256, BK = 64, HALF = 128, HTB = HALF * BK * 2  , STAGE_BYTES = 8 * HTB, NXCD = 8, WGM = 8;

__host__ __device__ __forceinline__ int lds_byte(int r, int c) { const int st = (r >> 4) * 2 + (c >> 5), rr = r & 15, cc = c & 31, ob = rr * 64 + cc * 2; return st * 1024 + (ob ^ (((ob >> 9) & 1) << 5)); }
__host__ __device__ __forceinline__ void stage_rc(int b, int& R, int& C) { const int st = b / 1024, sb = b % 1024, swz = sb ^ (((sb >> 9) & 1) << 5); R = (st >> 1) * 16 + swz / 64; C = (st & 1) * 32 + (swz % 64) / 2; }
__host__ __device__ __forceinline__ int perm32(int rho) { const int n = rho >> 4, i = rho & 15; return 8 * (i >> 2) + 4 * n + (i & 3); }

struct Unit { int pm, pn; };
struct Gemm { const bf16_t* A; const bf16_t* Bt; int M, N, K; };

struct StaticOrder {
    int nM, nN, nwg, G, c;
    __host__ __device__ void init(int M, int N, int G_, int c_) { nM = M / BM; nN = N / BM; nwg = nM * nN; G = G_; c = c_; }
    __host__ __device__ bool next(int i, Unit& u) const {
        const long L = (long)i * G + c; if (L >= nwg) return false;
        int wgid = (int)L; { const int q = nwg / NXCD, r = nwg % NXCD, xcd = wgid % NXCD, off = wgid / NXCD; wgid = (xcd < r ? xcd * (q + 1) : r * (q + 1) + (xcd - r) * q) + off; }
        const int nig = WGM * nN, gid = wgid / nig, fm = gid * WGM, gsz = (nM - fm) < WGM ? (nM - fm) : WGM;
        u.pm = fm + ((wgid % nig) % gsz); u.pn = (wgid % nig) / gsz; return true;
    }
    __device__ __forceinline__ void a_ready(const Unit&) const {}
    __device__ __forceinline__ void done(const Unit&) const {}
};
__device__ __forceinline__ unsigned cvt_pk_bf16(float lo, float hi) { unsigned r; asm volatile("v_cvt_pk_bf16_f32 %0, %1, %2" : "=v"(r) : "v"(lo), "v"(hi)); return r; }

struct OneUnit { int pm, pn;
    __device__ __forceinline__ bool next(int i, Unit& u) const { if (i) return false; u.pm = pm; u.pn = pn; return true; }
    __device__ __forceinline__ void a_ready(const Unit&) const {}
    __device__ __forceinline__ void done(const Unit&) const {}
};
struct P1Order { StaticOrder S;
    __host__ __device__ void init(int M, int N, int G_, int c_) { S.init(M, N, G_, c_); }
    __host__ __device__ bool next(int i, Unit& u) const {
        if (i < 2) return S.next(i, u);
        if (i == 2 && S.c >= 128) { S.next(1, u); u.pn += 2; return true; }
        return false; }
    __device__ __forceinline__ void a_ready(const Unit&) const {}
    __device__ __forceinline__ void done(const Unit&) const {}
};
struct EpiProj {
    static constexpr bool PERM = true, AFTER_DRAIN = false, HAS_MID = false, FUSE_LAST = true; static constexpr int MID_T = -1;
    bf16_t *Z; const PG8_LAS float* rtab; const Ptrs* pp;
    __device__ __forceinline__ bool fused_unit(const Unit& u) const { return u.pn == 4 || u.pn == 5; }
    __device__ __forceinline__ void fused(const f32x4 (&acc)[2][2][4][2], const Unit& u, int wr, int wc, int fr, int fq, PG8_LAS unsigned char* lds, int wid, int lane) const {
        if (u.pn == 4) p1_fused_q_a(acc, u.pm, wr, wc, fr, fq, lds, pp); else p1_fused_kv_a(acc, u.pm, wr, wc, fr, fq, lds, pp);
        asm volatile("s_waitcnt lgkmcnt(0)\n\ts_barrier" ::: "memory");
        if (u.pn == 4) p1_fused_q_b(u.pm, lds, pp, wid, lane); else p1_fused_kv_b(u.pm, lds, pp, wid, lane); }
    __device__ __forceinline__ void mid(f32x4 (&)[2][2][4][2], int, int, PG8_LAS unsigned char*) const {}
    __device__ __forceinline__ void operator()(const f32x4 (&acc)[2][2][4][2], const Unit& u, int wr, int wc, int fr, int fq) const {
        const int row0 = u.pm * BM + wr * 64 + fr;
        const int zc = (u.pn < 4 ? 512 + u.pn * BM : u.pn < 8 ? u.pn * BM : (u.pn - 8) * BM);
        float rsv[2][4];
#pragma unroll
        for (int ai = 0; ai < 2; ++ai)
#pragma unroll
            for (int m = 0; m < 4; ++m) rsv[ai][m] = rtab[wr * 64 + fr + ai * HALF + m * 16];
#pragma unroll
        for (int ai = 0; ai < 2; ++ai)
#pragma unroll
            for (int m = 0; m < 4; ++m) { const int row = row0 + ai * HALF + m * 16; const float rs = rsv[ai][m];
#pragma unroll
                for (int bj = 0; bj < 2; ++bj) { const int lc = bj * HALF + wc * 32 + 8 * fq;
                    const f32x4 v0 = acc[ai][bj][m][0] * rs, v1 = acc[ai][bj][m][1] * rs;
                    u32x4 w; w.x = cvt_pk_bf16(v0[0], v0[1]); w.y = cvt_pk_bf16(v0[2], v0[3]); w.z = cvt_pk_bf16(v1[0], v1[1]); w.w = cvt_pk_bf16(v1[2], v1[3]);
                    *(u32x4*)(Z + (size_t)row * 2048 + zc + lc) = w; } }

    }
};
struct EpiOut {
    static constexpr bool PERM = false, AFTER_DRAIN = true, HAS_MID = true, FUSE_LAST = false; static constexpr int MID_T = 8;
    __device__ __forceinline__ bool fused_unit(const Unit&) const { return false; }
    __device__ __forceinline__ void fused(const f32x4 (&acc)[2][2][4][2], const Unit& u, int wr, int wc, int fr, int fq, PG8_LAS unsigned char* lds, int wid, int lane) const {
        typedef float nt4 __attribute__((ext_vector_type(4)));
        const PG8_LAS float* rstdb = (const PG8_LAS float*)(lds + STAGE_BYTES + 1024);
#pragma unroll
        for (int ai = 0; ai < 2; ++ai) {
            const size_t g0 = (size_t)(u.pm * BM + ai * HALF + wid * 16) * 1024 + u.pn * BM + 4 * lane;
            typedef unsigned nt2 __attribute__((ext_vector_type(2)));
            nt2 xv[16];
#pragma unroll
            for (int i = 0; i < 16; ++i) xv[i] = __builtin_nontemporal_load((const nt2*)(xb + g0 + (size_t)i * 1024));
#pragma unroll
            for (int m = 0; m < 4; ++m) { const int r = wr * 64 + m * 16 + fr; const float rb = rstdb[ai * HALF + r];
#pragma unroll
                for (int bj = 0; bj < 2; ++bj)
#pragma unroll
                    for (int n = 0; n < 2; ++n) { const int c = bj * 32 + wc * 8 + n * 4 + fq;
                        *(PG8_LAS f32x4*)(lds + r * 1024 + ((c ^ (r & 15)) << 4)) = acc[ai][bj][m][n] * rb; } }
            asm volatile("s_waitcnt lgkmcnt(0)\n\ts_barrier" ::: "memory");
#pragma unroll
            for (int i = 0; i < 16; ++i) { const f32x4 v = *(const PG8_LAS f32x4*)(lds + (wid * 16 + i) * 1024 + ((lane ^ i) << 4));
                const f32x4 xr = {__builtin_bit_cast(float, xv[i].x << 16), __builtin_bit_cast(float, xv[i].x & 0xffff0000u), __builtin_bit_cast(float, xv[i].y << 16), __builtin_bit_cast(float, xv[i].y & 0xffff0000u)};
                __builtin_nontemporal_store(xr + v, (nt4*)(out + g0 + (size_t)i * 1024)); }
            if (ai == 0) asm volatile("s_waitcnt lgkmcnt(0)\n\ts_barrier" ::: "memory");
        }
    }
    const float* x; float* out; PG8_LAS unsigned char* ldsb; const bf16_t* xb;
    __device__ __forceinline__ void mid(f32x4 (&acc)[2][2][4][2], int wr, int fr, PG8_LAS unsigned char* lds) const {
        const PG8_LAS float* ratio = (const PG8_LAS float*)(lds + STAGE_BYTES);
#pragma unroll
        for (int ai = 0; ai < 2; ++ai)
#pragma unroll
            for (int m = 0; m < 4; ++m) { const float r = ratio[ai * HALF + wr * 64 + m * 16 + fr];
#pragma unroll
                for (int bj = 0; bj < 2; ++bj)
#pragma unroll
                    for (int n = 0; n < 2; ++n) acc[ai][bj][m][n] = acc[ai][bj][m][n] * r; }
    }
    __device__ __forceinline__ void operator()(const f32x4 (&acc)[2][2][4][2], const Unit& u, int wr, int wc, int fr, int fq) const {
        const PG8_LAS float* rstdb = (const PG8_LAS float*)(ldsb + STAGE_BYTES + 1024);
        const int row0 = u.pm * BM + wr * 64 + fr, col0 = u.pn * BM + wc * 32 + 4 * fq;
#pragma unroll
        for (int ai = 0; ai < 2; ++ai) {
            f32x4 xv[4][2][2]; float rb[4];
#pragma unroll
            for (int m = 0; m < 4; ++m) { rb[m] = rstdb[ai * HALF + wr * 64 + m * 16 + fr]; const size_t off = (size_t)(row0 + ai * HALF + m * 16) * 1024 + col0;
#pragma unroll
                for (int bj = 0; bj < 2; ++bj)
#pragma unroll
                    for (int n = 0; n < 2; ++n) xv[m][bj][n] = __builtin_nontemporal_load((const f32x4*)(x + off + bj * HALF + n * 16)); }
#pragma unroll
            for (int m = 0; m < 4; ++m) { const size_t off = (size_t)(row0 + ai * HALF + m * 16) * 1024 + col0;
#pragma unroll
                for (int bj = 0; bj < 2; ++bj)
#pragma unroll
                    for (int n = 0; n < 2; ++n) __builtin_nontemporal_store(xv[m][bj][n] + acc[ai][bj][m][n] * rb[m], (f32x4*)(out + off + bj * HALF + n * 16)); }
        }
    }
};
template <class Epi, class Sched, bool ALIGN_EPI = false, bool SP2 = false>
__device__ __forceinline__ void gemm_phase(PG8_LAS unsigned char* lds, const Gemm g, const Sched& S, const Epi& E) {
    const int tid = threadIdx.x, wid = __builtin_amdgcn_readfirstlane(tid >> 6), lane = tid & 63, wr = wid >> 2, wc = wid & 3, fr = lane & 15, fq = lane >> 4;
    const int K = g.K, nt = K / BK;
    unsigned voffA[2], voffB[2];
#pragma unroll
    for (int i = 0; i < 2; ++i) { int R, C; stage_rc(tid * 16 + i * 8192, R, C); const int Rb = Epi::PERM ? ((R & ~31) + perm32(R & 31)) : R;
        voffA[i] = (unsigned)(R * K + C) * 2u; voffB[i] = (unsigned)(Rb * K + C) * 2u; }
    const size_t kstep = (size_t)(BK * 2);
    const size_t hstep = (size_t)HALF * K * 2;
    const size_t tstep = 2 * hstep;
    const unsigned ldsw = (unsigned)wid * 1024u;
    const int aoff = lds_byte(wr * 64 + fr, fq * 8), boff = lds_byte(wc * 32 + fr, fq * 8);
#define PG8_SA(b, h) (((b) * 2 + (h)) * HTB)
#define PG8_SB(b, h) ((4 + (b) * 2 + (h)) * HTB)
#define PG8_STAGE(bufoff, gbase, voff) do { _Pragma("unroll") for (int _i = 0; _i < 2; ++_i) \
        __builtin_amdgcn_global_load_lds((const unsigned*)((const char*)(gbase) + (voff)[_i]), (PG8_LAS unsigned*)(lds + (bufoff) + ldsw + _i * 8192), 16, 0, 0); } while (0)
#define PG8_LDA(dst, b, h) do { _Pragma("unroll") for (int m = 0; m < 4; ++m) _Pragma("unroll") for (int k = 0; k < 2; ++k) dst[m][k] = *(const PG8_LAS bf16x8*)(lds + PG8_SA(b, h) + aoff + m * 2048 + k * 1024); } while (0)
#define PG8_LDB(dst, b, h) do { _Pragma("unroll") for (int n = 0; n < 2; ++n) _Pragma("unroll") for (int k = 0; k < 2; ++k) dst[n][k] = *(const PG8_LAS bf16x8*)(lds + PG8_SB(b, h) + boff + n * 2048 + k * 1024); } while (0)
#define PG8_MMA(ai, bj, At, Bt) do { __builtin_amdgcn_s_setprio(1); _Pragma("unroll") for (int m = 0; m < 4; ++m) _Pragma("unroll") for (int n = 0; n < 2; ++n) _Pragma("unroll") for (int k = 0; k < 2; ++k) \
        acc[ai][bj][m][n] = __builtin_amdgcn_mfma_f32_16x16x32_bf16(Bt[n][k], At[m][k], acc[ai][bj][m][n], 0, 0, 0); __builtin_amdgcn_s_setprio(0); } while (0)
#define PG8_WAIT_V(n) asm volatile("s_waitcnt vmcnt(" #n ")" ::: "memory")
#define PG8_WAIT_L(n) asm volatile("s_waitcnt lgkmcnt(" #n ")" ::: "memory")
#define PG8_BAR __builtin_amdgcn_s_barrier()
#define PG8_SCHED __builtin_amdgcn_sched_barrier(0)
    Unit cur, nxt; int ui = 0;
    if (!S.next(0, cur)) return;
    f32x4 acc[2][2][4][2];
#pragma unroll
    for (int a = 0; a < 2; ++a)
#pragma unroll
        for (int b = 0; b < 2; ++b)
#pragma unroll
            for (int m = 0; m < 4; ++m)
#pragma unroll
                for (int n = 0; n < 2; ++n) acc[a][b][m][n] = (f32x4){0.f, 0.f, 0.f, 0.f};
    bf16x8 At[4][2], B0[2][2], B1[2][2];
    const char* cA = (const char*)g.A + (size_t)cur.pm * tstep; const char* cB = (const char*)g.Bt + (size_t)cur.pn * tstep;
    S.a_ready(cur);
    if constexpr (SP2) {
        PG8_STAGE(PG8_SB(0, 0), cB, voffB); PG8_STAGE(PG8_SB(0, 1), cB + hstep, voffB); PG8_STAGE(PG8_SA(0, 0), cA, voffA); PG8_STAGE(PG8_SA(0, 1), cA + hstep, voffA);
        if (wr == 1) PG8_BAR;
        PG8_WAIT_V(2); PG8_BAR;
        PG8_STAGE(PG8_SB(1, 0), cB + kstep, voffB); PG8_STAGE(PG8_SA(1, 0), cA + kstep, voffA); PG8_STAGE(PG8_SB(1, 1), cB + hstep + kstep, voffB);
        PG8_WAIT_V(6); PG8_BAR;
    } else {
        PG8_STAGE(PG8_SB(0, 0), cB, voffB); PG8_STAGE(PG8_SA(0, 0), cA, voffA); PG8_STAGE(PG8_SB(0, 1), cB + hstep, voffB); PG8_STAGE(PG8_SA(0, 1), cA + hstep, voffA);
        if (wr == 1) PG8_BAR;
        PG8_WAIT_V(4); PG8_BAR;
        PG8_STAGE(PG8_SB(1, 0), cB + kstep, voffB); PG8_STAGE(PG8_SA(1, 0), cA + kstep, voffA); PG8_STAGE(PG8_SB(1, 1), cB + hstep + kstep, voffB);
        PG8_WAIT_V(6); PG8_BAR;
    }
    for (;;) {
        const bool has_next = S.next(ui + 1, nxt);
        const char* nA = has_next ? (const char*)g.A + (size_t)nxt.pm * tstep : cA; const char* nB = has_next ? (const char*)g.Bt + (size_t)nxt.pn * tstep : cB;
        for (int t = 0; t < nt; t += 2) {
            const bool last = (t == nt - 2);
            const char* a1 = cA + (size_t)(t + 1) * kstep;
            const char* a2 = last ? nA : cA + (size_t)(t + 2) * kstep; const char* b2 = last ? nB : cB + (size_t)(t + 2) * kstep;
            const char* a3 = a2 + kstep; const char* b3 = b2 + kstep;
            if (last && has_next) S.a_ready(nxt);
            if constexpr (Epi::HAS_MID) { if (t == Epi::MID_T) { PG8_SCHED; E.mid(acc, wr, fr, lds); PG8_SCHED; } }
            if constexpr (SP2) {
            PG8_LDB(B0, 0, 0); PG8_LDB(B1, 0, 1); PG8_SCHED; PG8_LDA(At, 0, 0); PG8_STAGE(PG8_SA(1, 1), a1 + hstep, voffA);
            PG8_WAIT_V(8); PG8_WAIT_L(0); PG8_BAR; PG8_MMA(0, 0, At, B0); PG8_MMA(0, 1, At, B1); PG8_BAR; PG8_SCHED;
            PG8_LDA(At, 0, 1); PG8_STAGE(PG8_SB(0, 0), b2, voffB); PG8_STAGE(PG8_SB(0, 1), b2 + hstep, voffB); PG8_STAGE(PG8_SA(0, 0), a2, voffA);
            PG8_WAIT_V(8); PG8_WAIT_L(0); PG8_BAR; PG8_MMA(1, 0, At, B0); PG8_MMA(1, 1, At, B1); PG8_BAR; PG8_SCHED;
            PG8_LDB(B0, 1, 0); PG8_LDB(B1, 1, 1); PG8_SCHED; PG8_LDA(At, 1, 0); PG8_STAGE(PG8_SA(0, 1), a2 + hstep, voffA);
            PG8_WAIT_V(8); PG8_WAIT_L(0); PG8_BAR; PG8_MMA(0, 0, At, B0); PG8_MMA(0, 1, At, B1); PG8_BAR; PG8_SCHED;
            PG8_LDA(At, 1, 1); PG8_STAGE(PG8_SB(1, 0), b3, voffB); PG8_STAGE(PG8_SB(1, 1), b3 + hstep, voffB); PG8_STAGE(PG8_SA(1, 0), a3, voffA);
            PG8_WAIT_V(8); PG8_WAIT_L(0); PG8_BAR; PG8_MMA(1, 0, At, B0); PG8_MMA(1, 1, At, B1); PG8_BAR; PG8_SCHED;
            } else {
            PG8_LDB(B0, 0, 0); PG8_SCHED; PG8_LDA(At, 0, 0); PG8_STAGE(PG8_SA(1, 1), a1 + hstep, voffA);
            PG8_WAIT_L(8); PG8_BAR; PG8_WAIT_L(0); PG8_MMA(0, 0, At, B0); PG8_BAR; PG8_SCHED;
            PG8_LDB(B1, 0, 1); PG8_STAGE(PG8_SB(0, 0), b2, voffB);
            PG8_BAR; PG8_WAIT_L(0); PG8_MMA(0, 1, At, B1); PG8_BAR;
            PG8_LDA(At, 0, 1); PG8_STAGE(PG8_SA(0, 0), a2, voffA);
            PG8_BAR; PG8_WAIT_L(0); PG8_MMA(1, 0, At, B0); PG8_BAR; PG8_SCHED;
            PG8_STAGE(PG8_SB(0, 1), b2 + hstep, voffB);
            PG8_WAIT_V(6); PG8_BAR; PG8_MMA(1, 1, At, B1); PG8_BAR;
            PG8_LDB(B0, 1, 0); PG8_SCHED; PG8_LDA(At, 1, 0); PG8_STAGE(PG8_SA(0, 1), a2 + hstep, voffA);
            PG8_WAIT_L(8); PG8_BAR; PG8_WAIT_L(0); PG8_MMA(0, 0, At, B0); PG8_BAR; PG8_SCHED;
            PG8_LDB(B1, 1, 1); PG8_STAGE(PG8_SB(1, 0), b3, voffB);
            PG8_BAR; PG8_WAIT_L(0); PG8_MMA(0, 1, At, B1); PG8_BAR;
            PG8_LDA(At, 1, 1); PG8_STAGE(PG8_SA(1, 0), a3, voffA);
            PG8_BAR; PG8_WAIT_L(0); PG8_MMA(1, 0, At, B0); PG8_BAR; PG8_SCHED;
            PG8_STAGE(PG8_SB(1, 1), b3 + hstep, voffB);
            PG8_WAIT_V(6); PG8_BAR; PG8_MMA(1, 1, At, B1); PG8_BAR;
            }
        }
        if constexpr (ALIGN_EPI) { if (wr == 0) PG8_BAR; }
        if constexpr (Epi::FUSE_LAST) { if (has_next || !E.fused_unit(cur)) E(acc, cur, wr, wc, fr, fq); S.done(cur); }
        else if constexpr (!Epi::AFTER_DRAIN) { E(acc, cur, wr, wc, fr, fq); S.done(cur); }
        if (!has_next) break;
#pragma unroll
        for (int a = 0; a < 2; ++a)
#pragma unroll
            for (int b = 0; b < 2; ++b)
#pragma unroll
                for (int m = 0; m < 4; ++m)
#pragma unroll
                    for (int n = 0; n < 2; ++n) acc[a][b][m][n] = (f32x4){0.f, 0.f, 0.f, 0.f};
        cur = nxt; cA = nA; cB = nB; ++ui;
        if constexpr (ALIGN_EPI) { if (wr == 1) PG8_BAR; }
    }
    PG8_WAIT_V(0);
    if constexpr (!ALIGN_EPI) { if (wr == 0) PG8_BAR; }
    PG8_BAR;
    if constexpr (Epi::FUSE_LAST) { if (E.fused_unit(cur)) E.fused(acc, cur, wr, wc, fr, fq, lds, wid, lane); }
    else if constexpr (Epi::AFTER_DRAIN) { E.fused(acc, cur, wr, wc, fr, fq, lds, wid, lane); S.done(cur); }
#undef PG8_SA
#undef PG8_SB
#undef PG8_STAGE
#undef PG8_LDA
#undef PG8_LDB
#undef PG8_MMA
#undef PG8_WAIT_V
#undef PG8_WAIT_L
#undef PG8_BAR
#undef PG8_SCHED
}
}


namespace att {
typedef short bf16x8 __attribute__((ext_vector_type(8)));
typedef float f32x16 __attribute__((ext_vector_type(16)));
typedef float f32x2_t __attribute__((ext_vector_type(2))); typedef __bf16 bf16x2_t __attribute__((ext_vector_type(2)));
DI unsigned cvtpk(float lo, float hi) { f32x2_t v = {lo, hi}; bf16x2_t b = __builtin_convertvector(v, bf16x2_t); return __builtin_bit_cast(unsigned, b); }
DI void glds16(const void* gsrc, unsigned lds_dst) { unsigned keep;
    asm volatile("s_mov_b32 %0, m0\n\ts_mov_b32 m0, %2\n\ts_nop 0\n\tglobal_load_lds_dwordx4 %1, off\n\ts_mov_b32 m0, %0" : "=&s"(keep) : "v"(gsrc), "s"(lds_dst) : "memory"); }
constexpr int SLOTB = 20480, KBYTES = 12288, VBYTES = 8192;
#define MFMA32(a, b, c) __builtin_amdgcn_mfma_f32_32x32x16_bf16((a), (b), (c), 0, 0, 0)
DI void attn_epi64(const Ptrs& p, const f32x16& o0, const f32x16& o1, float lsum, int bh, int q0, int lane) {
    const int r = lane & 31, h = lane >> 5;
    lsum += __shfl_xor(lsum, 32);
    const float rl = __builtin_amdgcn_rcpf(lsum);
    const int b = bh >> 3, hd = bh & 7, t = b * SEQ + q0 + r;
    const bf16_t* Z = (const bf16_t*)(p.ws + WS_Z) + (size_t)t * 2048 + hd * 64 + 4 * h;
    bf16_t* A = (bf16_t*)(p.ws + WS_AMIX) + (size_t)t * 1024 + hd * 64 + 4 * h;
    float sq = 0.f;
    uint2 zld[2][4];
#pragma unroll
    for (int dt = 0; dt < 2; ++dt)
#pragma unroll
        for (int g = 0; g < 4; ++g) zld[dt][g] = *(const uint2*)(Z + 32 * dt + 8 * g);
#pragma unroll
    for (int dt = 0; dt < 2; ++dt)
#pragma unroll
        for (int g = 0; g < 4; ++g) {
            const uint2 zz2 = zld[dt][g];
            float ov[4];
#pragma unroll
            for (int e = 0; e < 4; ++e) { ov[e] = (dt ? o1[4 * g + e] : o0[4 * g + e]) * rl; sq += ov[e] * ov[e]; }
            const float z0 = __uint_as_float(zz2.x << 16), z1 = __uint_as_float(zz2.x & 0xffff0000u), z2 = __uint_as_float(zz2.y << 16), z3 = __uint_as_float(zz2.y & 0xffff0000u);
            uint2 w; w.x = cvtpk(ov[0] * silu(z0), ov[1] * silu(z1)); w.y = cvtpk(ov[2] * silu(z2), ov[3] * silu(z3));
            *(uint2*)(A + 32 * dt + 8 * g) = w;
        }
    sq += __shfl_xor(sq, 32);
    if (h == 0) ((float*)(p.ws + WS_SSQA))[(size_t)hd * T + t] = sq;
}
DI void attn_unit64(LAS unsigned char* lds, const Ptrs& p, int bh, int qb512, int wid, int lane) {
    const unsigned lds0 = (unsigned)(uintptr_t)lds;
    const unsigned char* Kg = p.ws + WS_KIMG + (size_t)bh * 64 * KBYTES + lane * 16;
    const unsigned char* Vg = p.ws + WS_VIMG + (size_t)bh * 64 * VBYTES + lane * 16;
    const bf16x8* Qg = (const bf16x8*)(p.ws + WS_QIMG + ((size_t)(bh * 128 + qb512 * 16 + 2 * wid) * 6 * 64 + lane) * 16);
    bf16x8 qa[6], qb[6];
#pragma unroll
    for (int kk = 0; kk < 6; ++kk) { qa[kk] = Qg[kk * 64]; qb[kk] = Qg[(6 + kk) * 64]; }
#define ATT_DMA(t, slotoff) do { const unsigned char* kt_ = Kg + (size_t)(t) * KBYTES; const unsigned char* vt_ = Vg + (size_t)(t) * VBYTES; \
        glds16(kt_ + wid * 1024, (unsigned)__builtin_amdgcn_readfirstlane(lds0 + (slotoff) + wid * 1024)); \
        if (wid < 4) { glds16(kt_ + (wid + 8) * 1024, (unsigned)__builtin_amdgcn_readfirstlane(lds0 + (slotoff) + (wid + 8) * 1024)); \
                       glds16(vt_ + (wid + 4) * 1024, (unsigned)__builtin_amdgcn_readfirstlane(lds0 + (slotoff) + KBYTES + (wid + 4) * 1024)); } \
        else glds16(vt_ + (wid - 4) * 1024, (unsigned)__builtin_amdgcn_readfirstlane(lds0 + (slotoff) + KBYTES + (wid - 4) * 1024)); } while (0)
#define ATT_WAIT_MINE() do { if (wid < 4) asm volatile("s_waitcnt vmcnt(3) lgkmcnt(0)\n\ts_barrier" ::: "memory"); else asm volatile("s_waitcnt vmcnt(2) lgkmcnt(0)\n\ts_barrier" ::: "memory"); } while (0)
#define ATT_WAIT_ALL() asm volatile("s_waitcnt vmcnt(0) lgkmcnt(0)\n\ts_barrier" ::: "memory")
#define SBAR() __builtin_amdgcn_sched_barrier(0)
#define EX(v) __builtin_amdgcn_exp2f(v)
#define LD(ptr) (*(const LAS bf16x8*)(ptr))
#define MF(a, b, c) MFMA32((a), (b), (c))
    ATT_DMA(0, 0); ATT_DMA(1, SLOTB); ATT_DMA(2, 2 * SLOTB); ATT_DMA(3, 3 * SLOTB);
    ATT_WAIT_ALL();
    f32x16 OA0, OA1, OB0, OB1, SA0, SA1, SB0, SB1, zz;
#pragma unroll
    for (int i = 0; i < 16; ++i) { OA0[i] = 0.f; OA1[i] = 0.f; OB0[i] = 0.f; OB1[i] = 0.f; zz[i] = 0.f; }
    float lsA = 0.f, lsB = 0.f;
    uint4 pA0_0, pA0_1, pA1_0, pA1_1, pB0_0, pB0_1, pB1_0, pB1_1;
    bf16x8 fr0, fr1, fr2, fr3;
    {
        const LAS unsigned char* kp0 = lds + lane * 16;
        SA0 = zz; SA1 = zz; SB0 = zz; SB1 = zz;
#pragma unroll
        for (int kk = 0; kk < 6; ++kk) { const bf16x8 k0 = LD(kp0 + (2 * kk) * 1024), k1 = LD(kp0 + (2 * kk + 1) * 1024);
            SA0 = MFMA32(k0, qa[kk], SA0); SA1 = MFMA32(k1, qa[kk], SA1); SB0 = MFMA32(k0, qb[kk], SB0); SB1 = MFMA32(k1, qb[kk], SB1); }
#pragma unroll
        for (int i = 0; i < 16; ++i) { SA0[i] = EX(SA0[i]); SB0[i] = EX(SB0[i]); lsA += SA0[i]; lsB += SB0[i]; }
        pA0_0 = make_uint4(cvtpk(SA0[0], SA0[1]), cvtpk(SA0[2], SA0[3]), cvtpk(SA0[4], SA0[5]), cvtpk(SA0[6], SA0[7]));
        pA0_1 = make_uint4(cvtpk(SA0[8], SA0[9]), cvtpk(SA0[10], SA0[11]), cvtpk(SA0[12], SA0[13]), cvtpk(SA0[14], SA0[15]));
        pB0_0 = make_uint4(cvtpk(SB0[0], SB0[1]), cvtpk(SB0[2], SB0[3]), cvtpk(SB0[4], SB0[5]), cvtpk(SB0[6], SB0[7]));
        pB0_1 = make_uint4(cvtpk(SB0[8], SB0[9]), cvtpk(SB0[10], SB0[11]), cvtpk(SB0[12], SB0[13]), cvtpk(SB0[14], SB0[15]));
        fr0 = LD(kp0 + SLOTB + 0 * 1024); fr1 = LD(kp0 + SLOTB + 2 * 1024);
        pA1_0 = pA0_0; pA1_1 = pA0_1; pB1_0 = pB0_0; pB1_1 = pB0_1; fr2 = fr0; fr3 = fr1;
    }
    int off_v = 0, off_k1 = SLOTB, off_k2 = 2 * SLOTB, off_d = 4 * SLOTB, off_d2 = 5 * SLOTB;
#define A64H_STEP(LAST, ODD) do { \
        if (!(ODD)) { if (t + 4 < 64) ATT_DMA(t + 4, off_d); if (t + 5 < 64) ATT_DMA(t + 5, off_d2); } \
        const LAS unsigned char* vp_ = lds + off_v + KBYTES + lane * 16; const LAS unsigned char* kp_ = lds + off_k1 + lane * 16; const LAS unsigned char* kn_ = lds + off_k2 + lane * 16; \
        float la_ = 0.f, lb_ = 0.f; SBAR(); \
        if (!(LAST)) SA0 = MF(fr0, qa[0], zz); fr2 = LD(kp_ + 4096); SA1[0] = EX(SA1[0]); SA1[1] = EX(SA1[1]); SA1[2] = EX(SA1[2]); SBAR(); \
        if (!(LAST)) SB0 = MF(fr0, qb[0], zz); SA1[3] = EX(SA1[3]); SA1[4] = EX(SA1[4]); SA1[5] = EX(SA1[5]); SBAR(); \
        if (!(LAST)) SA0 = MF(fr1, qa[1], SA0); fr3 = LD(kp_ + 6144); SA1[6] = EX(SA1[6]); SA1[7] = EX(SA1[7]); SA1[8] = EX(SA1[8]); SBAR(); \
        if (!(LAST)) SB0 = MF(fr1, qb[1], SB0); SA1[9] = EX(SA1[9]); SA1[10] = EX(SA1[10]); SA1[11] = EX(SA1[11]); SBAR(); \
        if (!(LAST)) SA0 = MF(fr2, qa[2], SA0); fr0 = LD(kp_ + 8192); SA1[12] = EX(SA1[12]); SA1[13] = EX(SA1[13]); SA1[14] = EX(SA1[14]); SBAR(); \
        if (!(LAST)) SB0 = MF(fr2, qb[2], SB0); SA1[15] = EX(SA1[15]); SB1[0] = EX(SB1[0]); SB1[1] = EX(SB1[1]); SBAR(); \
        if (!(LAST)) SA0 = MF(fr3, qa[3], SA0); fr1 = LD(kp_ + 10240); SB1[2] = EX(SB1[2]); SB1[3] = EX(SB1[3]); SB1[4] = EX(SB1[4]); SBAR(); \
        if (!(LAST)) SB0 = MF(fr3, qb[3], SB0); SB1[5] = EX(SB1[5]); SB1[6] = EX(SB1[6]); SB1[7] = EX(SB1[7]); SBAR(); \
        if (!(LAST)) SA0 = MF(fr0, qa[4], SA0); fr2 = LD(vp_ + 0); SB1[8] = EX(SB1[8]); SB1[9] = EX(SB1[9]); SBAR(); \
        if (!(LAST)) SB0 = MF(fr0, qb[4], SB0); SB1[10] = EX(SB1[10]); SB1[11] = EX(SB1[11]); SBAR(); \
        if (!(LAST)) SA0 = MF(fr1, qa[5], SA0); fr3 = LD(vp_ + 1024); SB1[12] = EX(SB1[12]); SB1[13] = EX(SB1[13]); SBAR(); \
        if (!(LAST)) SB0 = MF(fr1, qb[5], SB0); SB1[14] = EX(SB1[14]); SB1[15] = EX(SB1[15]); SBAR(); \
        OA0 = MF(fr2, __builtin_bit_cast(bf16x8, pA0_0), OA0); fr0 = LD(vp_ + 2048); pA1_0.x = cvtpk(SA1[0], SA1[1]); pA1_0.y = cvtpk(SA1[2], SA1[3]); la_ += SA1[0]; la_ += SA1[1]; la_ += SA1[2]; la_ += SA1[3]; asm volatile("" : "+v"(la_), "+v"(lb_)); SBAR(); \
        OB0 = MF(fr2, __builtin_bit_cast(bf16x8, pB0_0), OB0); pA1_0.z = cvtpk(SA1[4], SA1[5]); pA1_0.w = cvtpk(SA1[6], SA1[7]); la_ += SA1[4]; la_ += SA1[5]; la_ += SA1[6]; la_ += SA1[7]; asm volatile("" : "+v"(la_), "+v"(lb_)); SBAR(); \
        OA1 = MF(fr3, __builtin_bit_cast(bf16x8, pA0_0), OA1); fr1 = LD(vp_ + 3072); pA1_1.x = cvtpk(SA1[8], SA1[9]); pA1_1.y = cvtpk(SA1[10], SA1[11]); la_ += SA1[8]; la_ += SA1[9]; la_ += SA1[10]; la_ += SA1[11]; asm volatile("" : "+v"(la_), "+v"(lb_)); SBAR(); \
        OB1 = MF(fr3, __builtin_bit_cast(bf16x8, pB0_0), OB1); pA1_1.z = cvtpk(SA1[12], SA1[13]); pA1_1.w = cvtpk(SA1[14], SA1[15]); la_ += SA1[12]; la_ += SA1[13]; la_ += SA1[14]; la_ += SA1[15]; asm volatile("" : "+v"(la_), "+v"(lb_)); SBAR(); \
        OA0 = MF(fr0, __builtin_bit_cast(bf16x8, pA0_1), OA0); fr2 = LD(kp_ + 1024); pB1_0.x = cvtpk(SB1[0], SB1[1]); pB1_0.y = cvtpk(SB1[2], SB1[3]); lb_ += SB1[0]; lb_ += SB1[1]; lb_ += SB1[2]; lb_ += SB1[3]; asm volatile("" : "+v"(la_), "+v"(lb_)); SBAR(); \
        OB0 = MF(fr0, __builtin_bit_cast(bf16x8, pB0_1), OB0); pB1_0.z = cvtpk(SB1[4], SB1[5]); pB1_0.w = cvtpk(SB1[6], SB1[7]); lb_ += SB1[4]; lb_ += SB1[5]; lb_ += SB1[6]; lb_ += SB1[7]; asm volatile("" : "+v"(la_), "+v"(lb_)); SBAR(); \
        OA1 = MF(fr1, __builtin_bit_cast(bf16x8, pA0_1), OA1); fr3 = LD(kp_ + 3072); pB1_1.x = cvtpk(SB1[8], SB1[9]); pB1_1.y = cvtpk(SB1[10], SB1[11]); lb_ += SB1[8]; lb_ += SB1[9]; lb_ += SB1[10]; lb_ += SB1[11]; asm volatile("" : "+v"(la_), "+v"(lb_)); SBAR(); \
        OB1 = MF(fr1, __builtin_bit_cast(bf16x8, pB0_1), OB1); pB1_1.z = cvtpk(SB1[12], SB1[13]); pB1_1.w = cvtpk(SB1[14], SB1[15]); lb_ += SB1[12]; lb_ += SB1[13]; lb_ += SB1[14]; lb_ += SB1[15]; asm volatile("" : "+v"(la_), "+v"(lb_)); SBAR(); \
        if (!(LAST)) SA1 = MF(fr2, qa[0], zz); fr0 = LD(kp_ + 5120); if (!(LAST)) { SA0[0] = EX(SA0[0]); SA0[1] = EX(SA0[1]); SA0[2] = EX(SA0[2]); } SBAR(); \
        if (!(LAST)) SB1 = MF(fr2, qb[0], zz); if (!(LAST)) { SA0[3] = EX(SA0[3]); SA0[4] = EX(SA0[4]); SA0[5] = EX(SA0[5]); } SBAR(); \
        if (!(LAST)) SA1 = MF(fr3, qa[1], SA1); fr1 = LD(kp_ + 7168); if (!(LAST)) { SA0[6] = EX(SA0[6]); SA0[7] = EX(SA0[7]); SA0[8] = EX(SA0[8]); } SBAR(); \
        if (!(LAST)) SB1 = MF(fr3, qb[1], SB1); if (!(LAST)) { SA0[9] = EX(SA0[9]); SA0[10] = EX(SA0[10]); SA0[11] = EX(SA0[11]); } SBAR(); \
        if (!(LAST)) SA1 = MF(fr0, qa[2], SA1); fr2 = LD(kp_ + 9216); if (!(LAST)) { SA0[12] = EX(SA0[12]); SA0[13] = EX(SA0[13]); SA0[14] = EX(SA0[14]); } SBAR(); \
        if (!(LAST)) SB1 = MF(fr0, qb[2], SB1); if (!(LAST)) { SA0[15] = EX(SA0[15]); SB0[0] = EX(SB0[0]); SB0[1] = EX(SB0[1]); } SBAR(); \
        if (!(LAST)) SA1 = MF(fr1, qa[3], SA1); fr3 = LD(kp_ + 11264); if (!(LAST)) { SB0[2] = EX(SB0[2]); SB0[3] = EX(SB0[3]); SB0[4] = EX(SB0[4]); } SBAR(); \
        if (!(LAST)) SB1 = MF(fr1, qb[3], SB1); if (!(LAST)) { SB0[5] = EX(SB0[5]); SB0[6] = EX(SB0[6]); SB0[7] = EX(SB0[7]); } SBAR(); \
        if (!(LAST)) SA1 = MF(fr2, qa[4], SA1); fr0 = LD(vp_ + 4096); if (!(LAST)) { SB0[8] = EX(SB0[8]); SB0[9] = EX(SB0[9]); } SBAR(); \
        if (!(LAST)) SB1 = MF(fr2, qb[4], SB1); if (!(LAST)) { SB0[10] = EX(SB0[10]); SB0[11] = EX(SB0[11]); } SBAR(); \
        if (!(LAST)) SA1 = MF(fr3, qa[5], SA1); fr1 = LD(vp_ + 5120); if (!(LAST)) { SB0[12] = EX(SB0[12]); SB0[13] = EX(SB0[13]); } SBAR(); \
        if (!(LAST)) SB1 = MF(fr3, qb[5], SB1); if (!(LAST)) { SB0[14] = EX(SB0[14]); SB0[15] = EX(SB0[15]); } SBAR(); \
        OA0 = MF(fr0, __builtin_bit_cast(bf16x8, pA1_0), OA0); fr2 = LD(vp_ + 6144); if (!(LAST)) { pA0_0.x = cvtpk(SA0[0], SA0[1]); pA0_0.y = cvtpk(SA0[2], SA0[3]); la_ += SA0[0]; la_ += SA0[1]; la_ += SA0[2]; la_ += SA0[3]; asm volatile("" : "+v"(la_), "+v"(lb_), "+v"(pA0_0.x), "+v"(pA0_0.y)); } SBAR(); \
        OB0 = MF(fr0, __builtin_bit_cast(bf16x8, pB1_0), OB0); if (!(LAST)) { pA0_0.z = cvtpk(SA0[4], SA0[5]); pA0_0.w = cvtpk(SA0[6], SA0[7]); la_ += SA0[4]; la_ += SA0[5]; la_ += SA0[6]; la_ += SA0[7]; asm volatile("" : "+v"(la_), "+v"(lb_), "+v"(pA0_0.z), "+v"(pA0_0.w)); } SBAR(); \
        OA1 = MF(fr1, __builtin_bit_cast(bf16x8, pA1_0), OA1); fr3 = LD(vp_ + 7168); if (!(LAST)) { pA0_1.x = cvtpk(SA0[8], SA0[9]); pA0_1.y = cvtpk(SA0[10], SA0[11]); la_ += SA0[8]; la_ += SA0[9]; la_ += SA0[10]; la_ += SA0[11]; asm volatile("" : "+v"(la_), "+v"(lb_), "+v"(pA0_1.x), "+v"(pA0_1.y)); } SBAR(); \
        OB1 = MF(fr1, __builtin_bit_cast(bf16x8, pB1_0), OB1); if (!(LAST)) { pA0_1.z = cvtpk(SA0[12], SA0[13]); pA0_1.w = cvtpk(SA0[14], SA0[15]); la_ += SA0[12]; la_ += SA0[13]; la_ += SA0[14]; la_ += SA0[15]; asm volatile("" : "+v"(la_), "+v"(lb_), "+v"(pA0_1.z), "+v"(pA0_1.w)); } SBAR(); \
        OA0 = MF(fr2, __builtin_bit_cast(bf16x8, pA1_1), OA0); if (!(LAST) || 20 < 20) fr0 = LD(kn_ + 0); if (!(LAST)) { pB0_0.x = cvtpk(SB0[0], SB0[1]); pB0_0.y = cvtpk(SB0[2], SB0[3]); lb_ += SB0[0]; lb_ += SB0[1]; lb_ += SB0[2]; lb_ += SB0[3]; asm volatile("" : "+v"(la_), "+v"(lb_), "+v"(pB0_0.x), "+v"(pB0_0.y)); } SBAR(); \
        OB0 = MF(fr2, __builtin_bit_cast(bf16x8, pB1_1), OB0); if (!(LAST)) { pB0_0.z = cvtpk(SB0[4], SB0[5]); pB0_0.w = cvtpk(SB0[6], SB0[7]); lb_ += SB0[4]; lb_ += SB0[5]; lb_ += SB0[6]; lb_ += SB0[7]; asm volatile("" : "+v"(la_), "+v"(lb_), "+v"(pB0_0.z), "+v"(pB0_0.w)); } SBAR(); \
        OA1 = MF(fr3, __builtin_bit_cast(bf16x8, pA1_1), OA1); if (!(LAST) || 21 < 20) fr1 = LD(kn_ + 2048); if (!(LAST)) { pB0_1.x = cvtpk(SB0[8], SB0[9]); pB0_1.y = cvtpk(SB0[10], SB0[11]); lb_ += SB0[8]; lb_ += SB0[9]; lb_ += SB0[10]; lb_ += SB0[11]; asm volatile("" : "+v"(la_), "+v"(lb_), "+v"(pB0_1.x), "+v"(pB0_1.y)); } SBAR(); \
        OB1 = MF(fr3, __builtin_bit_cast(bf16x8, pB1_1), OB1); if (!(LAST)) { pB0_1.z = cvtpk(SB0[12], SB0[13]); pB0_1.w = cvtpk(SB0[14], SB0[15]); lb_ += SB0[12]; lb_ += SB0[13]; lb_ += SB0[14]; lb_ += SB0[15]; asm volatile("" : "+v"(la_), "+v"(lb_), "+v"(pB0_1.z), "+v"(pB0_1.w)); } SBAR(); \
        lsA += la_; lsB += lb_; \
        if (ODD) ATT_WAIT_ALL(); \
        off_v = off_k1; off_k1 = off_k2; off_k2 = (off_k2 == 5 * SLOTB) ? 0 : off_k2 + SLOTB; off_d = off_d2; off_d2 = (off_d2 == 5 * SLOTB) ? 0 : off_d2 + SLOTB; \
    } while (0)
    int t = 0;
    for (; t < 62; t += 2) { A64H_STEP(false, false); A64H_STEP(false, true); }
    A64H_STEP(false, false); A64H_STEP(true, true);
    const int q0 = qb512 * 512 + wid * 64;
    attn_epi64(p, OA0, OA1, lsA, bh, q0, lane);
    attn_epi64(p, OB0, OB1, lsB, bh, q0 + 32, lane);
    asm volatile("s_waitcnt vmcnt(0) lgkmcnt(0)\n\ts_barrier" ::: "memory");
#undef ATT_DMA
#undef ATT_WAIT_MINE
#undef ATT_WAIT_ALL
#undef A64H_STEP
#undef SBAR
#undef EX
#undef LD
#undef MF
}
DI void attn_phase64(LAS unsigned char* lds, const Ptrs& p, int vcu, int G) {
    const int lane = threadIdx.x & 63, wid = __builtin_amdgcn_readfirstlane(threadIdx.x >> 6);
    for (int U = vcu; U < 256; U += G) attn_unit64(lds, p, U >> 3, U & 7, wid, lane);
}
}


namespace p2 {
typedef short bf16x8 __attribute__((ext_vector_type(8)));
typedef short s16x4 __attribute__((ext_vector_type(4)));
typedef unsigned u32x4v __attribute__((ext_vector_type(4)));
typedef float f32x16 __attribute__((ext_vector_type(16)));
using att::cvtpk; using att::glds16;
DI int crow(int i, int h) { return (i & 3) + 8 * (i >> 2) + 4 * h; }
DI float lo16(unsigned u) { return __uint_as_float(u << 16); }
DI float hi16(unsigned u) { return __uint_as_float(u & 0xffff0000u); }
DI float frag_ssq(const bf16x8& f) { const uint4 u = __builtin_bit_cast(uint4, f); float s = 0.f;
    s += lo16(u.x) * lo16(u.x) + hi16(u.x) * hi16(u.x); s += lo16(u.y) * lo16(u.y) + hi16(u.y) * hi16(u.y);
    s += lo16(u.z) * lo16(u.z) + hi16(u.z) * hi16(u.z); s += lo16(u.w) * lo16(u.w) + hi16(u.w) * hi16(u.w); return s; }
DI bf16x8 frag_scale(const bf16x8& f, float sc) { const uint4 u = __builtin_bit_cast(uint4, f); uint4 o;
    o.x = cvtpk(lo16(u.x) * sc, hi16(u.x) * sc); o.y = cvtpk(lo16(u.y) * sc, hi16(u.y) * sc); o.z = cvtpk(lo16(u.z) * sc, hi16(u.z) * sc); o.w = cvtpk(lo16(u.w) * sc, hi16(u.w) * sc);
    return __builtin_bit_cast(bf16x8, o); }
DI uint4 pack8(const f32x16& a, int g, float sc, const float (&gv)[16]) {
    float v[8];
#pragma unroll
    for (int j = 0; j < 8; ++j) v[j] = a[8 * g + j] * sc * gv[8 * g + j];
    uint4 o; o.x = cvtpk(v[0], v[1]); o.y = cvtpk(v[2], v[3]); o.z = cvtpk(v[4], v[5]); o.w = cvtpk(v[6], v[7]); return o;
}
DI uint4 pack8n(const f32x16& a, int g, float sc) {
    uint4 o; o.x = cvtpk(a[8 * g + 0] * sc, a[8 * g + 1] * sc); o.y = cvtpk(a[8 * g + 2] * sc, a[8 * g + 3] * sc); o.z = cvtpk(a[8 * g + 4] * sc, a[8 * g + 5] * sc); o.w = cvtpk(a[8 * g + 6] * sc, a[8 * g + 7] * sc); return o;
}
DI s16x4 vtr(const LAS unsigned char* q) { return __builtin_bit_cast(s16x4, __builtin_amdgcn_ds_read_tr16_b64_v4i16((LAS s16x4*)q)); }
DI void glds16s(const void* sbase, unsigned voff, unsigned lds_dst) { unsigned keep;
    asm volatile("s_mov_b32 %0, m0\n\ts_mov_b32 m0, %3\n\ts_nop 0\n\tglobal_load_lds_dwordx4 %1, %2\n\ts_mov_b32 m0, %0" : "=&s"(keep) : "v"(voff), "s"(sbase), "s"(lds_dst) : "memory"); }
template <int NP8> DI void dma_copy(const unsigned char* gsrc, unsigned lds_dst, int wid, int lane) {
    const unsigned voff = (unsigned)(wid * 1024 + lane * 16);
#pragma unroll
    for (int i = 0; i < NP8; ++i) glds16s(gsrc + (size_t)i * 8192, voff, (unsigned)__builtin_amdgcn_readfirstlane(lds_dst + (i * 8 + wid) * 1024));
}
#define P2_BAR_V(N) asm volatile("s_waitcnt vmcnt(" #N ") lgkmcnt(0)\n\ts_barrier" ::: "memory")

DI void q_head(const Ptrs& p, const LAS unsigned char* wb, const bf16x8 (&cf)[16], float rq, const float (&cs)[8], const float (&sn)[8], int bh, int qblk, int lane) {
    const int h = lane >> 5;
    f32x16 acc[3];
#pragma unroll
    for (int nt = 0; nt < 3; ++nt) {
#pragma unroll
        for (int i = 0; i < 16; ++i) acc[nt][i] = 0.f;
#pragma unroll
        for (int ks = 0; ks < 16; ++ks) acc[nt] = MFMA32(*(const LAS bf16x8*)(wb + (nt * 16 + ks) * 1024 + lane * 16), cf[ks], acc[nt]);
    }
#pragma unroll
    for (int nt = 0; nt < 3; ++nt)
#pragma unroll
        for (int i = 0; i < 16; ++i) acc[nt][i] *= rq;
#pragma unroll
    for (int i = 0; i < 8; ++i) { const float a = acc[2][i], bb = acc[2][i + 8]; acc[2][i] = a * cs[i] - bb * sn[i]; acc[2][i + 8] = bb * cs[i] + a * sn[i]; }
    float sh = 0.f;
#pragma unroll
    for (int nt = 0; nt < 3; ++nt)
#pragma unroll
        for (int i = 0; i < 16; ++i) sh += acc[nt][i] * acc[nt][i];
    sh += __shfl_xor(sh, 32);
    const float rh = QSCALE * rsqrt_fast(sh * (1.f / 96.f) + EPS);
    uint4* dst = (uint4*)(p.ws + WS_QIMG) + ((size_t)(bh * 128 + qblk) * 6) * 64 + lane;
#pragma unroll
    for (int nt = 0; nt < 3; ++nt)
#pragma unroll
        for (int g = 0; g < 2; ++g) dst[(2 * nt + g) * 64] = pack8n(acc[nt], g, rh);
}
DI void kv_head(const Ptrs& p, const LAS unsigned char* wb, const bf16x8 (&cf)[8], const f32x16& kpe, float sspe, const float (&gk)[3][16], int bh, int tile, int c, int lane) {
    const int h = lane >> 5;
    f32x16 acc[2];
#pragma unroll
    for (int nt = 0; nt < 2; ++nt) {
#pragma unroll
        for (int i = 0; i < 16; ++i) acc[nt][i] = 0.f;
#pragma unroll
        for (int ks = 0; ks < 8; ++ks) acc[nt] = MFMA32(*(const LAS bf16x8*)(wb + (nt * 8 + ks) * 1024 + lane * 16), cf[ks], acc[nt]);
    }
    float sk = sspe;
#pragma unroll
    for (int nt = 0; nt < 2; ++nt)
#pragma unroll
        for (int i = 0; i < 16; ++i) sk += acc[nt][i] * acc[nt][i];
    sk += __shfl_xor(sk, 32);
    const float rk = rsqrt_fast(sk * (1.f / 96.f) + EPS);
    uint4* kd = (uint4*)(p.ws + WS_KIMG) + (size_t)(bh * 64 + tile) * 6 * 2 * 64 + c * 64 + lane;
#pragma unroll
    for (int nt = 0; nt < 2; ++nt)
#pragma unroll
        for (int g = 0; g < 2; ++g) kd[(2 * nt + g) * 128] = pack8(acc[nt], g, rk, gk[nt]);
#pragma unroll
    for (int g = 0; g < 2; ++g) kd[(4 + g) * 128] = pack8(kpe, g, rk, gk[2]);
    uint4* vd = (uint4*)(p.ws + WS_VIMG) + (size_t)(bh * 64 + tile) * 8 * 64 + c * 4 * 64 + lane;
#pragma unroll
    for (int dt = 0; dt < 2; ++dt) {
        f32x16 av;
#pragma unroll
        for (int i = 0; i < 16; ++i) av[i] = 0.f;
#pragma unroll
        for (int ks = 0; ks < 8; ++ks) av = MFMA32(cf[ks], *(const LAS bf16x8*)(wb + ((2 + dt) * 8 + ks) * 1024 + lane * 16), av);
#pragma unroll
        for (int s = 0; s < 2; ++s) { uint4 o; o.x = cvtpk(av[8 * s + 0], av[8 * s + 1]); o.y = cvtpk(av[8 * s + 2], av[8 * s + 3]); o.z = cvtpk(av[8 * s + 4], av[8 * s + 5]); o.w = cvtpk(av[8 * s + 6], av[8 * s + 7]);
            vd[(s * 2 + dt) * 64] = o; }
    }
}
DI uint4 pack8l(const f32x16& a, int g, float sc, const LAS float* G) {
    const f32x4_t g0 = *(const LAS f32x4_t*)(G + 16 * g), g1 = *(const LAS f32x4_t*)(G + 16 * g + 8);
    uint4 o; o.x = cvtpk(a[8 * g + 0] * sc * g0[0], a[8 * g + 1] * sc * g0[1]); o.y = cvtpk(a[8 * g + 2] * sc * g0[2], a[8 * g + 3] * sc * g0[3]);
    o.z = cvtpk(a[8 * g + 4] * sc * g1[0], a[8 * g + 5] * sc * g1[1]); o.w = cvtpk(a[8 * g + 6] * sc * g1[2], a[8 * g + 7] * sc * g1[3]); return o;
}
DI void kv_head_l(const Ptrs& p, const LAS unsigned char* wb, const bf16x8 (&cf)[8], const f32x16& kpe, float sspe, const LAS float* G, int bh, int tile, int c, int lane) {
    f32x16 acc[2];
#pragma unroll
    for (int nt = 0; nt < 2; ++nt) {
#pragma unroll
        for (int i = 0; i < 16; ++i) acc[nt][i] = 0.f;
#pragma unroll
        for (int ks = 0; ks < 8; ++ks) acc[nt] = MFMA32(*(const LAS bf16x8*)(wb + (nt * 8 + ks) * 1024 + lane * 16), cf[ks], acc[nt]);
    }
    float sk = sspe;
#pragma unroll
    for (int nt = 0; nt < 2; ++nt)
#pragma unroll
        for (int i = 0; i < 16; ++i) sk += acc[nt][i] * acc[nt][i];
    sk += __shfl_xor(sk, 32);
    const float rk = rsqrt_fast(sk * (1.f / 96.f) + EPS);
    uint4* kd = (uint4*)(p.ws + WS_KIMG) + (size_t)(bh * 64 + tile) * 6 * 2 * 64 + c * 64 + lane;
#pragma unroll
    for (int nt = 0; nt < 2; ++nt)
#pragma unroll
        for (int g = 0; g < 2; ++g) kd[(2 * nt + g) * 128] = pack8l(acc[nt], g, rk, G + 32 * nt);
#pragma unroll
    for (int g = 0; g < 2; ++g) kd[(4 + g) * 128] = pack8l(kpe, g, rk, G + 64);
    uint4* vd = (uint4*)(p.ws + WS_VIMG) + (size_t)(bh * 64 + tile) * 8 * 64 + c * 4 * 64 + lane;
#pragma unroll
    for (int dt = 0; dt < 2; ++dt) {
        f32x16 av;
#pragma unroll
        for (int i = 0; i < 16; ++i) av[i] = 0.f;
#pragma unroll
        for (int ks = 0; ks < 8; ++ks) av = MFMA32(cf[ks], *(const LAS bf16x8*)(wb + ((2 + dt) * 8 + ks) * 1024 + lane * 16), av);
#pragma unroll
        for (int s = 0; s < 2; ++s) { uint4 o; o.x = cvtpk(av[8 * s + 0], av[8 * s + 1]); o.y = cvtpk(av[8 * s + 2], av[8 * s + 3]); o.z = cvtpk(av[8 * s + 4], av[8 * s + 5]); o.w = cvtpk(av[8 * s + 6], av[8 * s + 7]);
            vd[(s * 2 + dt) * 64] = o; }
    }
}
template <bool DO_QKV, bool DO_GMLP>
DI void wg_item(LAS unsigned char* lds, const Ptrs& p, int tg, int hp, int wid, int lane) {
    const int r = lane & 31, h = lane >> 5;
    const unsigned lds0 = (unsigned)(uintptr_t)lds, ldsA = lds0, ldsB = lds0 + 65536;
    const LAS unsigned char* bufA = lds; const LAS unsigned char* bufB = lds + 65536;
    const unsigned char* WqF = p.ws + WS_WUQT; const unsigned char* WkvF = p.ws + WS_WUKVT; const unsigned char* WsF = p.ws + WS_WSB;
    const int hA = 2 * hp, tb = tg * 8 + wid, t = tb * 32 + r, b = t >> 12, s0 = (tb * 32) & 4095, qblk = s0 >> 5, tile = s0 >> 6, c = (s0 >> 5) & 1;
    if constexpr (DO_QKV) {
    const bf16_t* CQ = (const bf16_t*)(p.ws + WS_CQ);
    bf16x8 cf[16];
#pragma unroll
    for (int ks = 0; ks < 16; ++ks) cf[ks] = *(const bf16x8*)(CQ + (((size_t)(tb * 32 + 2 * ks + h) * 32 + r) << 3));
    float cs[8], sn[8];
    { const float* ct = (const float*)(p.ws + WS_COS) + t * 16; const float* st = (const float*)(p.ws + WS_SIN) + t * 16;
#pragma unroll
      for (int i = 0; i < 8; ++i) { cs[i] = ct[crow(i, h)]; sn[i] = st[crow(i, h)]; } }
    dma_copy<6>(WqF + (size_t)hA * 49152, ldsA, wid, lane);
    dma_copy<6>(WqF + (size_t)(hA + 1) * 49152, ldsB, wid, lane);
    float ss = 0.f;
#pragma unroll
    for (int ks = 0; ks < 16; ++ks) ss += frag_ssq(cf[ks]);
    ss += __shfl_xor(ss, 32);
    const float rq = rsqrt_fast(ss * (1.f / 256.f) + EPS);
    P2_BAR_V(6);
    q_head(p, bufA, cf, rq, cs, sn, b * 8 + hA, qblk, lane);
    P2_BAR_V(0);
    dma_copy<8>(WkvF + (size_t)hA * 32768, ldsA, wid, lane);
    q_head(p, bufB, cf, rq, cs, sn, b * 8 + hA + 1, qblk, lane);
    const bf16_t* CKV = (const bf16_t*)(p.ws + WS_CKV);
    bf16x8 kf[8]; float ssk = 0.f;
#pragma unroll
    for (int ks = 0; ks < 8; ++ks) { kf[ks] = *(const bf16x8*)(CKV + (((size_t)(tb * 20 + 2 * ks + h) * 32 + r) << 3)); ssk += frag_ssq(kf[ks]); }
    ssk += __shfl_xor(ssk, 32);
    const float rkv = rsqrt_fast(ssk * (1.f / 128.f) + EPS);
#pragma unroll
    for (int ks = 0; ks < 8; ++ks) kf[ks] = frag_scale(kf[ks], rkv);
    f32x16 kpe; float sspe = 0.f;
    {
        float kr[16];
#pragma unroll
        for (int g = 0; g < 4; ++g) { const uint2 w = *(const uint2*)(CKV + (((size_t)(tb * 20 + 16 + g) * 32 + r) << 3) + 4 * h);
            kr[4 * g + 0] = lo16(w.x); kr[4 * g + 1] = hi16(w.x); kr[4 * g + 2] = lo16(w.y); kr[4 * g + 3] = hi16(w.y); }
#pragma unroll
        for (int i = 0; i < 8; ++i) { const float a = kr[i], bb = kr[i + 8];
            kpe[i] = a * cs[i] - bb * sn[i]; kpe[i + 8] = bb * cs[i] + a * sn[i]; sspe += kpe[i] * kpe[i] + kpe[i + 8] * kpe[i + 8]; }
    }
    float gk[3][16];
#pragma unroll
    for (int nt = 0; nt < 3; ++nt)
#pragma unroll
        for (int i = 0; i < 16; ++i) gk[nt][i] = p.g_kh[32 * nt + crow(i, h)] * p.g_qh[32 * nt + crow(i, h)];
    P2_BAR_V(0);
    if constexpr (DO_GMLP) dma_copy<8>(WsF + (size_t)hA * 32768, ldsB, wid, lane);
    kv_head(p, bufA, kf, kpe, sspe, gk, b * 8 + hA, tile, c, lane);
    kv_head(p, bufA + 32768, kf, kpe, sspe, gk, b * 8 + hA + 1, tile, c, lane);
    P2_BAR_V(0);
    } else { if constexpr (DO_GMLP) dma_copy<8>(WsF + (size_t)hA * 32768, ldsB, wid, lane); }
    if constexpr (DO_GMLP) {
    const bf16_t* Z = (const bf16_t*)(p.ws + WS_Z);
    const int pair = wid >> 1, cl = pair >> 1, hl = pair & 1, hd = hA + hl, tc0 = (2 * tg + cl) * 128;
    uint2 uld[2][2][4], zld[2][2][4];
#pragma unroll
    for (int ii = 0; ii < 2; ++ii) { const bf16_t* zr = Z + (size_t)(tc0 + 32 * (2 * (wid & 1) + ii) + r) * 2048 + hd * 64 + 4 * h;
#pragma unroll
        for (int nt = 0; nt < 2; ++nt)
#pragma unroll
            for (int g = 0; g < 4; ++g) { uld[ii][nt][g] = *(const uint2*)(zr + 512 + 32 * nt + 8 * g); zld[ii][nt][g] = *(const uint2*)(zr + 1536 + 32 * nt + 8 * g); } }
    {
        const int j = 64 * (wid & 1) + lane;
        const uint4* srcv = (const uint4*)(Z + (size_t)(tc0 + j) * 2048 + 1024 + hd * 64);
        float gv[64]; float sg = 0.f;
#pragma unroll
        for (int c8 = 0; c8 < 8; ++c8) { const uint4 u = srcv[c8];
            gv[8 * c8 + 0] = gelu_tanh(lo16(u.x)); gv[8 * c8 + 1] = gelu_tanh(hi16(u.x)); gv[8 * c8 + 2] = gelu_tanh(lo16(u.y)); gv[8 * c8 + 3] = gelu_tanh(hi16(u.y));
            gv[8 * c8 + 4] = gelu_tanh(lo16(u.z)); gv[8 * c8 + 5] = gelu_tanh(hi16(u.z)); gv[8 * c8 + 6] = gelu_tanh(lo16(u.w)); gv[8 * c8 + 7] = gelu_tanh(hi16(u.w)); }
#pragma unroll
        for (int d = 0; d < 64; ++d) sg += gv[d] * gv[d];
        const float rv = rsqrt_fast(sg * (1.f / 64.f) + EPS);
        const float* gg = p.g_vg + hd * 64;
        LAS unsigned char* img = lds + pair * 16384;
#pragma unroll
        for (int c8 = 0; c8 < 8; ++c8) { u32x4v o;
            o.x = cvtpk(gv[8 * c8 + 0] * rv * gg[8 * c8 + 0], gv[8 * c8 + 1] * rv * gg[8 * c8 + 1]); o.y = cvtpk(gv[8 * c8 + 2] * rv * gg[8 * c8 + 2], gv[8 * c8 + 3] * rv * gg[8 * c8 + 3]);
            o.z = cvtpk(gv[8 * c8 + 4] * rv * gg[8 * c8 + 4], gv[8 * c8 + 5] * rv * gg[8 * c8 + 5]); o.w = cvtpk(gv[8 * c8 + 6] * rv * gg[8 * c8 + 6], gv[8 * c8 + 7] * rv * gg[8 * c8 + 7]);
            *(LAS u32x4v*)(img + (c8 >> 2) * 8192 + j * 64 + (c8 & 3) * 16) = o; }
    }
    P2_BAR_V(0);
    {
        bf16x8 vf[8][2];
        { const int q = (lane & 15) >> 2, pp = lane & 3, blk = (lane >> 4) & 1;
          const LAS unsigned char* base = bufA + pair * 16384 + (8 * h + q) * 64 + (16 * blk + 4 * pp) * 2;
#pragma unroll
          for (int ks = 0; ks < 8; ++ks)
#pragma unroll
              for (int nt = 0; nt < 2; ++nt) { const s16x4 lo = vtr(base + nt * 8192 + ks * 1024), hi = vtr(base + nt * 8192 + ks * 1024 + 256);
                  vf[ks][nt] = __builtin_shufflevector(lo, hi, 0, 1, 2, 3, 4, 5, 6, 7); } }
#pragma unroll
        for (int ii = 0; ii < 2; ++ii) { const int it = 2 * (wid & 1) + ii;
            f32x16 acc[2];
#pragma unroll
            for (int i = 0; i < 16; ++i) { acc[0][i] = 0.f; acc[1][i] = 0.f; }
            const LAS unsigned char* wsb = bufB + hl * 32768 + it * 8192 + lane * 16;
#pragma unroll
            for (int ks = 0; ks < 8; ++ks) { const bf16x8 wf = *(const LAS bf16x8*)(wsb + ks * 1024); acc[0] = MFMA32(vf[ks][0], wf, acc[0]); acc[1] = MFMA32(vf[ks][1], wf, acc[1]); }
            const int tt = tc0 + 32 * it + r; const float bs = p.b_s[hd * 128 + 32 * it + r];
            bf16_t* ar = (bf16_t*)(p.ws + WS_AMIX) + (size_t)tt * 1024 + 512 + hd * 64 + 4 * h;
            float sq = 0.f;
#pragma unroll
            for (int nt = 0; nt < 2; ++nt)
#pragma unroll
                for (int g = 0; g < 4; ++g) { const uint2 uu = uld[ii][nt][g], zz = zld[ii][nt][g];
                    const float uv[4] = {lo16(uu.x), hi16(uu.x), lo16(uu.y), hi16(uu.y)}, zv[4] = {lo16(zz.x), hi16(zz.x), lo16(zz.y), hi16(zz.y)}; float a[4];
#pragma unroll
                    for (int e = 0; e < 4; ++e) { const float o = gelu_tanh(uv[e]) * (acc[nt][4 * g + e] + bs); sq += o * o; a[e] = o * silu(zv[e]); }
                    uint2 w; w.x = cvtpk(a[0], a[1]); w.y = cvtpk(a[2], a[3]); *(uint2*)(ar + 32 * nt + 8 * g) = w; }
            sq += __shfl_xor(sq, 32);
            if (h == 0) ((float*)(p.ws + WS_SSQB))[(size_t)hd * T + tt] = sq;
        }
    }
    P2_BAR_V(0);
    }
}
#undef P2_BAR_V
}


typedef unsigned f_u32x2 __attribute__((ext_vector_type(2)));
#define F_BAR_V(N) asm volatile("s_waitcnt vmcnt(" #N ") lgkmcnt(0)\n\ts_barrier" ::: "memory")
#define F_BAR_L() asm volatile("s_waitcnt lgkmcnt(0)\n\ts_barrier" ::: "memory")
DI void p1_fused_q_a(const f32x4_t (&acc)[2][2][4][2], int pm, int wr, int wc, int fr, int fq, LAS unsigned char* lds, const Ptrs* pp) {
    using namespace p2;
    const Ptrs& p = *pp;
    const LAS float* rsx = (const LAS float*)(lds + 131072 + 4096 + 2048);
    LAS float* tab = (LAS float*)(lds + 131072);
#pragma unroll
    for (int ai = 0; ai < 2; ++ai)
#pragma unroll
        for (int m = 0; m < 4; ++m) {
            const int row = ai * 128 + wr * 64 + m * 16 + fr; const float rs = rsx[row]; float part = 0.f;
#pragma unroll
            for (int bj = 0; bj < 2; ++bj) { const f32x4_t v0 = acc[ai][bj][m][0] * rs, v1 = acc[ai][bj][m][1] * rs;
                part += (v0[0] * v0[0] + v0[1] * v0[1]) + (v0[2] * v0[2] + v0[3] * v0[3]) + (v1[0] * v1[0] + v1[1] * v1[1]) + (v1[2] * v1[2] + v1[3] * v1[3]);
                u32x4v w; w.x = cvtpk(v0[0], v0[1]); w.y = cvtpk(v0[2], v0[3]); w.z = cvtpk(v1[0], v1[1]); w.w = cvtpk(v1[2], v1[3]);
                const int chunk = 16 * bj + 4 * wc + fq;
                *(LAS u32x4v*)(lds + ((((row >> 5) * 16 + (chunk >> 1)) * 64 + (chunk & 1) * 32 + (row & 31)) << 4)) = w; }
            part += __shfl_xor(part, 16); part += __shfl_xor(part, 32);
            if (fq == 0) tab[row * 4 + wc] = part;
        }
}
DI void p1_fused_q_b(int pm, LAS unsigned char* lds, const Ptrs* pp, int wid, int lane) {
    using namespace p2;
    const Ptrs& p = *pp;
    const int r = lane & 31, h = lane >> 5;
    const LAS float* tab = (const LAS float*)(lds + 131072);
    bf16x8 cf[16];
#pragma unroll
    for (int ks = 0; ks < 16; ++ks) cf[ks] = *(const LAS bf16x8*)(lds + (((wid * 16 + ks) * 64 + lane) << 4));
    const int row = 32 * wid + r, t = pm * 256 + row, b = t >> 12, s0 = (pm * 256 + 32 * wid) & 4095, qblk = s0 >> 5;
    const float rq = rsqrt_fast((tab[row * 4] + tab[row * 4 + 1] + tab[row * 4 + 2] + tab[row * 4 + 3]) * (1.f / 256.f) + EPS);
    float cs[8], sn[8];
    { const float* ct = (const float*)(p.ws + WS_COS) + t * 16; const float* st = (const float*)(p.ws + WS_SIN) + t * 16;
#pragma unroll
      for (int i = 0; i < 8; ++i) { cs[i] = ct[crow(i, h)]; sn[i] = st[crow(i, h)]; } }
    F_BAR_L();
    const unsigned lds0 = (unsigned)(uintptr_t)lds, ldsA = lds0, ldsB = lds0 + 65536;
    const LAS unsigned char* bufA = lds; const LAS unsigned char* bufB = lds + 65536;
    const unsigned char* WqF = p.ws + WS_WUQT;
    dma_copy<6>(WqF, ldsA, wid, lane);
    dma_copy<6>(WqF + 49152, ldsB, wid, lane);
#pragma nounroll
    for (int hp = 0; hp < 4; ++hp) {
        F_BAR_V(6);
        q_head(p, bufA, cf, rq, cs, sn, b * 8 + 2 * hp, qblk, lane);
        F_BAR_V(0);
        if (hp < 3) dma_copy<6>(WqF + (size_t)(2 * hp + 2) * 49152, ldsA, wid, lane);
        q_head(p, bufB, cf, rq, cs, sn, b * 8 + 2 * hp + 1, qblk, lane);
        F_BAR_L();
        if (hp < 3) dma_copy<6>(WqF + (size_t)(2 * hp + 3) * 49152, ldsB, wid, lane);
    }
    F_BAR_V(0);
}
DI void p1_fused_kv_a(const f32x4_t (&acc)[2][2][4][2], int pm, int wr, int wc, int fr, int fq, LAS unsigned char* lds, const Ptrs* pp) {
    using namespace p2;
    const Ptrs& p = *pp;
    const LAS float* rsx = (const LAS float*)(lds + 131072 + 4096 + 2048);
    LAS float* tab = (LAS float*)(lds + 131072);
#pragma unroll
    for (int ai = 0; ai < 2; ++ai)
#pragma unroll
        for (int m = 0; m < 4; ++m) {
            const int row = ai * 128 + wr * 64 + m * 16 + fr; const float rs = rsx[row];
            { const f32x4_t v0 = acc[ai][0][m][0] * rs, v1 = acc[ai][0][m][1] * rs;
              float part = (v0[0] * v0[0] + v0[1] * v0[1]) + (v0[2] * v0[2] + v0[3] * v0[3]) + (v1[0] * v1[0] + v1[1] * v1[1]) + (v1[2] * v1[2] + v1[3] * v1[3]);
              u32x4v w; w.x = cvtpk(v0[0], v0[1]); w.y = cvtpk(v0[2], v0[3]); w.z = cvtpk(v1[0], v1[1]); w.w = cvtpk(v1[2], v1[3]);
              const int chunk = 4 * wc + fq;
              *(LAS u32x4v*)(lds + ((((row >> 5) * 8 + (chunk >> 1)) * 64 + (chunk & 1) * 32 + (row & 31)) << 4)) = w;
              part += __shfl_xor(part, 16); part += __shfl_xor(part, 32);
              if (fq == 0) tab[row * 4 + wc] = part; }
            if (wc == 0) { const f32x4_t v0 = acc[ai][1][m][0] * rs, v1 = acc[ai][1][m][1] * rs;
              u32x4v w; w.x = cvtpk(v0[0], v0[1]); w.y = cvtpk(v0[2], v0[3]); w.z = cvtpk(v1[0], v1[1]); w.w = cvtpk(v1[2], v1[3]);
              *(LAS u32x4v*)(lds + 65536 + ((((row >> 5) * 4 + fq) * 32 + (row & 31)) << 4)) = w; }
        }
}
DI void p1_fused_kv_b(int pm, LAS unsigned char* lds, const Ptrs* pp, int wid, int lane) {
    using namespace p2;
    const Ptrs& p = *pp;
    const int r = lane & 31, h = lane >> 5;
    LAS float* tab = (LAS float*)(lds + 131072);
    bf16x8 kf[8];
#pragma unroll
    for (int ks = 0; ks < 8; ++ks) kf[ks] = *(const LAS bf16x8*)(lds + (((wid * 8 + ks) * 64 + lane) << 4));
    const int row = 32 * wid + r, t = pm * 256 + row, b = t >> 12, s0 = (pm * 256 + 32 * wid) & 4095, tile = s0 >> 6, c = (s0 >> 5) & 1;
    const float rkv = rsqrt_fast((tab[row * 4] + tab[row * 4 + 1] + tab[row * 4 + 2] + tab[row * 4 + 3]) * (1.f / 128.f) + EPS);
#pragma unroll
    for (int ks = 0; ks < 8; ++ks) kf[ks] = frag_scale(kf[ks], rkv);
    f32x16 kpe; float sspe = 0.f;
    {
        float kr[16];
#pragma unroll
        for (int g = 0; g < 4; ++g) { const f_u32x2 w = *(const LAS f_u32x2*)(lds + 65536 + (((wid * 4 + g) * 32 + r) << 4) + 8 * h);
            kr[4 * g + 0] = lo16(w.x); kr[4 * g + 1] = hi16(w.x); kr[4 * g + 2] = lo16(w.y); kr[4 * g + 3] = hi16(w.y); }
        const float* ct = (const float*)(p.ws + WS_COS) + t * 16; const float* st = (const float*)(p.ws + WS_SIN) + t * 16;
#pragma unroll
        for (int i = 0; i < 8; ++i) { const float a = kr[i], bb = kr[i + 8], cc = ct[crow(i, h)], sv = st[crow(i, h)];
            kpe[i] = a * cc - bb * sv; kpe[i + 8] = bb * cc + a * sv; sspe += kpe[i] * kpe[i] + kpe[i + 8] * kpe[i + 8]; }
    }
    const float gprod = (wid == 0 && lane < 48) ? p.g_kh[lane] * p.g_qh[lane] : 0.f, gprod2 = (wid == 0 && lane < 48) ? p.g_kh[lane + 48] * p.g_qh[lane + 48] : 0.f;
    F_BAR_L();
    if (wid == 0 && lane < 48) { tab[lane] = gprod; tab[lane + 48] = gprod2; }
    const LAS float* G = tab + 4 * h;
    const unsigned lds0 = (unsigned)(uintptr_t)lds, ldsA = lds0, ldsB = lds0 + 65536;
    const LAS unsigned char* bufA = lds; const LAS unsigned char* bufB = lds + 65536;
    const unsigned char* WkvF = p.ws + WS_WUKVT;
    dma_copy<8>(WkvF, ldsA, wid, lane);
    dma_copy<8>(WkvF + 65536, ldsB, wid, lane);
#pragma nounroll
    for (int hq = 0; hq < 2; ++hq) {
        F_BAR_V(8);
        kv_head_l(p, bufA, kf, kpe, sspe, G, b * 8 + 4 * hq, tile, c, lane);
        kv_head_l(p, bufA + 32768, kf, kpe, sspe, G, b * 8 + 4 * hq + 1, tile, c, lane);
        F_BAR_V(0);
        if (hq == 0) dma_copy<8>(WkvF + 2 * 65536, ldsA, wid, lane);
        kv_head_l(p, bufB, kf, kpe, sspe, G, b * 8 + 4 * hq + 2, tile, c, lane);
        kv_head_l(p, bufB + 32768, kf, kpe, sspe, G, b * 8 + 4 * hq + 3, tile, c, lane);
        F_BAR_L();
        if (hq == 0) dma_copy<8>(WkvF + 3 * 65536, ldsB, wid, lane);
    }
    F_BAR_V(0);
}
#undef F_BAR_V
#undef F_BAR_L

#define FB_V(k)      (0x5EED0000u + (unsigned)(k))
#define FB_OK(f, k)  ((((f) & 0xFFFFF0FFu) - FB_V(k)) <= 1u)
#define FB_SPIN_CAP  (1u << 22)
__device__ __forceinline__ unsigned xb_ld(unsigned* p)              { return __hip_atomic_load(p, __ATOMIC_RELAXED, __HIP_MEMORY_SCOPE_AGENT); }
__device__ __forceinline__ void xb_st(unsigned* p, unsigned v)      { __hip_atomic_store(p, v, __ATOMIC_RELAXED, __HIP_MEMORY_SCOPE_AGENT); }
__device__ __forceinline__ unsigned xb_xcc_id() { return (unsigned)__builtin_amdgcn_s_getreg((3 << 11) | 20) & 0xFu; }
__device__ __forceinline__ void flag_barrier(unsigned* bar, volatile LAS unsigned* st, int k) {
    asm volatile("s_waitcnt vmcnt(0)" ::: "memory");
    __syncthreads();
    if (threadIdx.x < 64) {
        const unsigned lane = threadIdx.x, bx = blockIdx.x, x = xb_xcc_id();
        __builtin_amdgcn_s_waitcnt(0);
        if (lane == 0) xb_st(&bar[bx], FB_V(k) | (x << 8));
        unsigned f0, f1, f2, f3, sp = 0u, m; bool leader;
        if (k == 0) {
            for (;;) {
                f0 = xb_ld(&bar[lane]); f1 = xb_ld(&bar[64 + lane]); f2 = xb_ld(&bar[128 + lane]); f3 = xb_ld(&bar[192 + lane]);
                if (__all(FB_OK(f0, k) && FB_OK(f1, k) && FB_OK(f2, k) && FB_OK(f3, k))) break;
                __builtin_amdgcn_s_sleep(2);
                if (++sp > FB_SPIN_CAP) break;
            }
            const unsigned x0 = (f0 >> 8) & 15u, x1 = (f1 >> 8) & 15u, x2 = (f2 >> 8) & 15u, x3 = (f3 >> 8) & 15u;
            const bool lower = (x0 == x && lane < bx) || (x1 == x && 64u + lane < bx) || (x2 == x && 128u + lane < bx) || (x3 == x && 192u + lane < bx);
            leader = !__any(lower);
            m = (1u << x0) | (1u << x1) | (1u << x2) | (1u << x3);
#pragma unroll
            for (int o = 1; o < 64; o <<= 1) m |= __shfl_xor(m, o);
            st[16 + lane] = (x0 == x ? 1u : 0u) | (x1 == x ? 2u : 0u) | (x2 == x ? 4u : 0u) | (x3 == x ? 8u : 0u);
            if (lane == 0) { st[0] = leader ? 1u : 0u; st[1] = m; }
        } else {
            leader = st[0] != 0u; m = st[1];
            if (leader) {
                const unsigned loc = st[16 + lane];
                for (;;) {
                    f0 = (loc & 1u) ? xb_ld(&bar[lane]) : FB_V(k); f1 = (loc & 2u) ? xb_ld(&bar[64 + lane]) : FB_V(k); f2 = (loc & 4u) ? xb_ld(&bar[128 + lane]) : FB_V(k); f3 = (loc & 8u) ? xb_ld(&bar[192 + lane]) : FB_V(k);
                    if (__all(FB_OK(f0, k) && FB_OK(f1, k) && FB_OK(f2, k) && FB_OK(f3, k))) break;
                    __builtin_amdgcn_s_sleep(1);
                    if (++sp > FB_SPIN_CAP) break;
                }
            }
        }
        if (leader) {
            __builtin_amdgcn_fence(__ATOMIC_RELEASE, "agent");
            asm volatile("s_waitcnt vmcnt(0)" ::: "memory");
            if (lane == 0) xb_st(&bar[256 + x], FB_V(k));
        }
        for (sp = 0u;;) {
            const unsigned t = lane < 16u ? xb_ld(&bar[256 + lane]) : 0u;
            const bool need = lane < 16u && ((m >> lane) & 1u);
            if (__all(!need || FB_OK(t, k))) break;
            __builtin_amdgcn_s_sleep(2);
            if (++sp > FB_SPIN_CAP) break;
        }
        __builtin_amdgcn_fence(__ATOMIC_ACQUIRE, "agent");
        asm volatile("s_waitcnt vmcnt(0)" ::: "memory");
    }
    __syncthreads();
}

constexpr int LDS_BYTES = 147456;
constexpr int NPHASE = 5;
constexpr int MISC_OFF = 131072 + 4096;
struct Args { Ptrs p; int ph_lo, ph_hi; };

DI size_t frag_off(int n, int k, int K) { return ((((size_t)(n >> 5) * (K >> 4) + (k >> 4)) * 64 + ((k >> 3) & 1) * 32 + (n & 31)) << 3) + (k & 7); }
template <bool FRAG>
DI void p0_transpose_item(const float* W, int K, int Nsrc, const float* gain, bf16_t* WT, int dst_row0, LAS float* scr, int k0, int n0, int lane) {
#pragma unroll 8
    for (int i = 0; i < 32; ++i) { const int kk = 2 * i + (lane >> 5); scr[kk * 33 + (lane & 31)] = W[(size_t)(k0 + kk) * Nsrc + n0 + (lane & 31)] * gain[k0 + kk]; }
    asm volatile("s_waitcnt lgkmcnt(0)" ::: "memory");
#pragma unroll
    for (int j = 0; j < 4; ++j) {
        const int c = FRAG ? (lane >> 5) + 2 * j : (lane & 7), n = FRAG ? (lane & 31) : (lane >> 3) + 8 * j; const LAS float* s = scr + (8 * c) * 33 + n;
        uint4 o; o.x = f2bf(s[0 * 33]) | ((unsigned)f2bf(s[1 * 33]) << 16); o.y = f2bf(s[2 * 33]) | ((unsigned)f2bf(s[3 * 33]) << 16);
        o.z = f2bf(s[4 * 33]) | ((unsigned)f2bf(s[5 * 33]) << 16); o.w = f2bf(s[6 * 33]) | ((unsigned)f2bf(s[7 * 33]) << 16);
        if (FRAG) *(uint4*)(WT + frag_off(dst_row0 + n, k0 + 8 * c, K)) = o; else *(uint4*)(WT + (size_t)(dst_row0 + n) * K + k0 + 8 * c) = o; }
    asm volatile("s_waitcnt lgkmcnt(0)" ::: "memory");
}
DI void p0_prologue(const Ptrs& p, LAS unsigned char* lds, int vcu, int G) {
    const int tid = threadIdx.x, lane = tid & 63, wave = __builtin_amdgcn_readfirstlane(tid >> 6);
    const int gw = vcu * 8 + wave, NGW = G * 8;
    LAS float* scr = (LAS float*)(lds + wave * 16384);
    bf16_t* WinT = (bf16_t*)(p.ws + WS_WINT); bf16_t* WuqT = (bf16_t*)(p.ws + WS_WUQT); bf16_t* WukvT = (bf16_t*)(p.ws + WS_WUKVT);
    bf16_t* WoutT = (bf16_t*)(p.ws + WS_WOUTT); bf16_t* Wsb = (bf16_t*)(p.ws + WS_WSB);
    {
    bf16_t* xb = (bf16_t*)(p.ws + WS_XB); float* rs = (float*)(p.ws + WS_RSTDX);
    for (int row = gw; row < T; row += NGW) {
        typedef float f32x4v __attribute__((ext_vector_type(4)));
        const f32x4v* xr = (const f32x4v*)(p.x + (size_t)row * DM) + lane;
        float s = 0.f; f32x4v v[4];
#pragma unroll
        for (int j = 0; j < 4; ++j) { v[j] = __builtin_nontemporal_load(xr + 64 * j); s += v[j].x * v[j].x + v[j].y * v[j].y + v[j].z * v[j].z + v[j].w * v[j].w; }
#pragma unroll
        for (int o = 1; o < 64; o <<= 1) s += __shfl_xor(s, o);
        if (lane == 0) rs[row] = rsqrt_fast(s * (1.f / DM) + EPS);
        uint2* o8 = (uint2*)(xb + (size_t)row * DM) + lane;
#pragma unroll
        for (int j = 0; j < 4; ++j) { uint2 w; w.x = f2bf(v[j].x) | ((unsigned)f2bf(v[j].y) << 16); w.y = f2bf(v[j].z) | ((unsigned)f2bf(v[j].w) << 16); o8[64 * j] = w; }
    }
    }
    constexpr int I_IN = 16 * 77, I_UQ = 4 * 24, I_UKV = 2 * 32, I_OUT = 16 * 32, NITEMS = I_IN + I_UQ + I_UKV + I_OUT;
    for (int it = gw; it < NITEMS; it += NGW) {
        int r = it;
        if (r < I_IN) { const int kb = r / 77, nb = r % 77; p0_transpose_item<false>(p.w_in, 1024, 2464, p.g_in, WinT, nb < 8 ? 1024 + 32 * nb : nb < 13 ? 1280 + 32 * (nb - 8) : nb < 29 ? 2048 + 32 * (nb - 13) : nb < 61 ? 32 * (nb - 29) : 1536 + 32 * (nb - 61), scr, 64 * kb, 32 * nb, lane);   continue; } r -= I_IN;
        if (r < I_UQ) { const int kb = r / 24, nb = r % 24; p0_transpose_item<true>(p.w_uq, 256, 768, p.g_ql, WuqT, 32 * nb, scr, 64 * kb, 32 * nb, lane); continue; } r -= I_UQ;
        if (r < I_UKV) { const int kb = r / 32, nb = r % 32; p0_transpose_item<true>(p.w_ukv, 128, 1024, p.g_kvl, WukvT, 32 * nb, scr, 64 * kb, 32 * nb, lane); continue; } r -= I_UKV;
        { const int kb = r / 32, nb = r % 32; p0_transpose_item<false>(p.w_out, 1024, 1024, kb < 8 ? p.g_oa : p.g_ob - 512, WoutT, 32 * nb, scr, 64 * kb, 32 * nb, lane); }
    }
    const size_t gid = (size_t)vcu * 512 + tid, gsz = (size_t)G * 512;
    for (size_t i = gid; i < (size_t)96 * 1024 / 8; i += gsz) ((uint4*)(WinT + (size_t)1440 * 1024))[i] = make_uint4(0u, 0u, 0u, 0u);
    for (size_t i = gid; i < (size_t)8 * 128 * 16; i += gsz) { const int n = (int)(i >> 4), kc = (int)(i & 15); const float4 a = *(const float4*)(p.w_s + (size_t)n * 128 + 8 * kc), bq = *(const float4*)(p.w_s + (size_t)n * 128 + 8 * kc + 4);
        uint4 o; o.x = f2bf(a.x) | ((unsigned)f2bf(a.y) << 16); o.y = f2bf(a.z) | ((unsigned)f2bf(a.w) << 16); o.z = f2bf(bq.x) | ((unsigned)f2bf(bq.y) << 16); o.w = f2bf(bq.z) | ((unsigned)f2bf(bq.w) << 16);
        *(uint4*)(Wsb + frag_off(n, 8 * kc, 128)) = o; }
    float* ct = (float*)(p.ws + WS_COS); float* st = (float*)(p.ws + WS_SIN);
    for (size_t i = gid; i < (size_t)T * 16; i += gsz) { const int t = (int)(i >> 4), f = (int)(i & 15);
        const float invf = 1.0f / powf(10000.0f, (float)(2 * f) / 32.0f);
        const float ang = (float)p.pos[t] * invf;
        const double rev = (double)ang * 0.15915494309189535; const float fr = (float)(rev - rint(rev));
        ct[i] = __builtin_amdgcn_cosf(fr); st[i] = __builtin_amdgcn_sinf(fr); }
}

__global__ void __launch_bounds__(512, 2) mega(Args a) {
    extern __shared__ __attribute__((aligned(16))) unsigned char lds_all[];
    LAS unsigned char* lds = (LAS unsigned char*)lds_all;
    cg::grid_group grid = cg::this_grid();
    const Ptrs& p = a.p;
#define GRID_BAR(k) flag_barrier((unsigned*)(p.ws + WS_CTL) + 1024, (volatile LAS unsigned*)(lds + MISC_OFF), (k))
    if (a.ph_lo > 1000) grid.sync();
    const int lo = a.ph_lo, hi = a.ph_hi, G = gridDim.x, bx = blockIdx.x;
    const int vcu = (G % 8 == 0) ? (bx % 8) * (G / 8) + bx / 8 : bx;
#define IN(k) (lo <= (k) && (k) < hi)
#define BOTH(k) (IN(k) && IN((k) + 1))
    if (IN(0)) { p0_prologue(p, lds, vcu, G); if (BOTH(0)) GRID_BAR(0); }
    if (IN(1)) {
        {
        __syncthreads();
        pg8::Gemm g{(const bf16_t*)(p.ws + WS_XB), (const bf16_t*)(p.ws + WS_WINT), T, NP + 512, DM}; pg8::P1Order S; S.init(T, NP, G, bx);
        { pg8::Unit u0; S.next(0, u0); if (threadIdx.x < 256) ((LAS float*)(lds + MISC_OFF + 2048))[threadIdx.x] = ((const float*)(p.ws + WS_RSTDX))[u0.pm * 256 + threadIdx.x];
          asm volatile("s_waitcnt vmcnt(0) lgkmcnt(0)" ::: "memory"); __syncthreads(); }
        pg8::EpiProj E{(bf16_t*)(p.ws + WS_Z), (const LAS float*)(lds + MISC_OFF + 2048), &p};
        pg8::gemm_phase<pg8::EpiProj, pg8::P1Order, true, true>(lds, g, S, E);
        }
        if (BOTH(1)) GRID_BAR(1);
    }
    if (IN(3)) { __syncthreads(); att::attn_phase64(lds, p, vcu, G); }
    if (IN(2)) {
        const int lane = threadIdx.x & 63, wid = __builtin_amdgcn_readfirstlane(threadIdx.x >> 6);
        __syncthreads();
        p2::wg_item<false, true>(lds, p, 8 * (bx & 7) + ((bx >> 3) & 7), bx >> 6, wid, lane);
        asm volatile("s_waitcnt vmcnt(0) lgkmcnt(0)" ::: "memory");
        if (BOTH(3)) GRID_BAR(2);
    }
    if (IN(4)) {
        {
        __syncthreads();
        pg8::StaticOrder S; S.init(T, DM, G, bx); pg8::Unit u0;
        if (S.next(0, u0) && threadIdx.x < 256) {
            const float* ssqa = (const float*)(p.ws + WS_SSQA); const float* ssqb = (const float*)(p.ws + WS_SSQB); const int t = u0.pm * 256 + threadIdx.x;
            float sa = 0.f, sb = 0.f;
#pragma unroll
            for (int h = 0; h < 8; ++h) { sa += ssqa[(size_t)h * T + t]; sb += ssqb[(size_t)h * T + t]; }
            const float ra = rsqrt_fast(sa * (1.f / 512.f) + EPS), rb = rsqrt_fast(sb * (1.f / 512.f) + EPS);
            ((LAS float*)(lds + pg8::STAGE_BYTES))[threadIdx.x] = ra / rb; ((LAS float*)(lds + pg8::STAGE_BYTES + 1024))[threadIdx.x] = rb;
        }
        asm volatile("s_waitcnt vmcnt(0) lgkmcnt(0)" ::: "memory"); __syncthreads();
        pg8::Gemm g{(const bf16_t*)(p.ws + WS_AMIX), (const bf16_t*)(p.ws + WS_WOUTT), T, DM, DM};
        pg8::EpiOut E{p.x, p.out, lds, (const bf16_t*)(p.ws + WS_XB)};
        pg8::gemm_phase<pg8::EpiOut, pg8::StaticOrder, false, true>(lds, g, S, E);
        }
    }
#undef IN
#undef BOTH
}

static int g_grid = 0;
static void launch_mega(const Ptrs& p, int lo, int hi, hipStream_t stream) {
    if (g_grid == 0) {
        int dev = 0, cus = 0, per_cu = 0;
        hipGetDevice(&dev); hipDeviceGetAttribute(&cus, hipDeviceAttributeMultiprocessorCount, dev);
        hipFuncSetAttribute((const void*)mega, hipFuncAttributeMaxDynamicSharedMemorySize, LDS_BYTES);
        hipOccupancyMaxActiveBlocksPerMultiprocessor(&per_cu, (const void*)mega, 512, LDS_BYTES);
        g_grid = cus;
        if (per_cu < 1 || cus != 256) { fprintf(stderr, "mega: built for 256 CUs x 1 resident workgroup; device has %d CUs, occupancy query says %d per CU; nothing launched\n", cus, per_cu); g_grid = -1; }
    }
    if (g_grid < 0) return;
    Args a{}; a.p = p; a.ph_lo = lo; a.ph_hi = hi;
    void* args[] = {&a};
    hipError_t e = hipLaunchCooperativeKernel((const void*)mega, dim3(g_grid), dim3(512), args, LDS_BYTES, stream);
    if (e != hipSuccess) fprintf(stderr, "cooperative launch failed: %s (grid %d)\n", hipGetErrorString(e), g_grid);
}
extern "C" void kernel_launch(void* const* d_in, const int* in_sizes, int n_in, void* d_out, int out_size, void* d_ws, size_t ws_size, hipStream_t stream) {
    if (n_in != 16 || out_size != T * DM || ws_size < WS_END) { fprintf(stderr, "kernel_launch: unexpected shapes n_in %d out %d ws %zu\n", n_in, out_size, ws_size); return; }
    Ptrs p{};
    p.x = (const float*)d_in[0]; p.pos = (const int*)d_in[1]; p.g_in = (const float*)d_in[2]; p.w_in = (const float*)d_in[3]; p.g_ql = (const float*)d_in[4]; p.w_uq = (const float*)d_in[5];
    p.g_kvl = (const float*)d_in[6]; p.w_ukv = (const float*)d_in[7]; p.g_qh = (const float*)d_in[8]; p.g_kh = (const float*)d_in[9]; p.g_vg = (const float*)d_in[10]; p.w_s = (const float*)d_in[11];
    p.b_s = (const float*)d_in[12]; p.g_oa = (const float*)d_in[13]; p.g_ob = (const float*)d_in[14]; p.w_out = (const float*)d_in[15];
    p.out = (float*)d_out; p.ws = (unsigned char*)d_ws;
    launch_mega(p, 0, 5, stream);
}
```

```cpp
#include <hip/hip_runtime.h>
#include <stdint.h>
#include <stdio.h>
#include <hip/hip_cooperative_groups.h>
namespace cg = cooperative_groups;

#define DI __device__ __forceinline__
#define LAS __attribute__((address_space(3)))
typedef unsigned short bf16_t;

constexpr int T = 16384, SEQ = 4096, NB = 4, DM = 1024, NH = 8, QK = 96, DV = 64;
constexpr int NP = 2048;
constexpr float EPS = 1e-6f;
constexpr float QSCALE = 0.10206207261596575f * 1.4426950408889634f;

constexpr size_t MiB = 1u << 20;
constexpr size_t WS_CTL = 0;
constexpr size_t WS_XB = 1 * MiB;
constexpr size_t WS_RSTDX = 33 * MiB;
constexpr size_t WS_COS = 34 * MiB;
constexpr size_t WS_SIN = 35 * MiB;
constexpr size_t WS_WINT = 36 * MiB;
constexpr size_t WS_WUQT = 41 * MiB;
constexpr size_t WS_WUKVT = 42 * MiB;
constexpr size_t WS_WOUTT = 43 * MiB;
constexpr size_t WS_WSB = 45 * MiB;
constexpr size_t WS_SSQA = 46 * MiB;
constexpr size_t WS_SSQB = 47 * MiB;
constexpr size_t WS_CQ = 48 * MiB;
constexpr size_t WS_CKV = 56 * MiB;
constexpr size_t WS_Z = 62 * MiB;
constexpr size_t WS_QIMG = 126 * MiB;
constexpr size_t WS_KIMG = 150 * MiB;
constexpr size_t WS_VIMG = 174 * MiB;
constexpr size_t WS_AMIX = 190 * MiB;
constexpr size_t WS_END = 222 * MiB;

DI float bf2f(bf16_t b) { return __uint_as_float(((unsigned)b) << 16); }
DI bf16_t f2bf(float f) { unsigned u = __float_as_uint(f); return (bf16_t)((u + 0x7fffu + ((u >> 16) & 1u)) >> 16); }
DI float gelu_tanh(float x) {
    const float y = x * (0.7978845608028654f + 0.035677408136300125f * x * x);
    return x * __builtin_amdgcn_rcpf(1.f + __builtin_amdgcn_exp2f(-2.885390081777927f * y));
}
DI float silu(float x) { return x * __builtin_amdgcn_rcpf(1.f + __builtin_amdgcn_exp2f(-1.4426950408889634f * x)); }
DI float rsqrt_fast(float x) { return __builtin_amdgcn_rsqf(x); }

DI size_t cq_idx(int t, int k) { return ((((size_t)(t >> 5) * 32 + (k >> 3)) * 32 + (t & 31)) << 3) + (k & 7); }
DI size_t ckv_idx(int t, int k) { return ((((size_t)(t >> 5) * 20 + (k >> 3)) * 32 + (t & 31)) << 3) + (k & 7); }
DI size_t qimg_idx(int bh, int s, int d) {
    const int qb = s >> 5, r = s & 31, kk = d >> 4, e = d & 15, h = (e >> 2) & 1, j = 4 * (e >> 3) + (e & 3);
    return (((((size_t)bh * 128 + qb) * 6 + kk) * 64 + (h * 32 + r)) << 3) + j;
}
DI size_t kimg_idx(int bh, int s, int d) {
    const int tile = s >> 6, c = (s >> 5) & 1, r = s & 31, kk = d >> 4, e = d & 15, h = (e >> 2) & 1, j = 4 * (e >> 3) + (e & 3);
    return ((((((size_t)bh * 64 + tile) * 6 + kk) * 2 + c) * 64 + (h * 32 + r)) << 3) + j;
}
DI size_t vimg_idx(int bh, int s, int d) {
    const int tile = s >> 6, kin = s & 63, c = kin >> 5, s2 = (kin >> 4) & 1, e = kin & 15, h = (e >> 2) & 1, j = 4 * (e >> 3) + (e & 3), dt = d >> 5, r = d & 31;
    return (((((((size_t)bh * 64 + tile) * 2 + c) * 2 + s2) * 2 + dt) * 64 + (h * 32 + r)) << 3) + j;
}

struct Ptrs {
    const float *x; const int* pos; const float *g_in, *w_in, *g_ql, *w_uq, *g_kvl, *w_ukv, *g_qh, *g_kh, *g_vg, *w_s, *b_s, *g_oa, *g_ob, *w_out;
    float* out; unsigned char* ws;
};

typedef float f32x4_t __attribute__((ext_vector_type(4)));
DI void p1_fused_q_a(const f32x4_t (&acc)[2][2][4][2], int pm, int wr, int wc, int fr, int fq, LAS unsigned char* lds, const Ptrs* pp);
DI void p1_fused_kv_a(const f32x4_t (&acc)[2][2][4][2], int pm, int wr, int wc, int fr, int fq, LAS unsigned char* lds, const Ptrs* pp);
DI void p1_fused_q_b(int pm, LAS unsigned char* lds, const Ptrs* pp, int wid, int lane);
DI void p1_fused_kv_b(int pm, LAS unsigned char* lds, const Ptrs* pp, int wid, int lane);
namespace pg8 {
#define PG8_LAS __attribute__((address_space(3)))
typedef short bf16x8 __attribute__((ext_vector_type(8)));
typedef float f32x4 __attribute__((ext_vector_type(4)));
typedef unsigned u32x4 __attribute__((ext_vector_type(4)));
constexpr int BM = 256, BK = 64, HALF = 128, HTB = HALF * BK * 2  , STAGE_BYTES = 8 * HTB, NXCD = 8, WGM = 8;

__host__ __device__ __forceinline__ int lds_byte(int r, int c) { const int st = (r >> 4) * 2 + (c >> 5), rr = r & 15, cc = c & 31, ob = rr * 64 + cc * 2; return st * 1024 + (ob ^ (((ob >> 9) & 1) << 5)); }
__host__ __device__ __forceinline__ void stage_rc(int b, int& R, int& C) { const int st = b / 1024, sb = b % 1024, swz = sb ^ (((sb >> 9) & 1) << 5); R = (st >> 1) * 16 + swz / 64; C = (st & 1) * 32 + (swz % 64) / 2; }
__host__ __device__ __forceinline__ int perm32(int rho) { const int n = rho >> 4, i = rho & 15; return 8 * (i >> 2) + 4 * n + (i & 3); }

struct Unit { int pm, pn; };
struct Gemm { const bf16_t* A; const bf16_t* Bt; int M, N, K; };

struct StaticOrder {
    int nM, nN, nwg, G, c;
    __host__ __device__ void init(int M, int N, int G_, int c_) { nM = M / BM; nN = N / BM; nwg = nM * nN; G = G_; c = c_; }
    __host__ __device__ bool next(int i, Unit& u) const {
        const long L = (long)i * G + c; if (L >= nwg) return false;
        int wgid = (int)L; { const int q = nwg / NXCD, r = nwg % NXCD, xcd = wgid % NXCD, off = wgid / NXCD; wgid = (xcd < r ? xcd * (q + 1) : r * (q + 1) + (xcd - r) * q) + off; }
        const int nig = WGM * nN, gid = wgid / nig, fm = gid * WGM, gsz = (nM - fm) < WGM ? (nM - fm) : WGM;
        u.pm = fm + ((wgid % nig) % gsz); u.pn = (wgid % nig) / gsz; return true;
    }
    __device__ __forceinline__ void a_ready(const Unit&) const {}
    __device__ __forceinline__ void done(const Unit&) const {}
};
__device__ __forceinline__ unsigned cvt_pk_bf16(float lo, float hi) { unsigned r; asm volatile("v_cvt_pk_bf16_f32 %0, %1, %2" : "=v"(r) : "v"(lo), "v"(hi)); return r; }

struct OneUnit { int pm, pn;
    __device__ __forceinline__ bool next(int i, Unit& u) const { if (i) return false; u.pm = pm; u.pn = pn; return true; }
    __device__ __forceinline__ void a_ready(const Unit&) const {}
    __device__ __forceinline__ void done(const Unit&) const {}
};
struct P1Order { StaticOrder S;
    __host__ __device__ void init(int M, int N, int G_, int c_) { S.init(M, N, G_, c_); }
    __host__ __device__ bool next(int i, Unit& u) const {
        if (i < 2) return S.next(i, u);
        if (i == 2 && S.c >= 128) { S.next(1, u); u.pn += 2; return true; }
        return false; }
    __device__ __forceinline__ void a_ready(const Unit&) const {}
    __device__ __forceinline__ void done(const Unit&) const {}
};
struct EpiProj {
    static constexpr bool PERM = true, AFTER_DRAIN = false, HAS_MID = false, FUSE_LAST = true; static constexpr int MID_T = -1;
    bf16_t *Z; const PG8_LAS float* rtab; const Ptrs* pp;
    __device__ __forceinline__ bool fused_unit(const Unit& u) const { return u.pn == 4 || u.pn == 5; }
    __device__ __forceinline__ void fused(const f32x4 (&acc)[2][2][4][2], const Unit& u, int wr, int wc, int fr, int fq, PG8_LAS unsigned char* lds, int wid, int lane) const {
        if (u.pn == 4) p1_fused_q_a(acc, u.pm, wr, wc, fr, fq, lds, pp); else p1_fused_kv_a(acc, u.pm, wr, wc, fr, fq, lds, pp);
        asm volatile("s_waitcnt lgkmcnt(0)\n\ts_barrier" ::: "memory");
        if (u.pn == 4) p1_fused_q_b(u.pm, lds, pp, wid, lane); else p1_fused_kv_b(u.pm, lds, pp, wid, lane); }
    __device__ __forceinline__ void mid(f32x4 (&)[2][2][4][2], int, int, PG8_LAS unsigned char*) const {}
    __device__ __forceinline__ void operator()(const f32x4 (&acc)[2][2][4][2], const Unit& u, int wr, int wc, int fr, int fq) const {
        const int row0 = u.pm * BM + wr * 64 + fr;
        const int zc = (u.pn < 4 ? 512 + u.pn * BM : u.pn < 8 ? u.pn * BM : (u.pn - 8) * BM);
        float rsv[2][4];
#pragma unroll
        for (int ai = 0; ai < 2; ++ai)
#pragma unroll
            for (int m = 0; m < 4; ++m) rsv[ai][m] = rtab[wr * 64 + fr + ai * HALF + m * 16];
#pragma unroll
        for (int ai = 0; ai < 2; ++ai)
#pragma unroll
            for (int m = 0; m < 4; ++m) { const int row = row0 + ai * HALF + m * 16; const float rs = rsv[ai][m];
#pragma unroll
                for (int bj = 0; bj < 2; ++bj) { const int lc = bj * HALF + wc * 32 + 8 * fq;
                    const f32x4 v0 = acc[ai][bj][m][0] * rs, v1 = acc[ai][bj][m][1] * rs;
                    u32x4 w; w.x = cvt_pk_bf16(v0[0], v0[1]); w.y = cvt_pk_bf16(v0[2], v0[3]); w.z = cvt_pk_bf16(v1[0], v1[1]); w.w = cvt_pk_bf16(v1[2], v1[3]);
                    *(u32x4*)(Z + (size_t)row * 2048 + zc + lc) = w; } }

    }
};
struct EpiOut {
    static constexpr bool PERM = false, AFTER_DRAIN = true, HAS_MID = true, FUSE_LAST = false; static constexpr int MID_T = 8;
    __device__ __forceinline__ bool fused_unit(const Unit&) const { return false; }
    __device__ __forceinline__ void fused(const f32x4 (&acc)[2][2][4][2], const Unit& u, int wr, int wc, int fr, int fq, PG8_LAS unsigned char* lds, int wid, int lane) const {
        typedef float nt4 __attribute__((ext_vector_type(4)));
        const PG8_LAS float* rstdb = (const PG8_LAS float*)(lds + STAGE_BYTES + 1024);
#pragma unroll
        for (int ai = 0; ai < 2; ++ai) {
            const size_t g0 = (size_t)(u.pm * BM + ai * HALF + wid * 16) * 1024 + u.pn * BM + 4 * lane;
            typedef unsigned nt2 __attribute__((ext_vector_type(2)));
            nt2 xv[16];
#pragma unroll
            for (int i = 0; i < 16; ++i) xv[i] = __builtin_nontemporal_load((const nt2*)(xb + g0 + (size_t)i * 1024));
#pragma unroll
            for (int m = 0; m < 4; ++m) { const int r = wr * 64 + m * 16 + fr; const float rb = rstdb[ai * HALF + r];
#pragma unroll
                for (int bj = 0; bj < 2; ++bj)
#pragma unroll
                    for (int n = 0; n < 2; ++n) { const int c = bj * 32 + wc * 8 + n * 4 + fq;
                        *(PG8_LAS f32x4*)(lds + r * 1024 + ((c ^ (r & 15)) << 4)) = acc[ai][bj][m][n] * rb; } }
            asm volatile("s_waitcnt lgkmcnt(0)\n\ts_barrier" ::: "memory");
#pragma unroll
            for (int i = 0; i < 16; ++i) { const f32x4 v = *(const PG8_LAS f32x4*)(lds + (wid * 16 + i) * 1024 + ((lane ^ i) << 4));
                const f32x4 xr = {__builtin_bit_cast(float, xv[i].x << 16), __builtin_bit_cast(float, xv[i].x & 0xffff0000u), __builtin_bit_cast(float, xv[i].y << 16), __builtin_bit_cast(float, xv[i].y & 0xffff0000u)};
                __builtin_nontemporal_store(xr + v, (nt4*)(out + g0 + (size_t)i * 1024)); }
            if (ai == 0) asm volatile("s_waitcnt lgkmcnt(0)\n\ts_barrier" ::: "memory");
        }
    }
    const float* x; float* out; PG8_LAS unsigned char* ldsb; const bf16_t* xb;
    __device__ __forceinline__ void mid(f32x4 (&acc)[2][2][4][2], int wr, int fr, PG8_LAS unsigned char* lds) const {
        const PG8_LAS float* ratio = (const PG8_LAS float*)(lds + STAGE_BYTES);
#pragma unroll
        for (int ai = 0; ai < 2; ++ai)
#pragma unroll
            for (int m = 0; m < 4; ++m) { const float r = ratio[ai * HALF + wr * 64 + m * 16 + fr];
#pragma unroll
                for (int bj = 0; bj < 2; ++bj)
#pragma unroll
                    for (int n = 0; n < 2; ++n) acc[ai][bj][m][n] = acc[ai][bj][m][n] * r; }
    }
    __device__ __forceinline__ void operator()(const f32x4 (&acc)[2][2][4][2], const Unit& u, int wr, int wc, int fr, int fq) const {
        const PG8_LAS float* rstdb = (const PG8_LAS float*)(ldsb + STAGE_BYTES + 1024);
        const int row0 = u.pm * BM + wr * 64 + fr, col0 = u.pn * BM + wc * 32 + 4 * fq;
#pragma unroll
        for (int ai = 0; ai < 2; ++ai) {
            f32x4 xv[4][2][2]; float rb[4];
#pragma unroll
            for (int m = 0; m < 4; ++m) { rb[m] = rstdb[ai * HALF + wr * 64 + m * 16 + fr]; const size_t off = (size_t)(row0 + ai * HALF + m * 16) * 1024 + col0;
#pragma unroll
                for (int bj = 0; bj < 2; ++bj)
#pragma unroll
                    for (int n = 0; n < 2; ++n) xv[m][bj][n] = __builtin_nontemporal_load((const f32x4*)(x + off + bj * HALF + n * 16)); }
#pragma unroll
            for (int m = 0; m < 4; ++m) { const size_t off = (size_t)(row0 + ai * HALF + m * 16) * 1024 + col0;
#pragma unroll
                for (int bj = 0; bj < 2; ++bj)
#pragma unroll
                    for (int n = 0; n < 2; ++n) __builtin_nontemporal_store(xv[m][bj][n] + acc[ai][bj][m][n] * rb[m], (f32x4*)(out + off + bj * HALF + n * 16)); }
        }
    }
};
template <class Epi, class Sched, bool ALIGN_EPI = false, bool SP2 = false>
__device__ __forceinline__ void gemm_phase(PG8_LAS unsigned char* lds, const Gemm g, const Sched& S, const Epi& E) {
    const int tid = threadIdx.x, wid = __builtin_amdgcn_readfirstlane(tid >> 6), lane = tid & 63, wr = wid >> 2, wc = wid & 3, fr = lane & 15, fq = lane >> 4;
    const int K = g.K, nt = K / BK;
    unsigned voffA[2], voffB[2];
#pragma unroll
    for (int i = 0; i < 2; ++i) { int R, C; stage_rc(tid * 16 + i * 8192, R, C); const int Rb = Epi::PERM ? ((R & ~31) + perm32(R & 31)) : R;
        voffA[i] = (unsigned)(R * K + C) * 2u; voffB[i] = (unsigned)(Rb * K + C) * 2u; }
    const size_t kstep = (size_t)(BK * 2);
    const size_t hstep = (size_t)HALF * K * 2;
    const size_t tstep = 2 * hstep;
    const unsigned ldsw = (unsigned)wid * 1024u;
    const int aoff = lds_byte(wr * 64 + fr, fq * 8), boff = lds_byte(wc * 32 + fr, fq * 8);
#define PG8_SA(b, h) (((b) * 2 + (h)) * HTB)
#define PG8_SB(b, h) ((4 + (b) * 2 + (h)) * HTB)
#define PG8_STAGE(bufoff, gbase, voff) do { _Pragma("unroll") for (int _i = 0; _i < 2; ++_i) \
        __builtin_amdgcn_global_load_lds((const unsigned*)((const char*)(gbase) + (voff)[_i]), (PG8_LAS unsigned*)(lds + (bufoff) + ldsw + _i * 8192), 16, 0, 0); } while (0)
#define PG8_LDA(dst, b, h) do { _Pragma("unroll") for (int m = 0; m < 4; ++m) _Pragma("unroll") for (int k = 0; k < 2; ++k) dst[m][k] = *(const PG8_LAS bf16x8*)(lds + PG8_SA(b, h) + aoff + m * 2048 + k * 1024); } while (0)
#define PG8_LDB(dst, b, h) do { _Pragma("unroll") for (int n = 0; n < 2; ++n) _Pragma("unroll") for (int k = 0; k < 2; ++k) dst[n][k] = *(const PG8_LAS bf16x8*)(lds + PG8_SB(b, h) + boff + n * 2048 + k * 1024); } while (0)
#define PG8_MMA(ai, bj, At, Bt) do { __builtin_amdgcn_s_setprio(1); _Pragma("unroll") for (int m = 0; m < 4; ++m) _Pragma("unroll") for (int n = 0; n < 2; ++n) _Pragma("unroll") for (int k = 0; k < 2; ++k) \
        acc[ai][bj][m][n] = __builtin_amdgcn_mfma_f32_16x16x32_bf16(Bt[n][k], At[m][k], acc[ai][bj][m][n], 0, 0, 0); __builtin_amdgcn_s_setprio(0); } while (0)
#define PG8_WAIT_V(n) asm volatile("s_waitcnt vmcnt(" #n ")" ::: "memory")
#define PG8_WAIT_L(n) asm volatile("s_waitcnt lgkmcnt(" #n ")" ::: "memory")
#define PG8_BAR __builtin_amdgcn_s_barrier()
#define PG8_SCHED __builtin_amdgcn_sched_barrier(0)
    Unit cur, nxt; int ui = 0;
    if (!S.next(0, cur)) return;
    f32x4 acc[2][2][4][2];
#pragma unroll
    for (int a = 0; a < 2; ++a)
#pragma unroll
        for (int b = 0; b < 2; ++b)
#pragma unroll
            for (int m = 0; m < 4; ++m)
#pragma unroll
                for (int n = 0; n < 2; ++n) acc[a][b][m][n] = (f32x4){0.f, 0.f, 0.f, 0.f};
    bf16x8 At[4][2], B0[2][2], B1[2][2];
    const char* cA = (const char*)g.A + (size_t)cur.pm * tstep; const char* cB = (const char*)g.Bt + (size_t)cur.pn * tstep;
    S.a_ready(cur);
    if constexpr (SP2) {
        PG8_STAGE(PG8_SB(0, 0), cB, voffB); PG8_STAGE(PG8_SB(0, 1), cB + hstep, voffB); PG8_STAGE(PG8_SA(0, 0), cA, voffA); PG8_STAGE(PG8_SA(0, 1), cA + hstep, voffA);
        if (wr == 1) PG8_BAR;
        PG8_WAIT_V(2); PG8_BAR;
        PG8_STAGE(PG8_SB(1, 0), cB + kstep, voffB); PG8_STAGE(PG8_SA(1, 0), cA + kstep, voffA); PG8_STAGE(PG8_SB(1, 1), cB + hstep + kstep, voffB);
        PG8_WAIT_V(6); PG8_BAR;
    } else {
        PG8_STAGE(PG8_SB(0, 0), cB, voffB); PG8_STAGE(PG8_SA(0, 0), cA, voffA); PG8_STAGE(PG8_SB(0, 1), cB + hstep, voffB); PG8_STAGE(PG8_SA(0, 1), cA + hstep, voffA);
        if (wr == 1) PG8_BAR;
        PG8_WAIT_V(4); PG8_BAR;
        PG8_STAGE(PG8_SB(1, 0), cB + kstep, voffB); PG8_STAGE(PG8_SA(1, 0), cA + kstep, voffA); PG8_STAGE(PG8_SB(1, 1), cB + hstep + kstep, voffB);
        PG8_WAIT_V(6); PG8_BAR;
    }
    for (;;) {
        const bool has_next = S.next(ui + 1, nxt);
        const char* nA = has_next ? (const char*)g.A + (size_t)nxt.pm * tstep : cA; const char* nB = has_next ? (const char*)g.Bt + (size_t)nxt.pn * tstep : cB;
        for (int t = 0; t < nt; t += 2) {
            const bool last = (t == nt - 2);
            const char* a1 = cA + (size_t)(t + 1) * kstep;
            const char* a2 = last ? nA : cA + (size_t)(t + 2) * kstep; const char* b2 = last ? nB : cB + (size_t)(t + 2) * kstep;
            const char* a3 = a2 + kstep; const char* b3 = b2 + kstep;
            if (last && has_next) S.a_ready(nxt);
            if constexpr (Epi::HAS_MID) { if (t == Epi::MID_T) { PG8_SCHED; E.mid(acc, wr, fr, lds); PG8_SCHED; } }
            if constexpr (SP2) {
            PG8_LDB(B0, 0, 0); PG8_LDB(B1, 0, 1); PG8_SCHED; PG8_LDA(At, 0, 0); PG8_STAGE(PG8_SA(1, 1), a1 + hstep, voffA);
            PG8_WAIT_V(8); PG8_WAIT_L(0); PG8_BAR; PG8_MMA(0, 0, At, B0); PG8_MMA(0, 1, At, B1); PG8_BAR; PG8_SCHED;
            PG8_LDA(At, 0, 1); PG8_STAGE(PG8_SB(0, 0), b2, voffB); PG8_STAGE(PG8_SB(0, 1), b2 + hstep, voffB); PG8_STAGE(PG8_SA(0, 0), a2, voffA);
            PG8_WAIT_V(8); PG8_WAIT_L(0); PG8_BAR; PG8_MMA(1, 0, At, B0); PG8_MMA(1, 1, At, B1); PG8_BAR; PG8_SCHED;
            PG8_LDB(B0, 1, 0); PG8_LDB(B1, 1, 1); PG8_SCHED; PG8_LDA(At, 1, 0); PG8_STAGE(PG8_SA(0, 1), a2 + hstep, voffA);
            PG8_WAIT_V(8); PG8_WAIT_L(0); PG8_BAR; PG8_MMA(0, 0, At, B0); PG8_MMA(0, 1, At, B1); PG8_BAR; PG8_SCHED;
            PG8_LDA(At, 1, 1); PG8_STAGE(PG8_SB(1, 0), b3, voffB); PG8_STAGE(PG8_SB(1, 1), b3 + hstep, voffB); PG8_STAGE(PG8_SA(1, 0), a3, voffA);
            PG8_WAIT_V(8); PG8_WAIT_L(0); PG8_BAR; PG8_MMA(1, 0, At, B0); PG8_MMA(1, 1, At, B1); PG8_BAR; PG8_SCHED;
            } else {
            PG8_LDB(B0, 0, 0); PG8_SCHED; PG8_LDA(At, 0, 0); PG8_STAGE(PG8_SA(1, 1), a1 + hstep, voffA);
            PG8_WAIT_L(8); PG8_BAR; PG8_WAIT_L(0); PG8_MMA(0, 0, At, B0); PG8_BAR; PG8_SCHED;
            PG8_LDB(B1, 0, 1); PG8_STAGE(PG8_SB(0, 0), b2, voffB);
            PG8_BAR; PG8_WAIT_L(0); PG8_MMA(0, 1, At, B1); PG8_BAR;
            PG8_LDA(At, 0, 1); PG8_STAGE(PG8_SA(0, 0), a2, voffA);
            PG8_BAR; PG8_WAIT_L(0); PG8_MMA(1, 0, At, B0); PG8_BAR; PG8_SCHED;
            PG8_STAGE(PG8_SB(0, 1), b2 + hstep, voffB);
            PG8_WAIT_V(6); PG8_BAR; PG8_MMA(1, 1, At, B1); PG8_BAR;
            PG8_LDB(B0, 1, 0); PG8_SCHED; PG8_LDA(At, 1, 0); PG8_STAGE(PG8_SA(0, 1), a2 + hstep, voffA);
            PG8_WAIT_L(8); PG8_BAR; PG8_WAIT_L(0); PG8_MMA(0, 0, At, B0); PG8_BAR; PG8_SCHED;
            PG8_LDB(B1, 1, 1); PG8_STAGE(PG8_SB(1, 0), b3, voffB);
            PG8_BAR; PG8_WAIT_L(0); PG8_MMA(0, 1, At, B1); PG8_BAR;
            PG8_LDA(At, 1, 1); PG8_STAGE(PG8_SA(1, 0), a3, voffA);
            PG8_BAR; PG8_WAIT_L(0); PG8_MMA(1, 0, At, B0); PG8_BAR; PG8_SCHED;
            PG8_STAGE(PG8_SB(1, 1), b3 + hstep, voffB);
            PG8_WAIT_V(6); PG8_BAR; PG8_MMA(1, 1, At, B1); PG8_BAR;
            }
        }
        if constexpr (ALIGN_EPI) { if (wr == 0) PG8_BAR; }
        if constexpr (Epi::FUSE_LAST) { if (has_next || !E.fused_unit(cur)) E(acc, cur, wr, wc, fr, fq); S.done(cur); }
        else if constexpr (!Epi::AFTER_DRAIN) { E(acc, cur, wr, wc, fr, fq); S.done(cur); }
        if (!has_next) break;
#pragma unroll
        for (int a = 0; a < 2; ++a)
#pragma unroll
            for (int b = 0; b < 2; ++b)
#pragma unroll
                for (int m = 0; m < 4; ++m)
#pragma unroll
                    for (int n = 0; n < 2; ++n) acc[a][b][m][n] = (f32x4){0.f, 0.f, 0.f, 0.f};
        cur = nxt; cA = nA; cB = nB; ++ui;
        if constexpr (ALIGN_EPI) { if (wr == 1) PG8_BAR; }
    }
    PG8_WAIT_V(0);
    if constexpr (!ALIGN_EPI) { if (wr == 0) PG8_BAR; }
    PG8_BAR;
    if constexpr (Epi::FUSE_LAST) { if (E.fused_unit(cur)) E.fused(acc, cur, wr, wc, fr, fq, lds, wid, lane); }
    else if constexpr (Epi::AFTER_DRAIN) { E.fused(acc, cur, wr, wc, fr, fq, lds, wid, lane); S.done(cur); }
#undef PG8_SA
#undef PG8_SB
#undef PG8_STAGE
#undef PG8_LDA
#undef PG8_LDB
#undef PG8_MMA
#undef PG8_WAIT_V
#undef PG8_WAIT_L
#undef PG8_BAR
#undef PG8_SCHED
}
}


namespace att {
typedef short bf16x8 __attribute__((ext_vector_type(8)));
typedef float f32x16 __attribute__((ext_vector_type(16)));
typedef float f32x2_t __attribute__((ext_vector_type(2))); typedef __bf16 bf16x2_t __attribute__((ext_vector_type(2)));
DI unsigned cvtpk(float lo, float hi) { f32x2_t v = {lo, hi}; bf16x2_t b = __builtin_convertvector(v, bf16x2_t); return __builtin_bit_cast(unsigned, b); }
DI void glds16(const void* gsrc, unsigned lds_dst) { unsigned keep;
    asm volatile("s_mov_b32 %0, m0\n\ts_mov_b32 m0, %2\n\ts_nop 0\n\tglobal_load_lds_dwordx4 %1, off\n\ts_mov_b32 m0, %0" : "=&s"(keep) : "v"(gsrc), "s"(lds_dst) : "memory"); }
constexpr int SLOTB = 20480, KBYTES = 12288, VBYTES = 8192;
#define MFMA32(a, b, c) __builtin_amdgcn_mfma_f32_32x32x16_bf16((a), (b), (c), 0, 0, 0)
DI void attn_epi64(const Ptrs& p, const f32x16& o0, const f32x16& o1, float lsum, int bh, int q0, int lane) {
    const int r = lane & 31, h = lane >> 5;
    lsum += __shfl_xor(lsum, 32);
    const float rl = __builtin_amdgcn_rcpf(lsum);
    const int b = bh >> 3, hd = bh & 7, t = b * SEQ + q0 + r;
    const bf16_t* Z = (const bf16_t*)(p.ws + WS_Z) + (size_t)t * 2048 + hd * 64 + 4 * h;
    bf16_t* A = (bf16_t*)(p.ws + WS_AMIX) + (size_t)t * 1024 + hd * 64 + 4 * h;
    float sq = 0.f;
    uint2 zld[2][4];
#pragma unroll
    for (int dt = 0; dt < 2; ++dt)
#pragma unroll
        for (int g = 0; g < 4; ++g) zld[dt][g] = *(const uint2*)(Z + 32 * dt + 8 * g);
#pragma unroll
    for (int dt = 0; dt < 2; ++dt)
#pragma unroll
        for (int g = 0; g < 4; ++g) {
            const uint2 zz2 = zld[dt][g];
            float ov[4];
#pragma unroll
            for (int e = 0; e < 4; ++e) { ov[e] = (dt ? o1[4 * g + e] : o0[4 * g + e]) * rl; sq += ov[e] * ov[e]; }
            const float z0 = __uint_as_float(zz2.x << 16), z1 = __uint_as_float(zz2.x & 0xffff0000u), z2 = __uint_as_float(zz2.y << 16), z3 = __uint_as_float(zz2.y & 0xffff0000u);
            uint2 w; w.x = cvtpk(ov[0] * silu(z0), ov[1] * silu(z1)); w.y = cvtpk(ov[2] * silu(z2), ov[3] * silu(z3));
            *(uint2*)(A + 32 * dt + 8 * g) = w;
        }
    sq += __shfl_xor(sq, 32);
    if (h == 0) ((float*)(p.ws + WS_SSQA))[(size_t)hd * T + t] = sq;
}
DI void attn_unit64(LAS unsigned char* lds, const Ptrs& p, int bh, int qb512, int wid, int lane) {
    const unsigned lds0 = (unsigned)(uintptr_t)lds;
    const unsigned char* Kg = p.ws + WS_KIMG + (size_t)bh * 64 * KBYTES + lane * 16;
    const unsigned char* Vg = p.ws + WS_VIMG + (size_t)bh * 64 * VBYTES + lane * 16;
    const bf16x8* Qg = (const bf16x8*)(p.ws + WS_QIMG + ((size_t)(bh * 128 + qb512 * 16 + 2 * wid) * 6 * 64 + lane) * 16);
    bf16x8 qa[6], qb[6];
#pragma unroll
    for (int kk = 0; kk < 6; ++kk) { qa[kk] = Qg[kk * 64]; qb[kk] = Qg[(6 + kk) * 64]; }
#define ATT_DMA(t, slotoff) do { const unsigned char* kt_ = Kg + (size_t)(t) * KBYTES; const unsigned char* vt_ = Vg + (size_t)(t) * VBYTES; \
        glds16(kt_ + wid * 1024, (unsigned)__builtin_amdgcn_readfirstlane(lds0 + (slotoff) + wid * 1024)); \
        if (wid < 4) { glds16(kt_ + (wid + 8) * 1024, (unsigned)__builtin_amdgcn_readfirstlane(lds0 + (slotoff) + (wid + 8) * 1024)); \
                       glds16(vt_ + (wid + 4) * 1024, (unsigned)__builtin_amdgcn_readfirstlane(lds0 + (slotoff) + KBYTES + (wid + 4) * 1024)); } \
        else glds16(vt_ + (wid - 4) * 1024, (unsigned)__builtin_amdgcn_readfirstlane(lds0 + (slotoff) + KBYTES + (wid - 4) * 1024)); } while (0)
#define ATT_WAIT_MINE() do { if (wid < 4) asm volatile("s_waitcnt vmcnt(3) lgkmcnt(0)\n\ts_barrier" ::: "memory"); else asm volatile("s_waitcnt vmcnt(2) lgkmcnt(0)\n\ts_barrier" ::: "memory"); } while (0)
#define ATT_WAIT_ALL() asm volatile("s_waitcnt vmcnt(0) lgkmcnt(0)\n\ts_barrier" ::: "memory")
#define SBAR() __builtin_amdgcn_sched_barrier(0)
#define EX(v) __builtin_amdgcn_exp2f(v)
#define LD(ptr) (*(const LAS bf16x8*)(ptr))
#define MF(a, b, c) MFMA32((a), (b), (c))
    ATT_DMA(0, 0); ATT_DMA(1, SLOTB); ATT_DMA(2, 2 * SLOTB); ATT_DMA(3, 3 * SLOTB);
    ATT_WAIT_ALL();
    f32x16 OA0, OA1, OB0, OB1, SA0, SA1, SB0, SB1, zz;
#pragma unroll
    for (int i = 0; i < 16; ++i) { OA0[i] = 0.f; OA1[i] = 0.f; OB0[i] = 0.f; OB1[i] = 0.f; zz[i] = 0.f; }
    float lsA = 0.f, lsB = 0.f;
    uint4 pA0_0, pA0_1, pA1_0, pA1_1, pB0_0, pB0_1, pB1_0, pB1_1;
    bf16x8 fr0, fr1, fr2, fr3;
    {
        const LAS unsigned char* kp0 = lds + lane * 16;
        SA0 = zz; SA1 = zz; SB0 = zz; SB1 = zz;
#pragma unroll
        for (int kk = 0; kk < 6; ++kk) { const bf16x8 k0 = LD(kp0 + (2 * kk) * 1024), k1 = LD(kp0 + (2 * kk + 1) * 1024);
            SA0 = MFMA32(k0, qa[kk], SA0); SA1 = MFMA32(k1, qa[kk], SA1); SB0 = MFMA32(k0, qb[kk], SB0); SB1 = MFMA32(k1, qb[kk], SB1); }
#pragma unroll
        for (int i = 0; i < 16; ++i) { SA0[i] = EX(SA0[i]); SB0[i] = EX(SB0[i]); lsA += SA0[i]; lsB += SB0[i]; }
        pA0_0 = make_uint4(cvtpk(SA0[0], SA0[1]), cvtpk(SA0[2], SA0[3]), cvtpk(SA0[4], SA0[5]), cvtpk(SA0[6], SA0[7]));
        pA0_1 = make_uint4(cvtpk(SA0[8], SA0[9]), cvtpk(SA0[10], SA0[11]), cvtpk(SA0[12], SA0[13]), cvtpk(SA0[14], SA0[15]));
        pB0_0 = make_uint4(cvtpk(SB0[0], SB0[1]), cvtpk(SB0[2], SB0[3]), cvtpk(SB0[4], SB0[5]), cvtpk(SB0[6], SB0[7]));
        pB0_1 = make_uint4(cvtpk(SB0[8], SB0[9]), cvtpk(SB0[10], SB0[11]), cvtpk(SB0[12], SB0[13]), cvtpk(SB0[14], SB0[15]));
        fr0 = LD(kp0 + SLOTB + 0 * 1024); fr1 = LD(kp0 + SLOTB + 2 * 1024);
        pA1_0 = pA0_0; pA1_1 = pA0_1; pB1_0 = pB0_0; pB1_1 = pB0_1; fr2 = fr0; fr3 = fr1;
    }
    int off_v = 0, off_k1 = SLOTB, off_k2 = 2 * SLOTB, off_d = 4 * SLOTB, off_d2 = 5 * SLOTB;
#define A64H_STEP(LAST, ODD) do { \
        if (!(ODD)) { if (t + 4 < 64) ATT_DMA(t + 4, off_d); if (t + 5 < 64) ATT_DMA(t + 5, off_d2); } \
        const LAS unsigned char* vp_ = lds + off_v + KBYTES + lane * 16; const LAS unsigned char* kp_ = lds + off_k1 + lane * 16; const LAS unsigned char* kn_ = lds + off_k2 + lane * 16; \
        float la_ = 0.f, lb_ = 0.f; SBAR(); \
        if (!(LAST)) SA0 = MF(fr0, qa[0], zz); fr2 = LD(kp_ + 4096); SA1[0] = EX(SA1[0]); SA1[1] = EX(SA1[1]); SA1[2] = EX(SA1[2]); SBAR(); \
        if (!(LAST)) SB0 = MF(fr0, qb[0], zz); SA1[3] = EX(SA1[3]); SA1[4] = EX(SA1[4]); SA1[5] = EX(SA1[5]); SBAR(); \
        if (!(LAST)) SA0 = MF(fr1, qa[1], SA0); fr3 = LD(kp_ + 6144); SA1[6] = EX(SA1[6]); SA1[7] = EX(SA1[7]); SA1[8] = EX(SA1[8]); SBAR(); \
        if (!(LAST)) SB0 = MF(fr1, qb[1], SB0); SA1[9] = EX(SA1[9]); SA1[10] = EX(SA1[10]); SA1[11] = EX(SA1[11]); SBAR(); \
        if (!(LAST)) SA0 = MF(fr2, qa[2], SA0); fr0 = LD(kp_ + 8192); SA1[12] = EX(SA1[12]); SA1[13] = EX(SA1[13]); SA1[14] = EX(SA1[14]); SBAR(); \
        if (!(LAST)) SB0 = MF(fr2, qb[2], SB0); SA1[15] = EX(SA1[15]); SB1[0] = EX(SB1[0]); SB1[1] = EX(SB1[1]); SBAR(); \
        if (!(LAST)) SA0 = MF(fr3, qa[3], SA0); fr1 = LD(kp_ + 10240); SB1[2] = EX(SB1[2]); SB1[3] = EX(SB1[3]); SB1[4] = EX(SB1[4]); SBAR(); \
        if (!(LAST)) SB0 = MF(fr3, qb[3], SB0); SB1[5] = EX(SB1[5]); SB1[6] = EX(SB1[6]); SB1[7] = EX(SB1[7]); SBAR(); \
        if (!(LAST)) SA0 = MF(fr0, qa[4], SA0); fr2 = LD(vp_ + 0); SB1[8] = EX(SB1[8]); SB1[9] = EX(SB1[9]); SBAR(); \
        if (!(LAST)) SB0 = MF(fr0, qb[4], SB0); SB1[10] = EX(SB1[10]); SB1[11] = EX(SB1[11]); SBAR(); \
        if (!(LAST)) SA0 = MF(fr1, qa[5], SA0); fr3 = LD(vp_ + 1024); SB1[12] = EX(SB1[12]); SB1[13] = EX(SB1[13]); SBAR(); \
        if (!(LAST)) SB0 = MF(fr1, qb[5], SB0); SB1[14] = EX(SB1[14]); SB1[15] = EX(SB1[15]); SBAR(); \
        OA0 = MF(fr2, __builtin_bit_cast(bf16x8, pA0_0), OA0); fr0 = LD(vp_ + 2048); pA1_0.x = cvtpk(SA1[0], SA1[1]); pA1_0.y = cvtpk(SA1[2], SA1[3]); la_ += SA1[0]; la_ += SA1[1]; la_ += SA1[2]; la_ += SA1[3]; asm volatile("" : "+v"(la_), "+v"(lb_)); SBAR(); \
        OB0 = MF(fr2, __builtin_bit_cast(bf16x8, pB0_0), OB0); pA1_0.z = cvtpk(SA1[4], SA1[5]); pA1_0.w = cvtpk(SA1[6], SA1[7]); la_ += SA1[4]; la_ += SA1[5]; la_ += SA1[6]; la_ += SA1[7]; asm volatile("" : "+v"(la_), "+v"(lb_)); SBAR(); \
        OA1 = MF(fr3, __builtin_bit_cast(bf16x8, pA0_0), OA1); fr1 = LD(vp_ + 3072); pA1_1.x = cvtpk(SA1[8], SA1[9]); pA1_1.y = cvtpk(SA1[10], SA1[11]); la_ += SA1[8]; la_ += SA1[9]; la_ += SA1[10]; la_ += SA1[11]; asm volatile("" : "+v"(la_), "+v"(lb_)); SBAR(); \
        OB1 = MF(fr3, __builtin_bit_cast(bf16x8, pB0_0), OB1); pA1_1.z = cvtpk(SA1[12], SA1[13]); pA1_1.w = cvtpk(SA1[14], SA1[15]); la_ += SA1[12]; la_ += SA1[13]; la_ += SA1[14]; la_ += SA1[15]; asm volatile("" : "+v"(la_), "+v"(lb_)); SBAR(); \
        OA0 = MF(fr0, __builtin_bit_cast(bf16x8, pA0_1), OA0); fr2 = LD(kp_ + 1024); pB1_0.x = cvtpk(SB1[0], SB1[1]); pB1_0.y = cvtpk(SB1[2], SB1[3]); lb_ += SB1[0]; lb_ += SB1[1]; lb_ += SB1[2]; lb_ += SB1[3]; asm volatile("" : "+v"(la_), "+v"(lb_)); SBAR(); \
        OB0 = MF(fr0, __builtin_bit_cast(bf16x8, pB0_1), OB0); pB1_0.z = cvtpk(SB1[4], SB1[5]); pB1_0.w = cvtpk(SB1[6], SB1[7]); lb_ += SB1[4]; lb_ += SB1[5]; lb_ += SB1[6]; lb_ += SB1[7]; asm volatile("" : "+v"(la_), "+v"(lb_)); SBAR(); \
        OA1 = MF(fr1, __builtin_bit_cast(bf16x8, pA0_1), OA1); fr3 = LD(kp_ + 3072); pB1_1.x = cvtpk(SB1[8], SB1[9]); pB1_1.y = cvtpk(SB1[10], SB1[11]); lb_ += SB1[8]; lb_ += SB1[9]; lb_ += SB1[10]; lb_ += SB1[11]; asm volatile("" : "+v"(la_), "+v"(lb_)); SBAR(); \
        OB1 = MF(fr1, __builtin_bit_cast(bf16x8, pB0_1), OB1); pB1_1.z = cvtpk(SB1[12], SB1[13]); pB1_1.w = cvtpk(SB1[14], SB1[15]); lb_ += SB1[12]; lb_ += SB1[13]; lb_ += SB1[14]; lb_ += SB1[15]; asm volatile("" : "+v"(la_), "+v"(lb_)); SBAR(); \
        if (!(LAST)) SA1 = MF(fr2, qa[0], zz); fr0 = LD(kp_ + 5120); if (!(LAST)) { SA0[0] = EX(SA0[0]); SA0[1] = EX(SA0[1]); SA0[2] = EX(SA0[2]); } SBAR(); \
        if (!(LAST)) SB1 = MF(fr2, qb[0], zz); if (!(LAST)) { SA0[3] = EX(SA0[3]); SA0[4] = EX(SA0[4]); SA0[5] = EX(SA0[5]); } SBAR(); \
        if (!(LAST)) SA1 = MF(fr3, qa[1], SA1); fr1 = LD(kp_ + 7168); if (!(LAST)) { SA0[6] = EX(SA0[6]); SA0[7] = EX(SA0[7]); SA0[8] = EX(SA0[8]); } SBAR(); \
        if (!(LAST)) SB1 = MF(fr3, qb[1], SB1); if (!(LAST)) { SA0[9] = EX(SA0[9]); SA0[10] = EX(SA0[10]); SA0[11] = EX(SA0[11]); } SBAR(); \
        if (!(LAST)) SA1 = MF(fr0, qa[2], SA1); fr2 = LD(kp_ + 9216); if (!(LAST)) { SA0[12] = EX(SA0[12]); SA0[13] = EX(SA0[13]); SA0[14] = EX(SA0[14]); } SBAR(); \
        if (!(LAST)) SB1 = MF(fr0, qb[2], SB1); if (!(LAST)) { SA0[15] = EX(SA0[15]); SB0[0] = EX(SB0[0]); SB0[1] = EX(SB0[1]); } SBAR(); \
        if (!(LAST)) SA1 = MF(fr1, qa[3], SA1); fr3 = LD(kp_ + 11264); if (!(LAST)) { SB0[2] = EX(SB0[2]); SB0[3] = EX(SB0[3]); SB0[4] = EX(SB0[4]); } SBAR(); \
        if (!(LAST)) SB1 = MF(fr1, qb[3], SB1); if (!(LAST)) { SB0[5] = EX(SB0[5]); SB0[6] = EX(SB0[6]); SB0[7] = EX(SB0[7]); } SBAR(); \
        if (!(LAST)) SA1 = MF(fr2, qa[4], SA1); fr0 = LD(vp_ + 4096); if (!(LAST)) { SB0[8] = EX(SB0[8]); SB0[9] = EX(SB0[9]); } SBAR(); \
        if (!(LAST)) SB1 = MF(fr2, qb[4], SB1); if (!(LAST)) { SB0[10] = EX(SB0[10]); SB0[11] = EX(SB0[11]); } SBAR(); \
        if (!(LAST)) SA1 = MF(fr3, qa[5], SA1); fr1 = LD(vp_ + 5120); if (!(LAST)) { SB0[12] = EX(SB0[12]); SB0[13] = EX(SB0[13]); } SBAR(); \
        if (!(LAST)) SB1 = MF(fr3, qb[5], SB1); if (!(LAST)) { SB0[14] = EX(SB0[14]); SB0[15] = EX(SB0[15]); } SBAR(); \
        OA0 = MF(fr0, __builtin_bit_cast(bf16x8, pA1_0), OA0); fr2 = LD(vp_ + 6144); if (!(LAST)) { pA0_0.x = cvtpk(SA0[0], SA0[1]); pA0_0.y = cvtpk(SA0[2], SA0[3]); la_ += SA0[0]; la_ += SA0[1]; la_ += SA0[2]; la_ += SA0[3]; asm volatile("" : "+v"(la_), "+v"(lb_), "+v"(pA0_0.x), "+v"(pA0_0.y)); } SBAR(); \
        OB0 = MF(fr0, __builtin_bit_cast(bf16x8, pB1_0), OB0); if (!(LAST)) { pA0_0.z = cvtpk(SA0[4], SA0[5]); pA0_0.w = cvtpk(SA0[6], SA0[7]); la_ += SA0[4]; la_ += SA0[5]; la_ += SA0[6]; la_ += SA0[7]; asm volatile("" : "+v"(la_), "+v"(lb_), "+v"(pA0_0.z), "+v"(pA0_0.w)); } SBAR(); \
        OA1 = MF(fr1, __builtin_bit_cast(bf16x8, pA1_0), OA1); fr3 = LD(vp_ + 7168); if (!(LAST)) { pA0_1.x = cvtpk(SA0[8], SA0[9]); pA0_1.y = cvtpk(SA0[10], SA0[11]); la_ += SA0[8]; la_ += SA0[9]; la_ += SA0[10]; la_ += SA0[11]; asm volatile("" : "+v"(la_), "+v"(lb_), "+v"(pA0_1.x), "+v"(pA0_1.y)); } SBAR(); \
        OB1 = MF(fr1, __builtin_bit_cast(bf16x8, pB1_0), OB1); if (!(LAST)) { pA0_1.z = cvtpk(SA0[12], SA0[13]); pA0_1.w = cvtpk(SA0[14], SA0[15]); la_ += SA0[12]; la_ += SA0[13]; la_ += SA0[14]; la_ += SA0[15]; asm volatile("" : "+v"(la_), "+v"(lb_), "+v"(pA0_1.z), "+v"(pA0_1.w)); } SBAR(); \
        OA0 = MF(fr2, __builtin_bit_cast(bf16x8, pA1_1), OA0); if (!(LAST) || 20 < 20) fr0 = LD(kn_ + 0); if (!(LAST)) { pB0_0.x = cvtpk(SB0[0], SB0[1]); pB0_0.y = cvtpk(SB0[2], SB0[3]); lb_ += SB0[0]; lb_ += SB0[1]; lb_ += SB0[2]; lb_ += SB0[3]; asm volatile("" : "+v"(la_), "+v"(lb_), "+v"(pB0_0.x), "+v"(pB0_0.y)); } SBAR(); \
        OB0 = MF(fr2, __builtin_bit_cast(bf16x8, pB1_1), OB0); if (!(LAST)) { pB0_0.z = cvtpk(SB0[4], SB0[5]); pB0_0.w = cvtpk(SB0[6], SB0[7]); lb_ += SB0[4]; lb_ += SB0[5]; lb_ += SB0[6]; lb_ += SB0[7]; asm volatile("" : "+v"(la_), "+v"(lb_), "+v"(pB0_0.z), "+v"(pB0_0.w)); } SBAR(); \
        OA1 = MF(fr3, __builtin_bit_cast(bf16x8, pA1_1), OA1); if (!(LAST) || 21 < 20) fr1 = LD(kn_ + 2048); if (!(LAST)) { pB0_1.x = cvtpk(SB0[8], SB0[9]); pB0_1.y = cvtpk(SB0[10], SB0[11]); lb_ += SB0[8]; lb_ += SB0[9]; lb_ += SB0[10]; lb_ += SB0[11]; asm volatile("" : "+v"(la_), "+v"(lb_), "+v"(pB0_1.x), "+v"(pB0_1.y)); } SBAR(); \
        OB1 = MF(fr3, __builtin_bit_cast(bf16x8, pB1_1), OB1); if (!(LAST)) { pB0_1.z = cvtpk(SB0[12], SB0[13]); pB0_1.w = cvtpk(SB0[14], SB0[15]); lb_ += SB0[12]; lb_ += SB0[13]; lb_ += SB0[14]; lb_ += SB0[15]; asm volatile("" : "+v"(la_), "+v"(lb_), "+v"(pB0_1.z), "+v"(pB0_1.w)); } SBAR(); \
        lsA += la_; lsB += lb_; \
        if (ODD) ATT_WAIT_ALL(); \
        off_v = off_k1; off_k1 = off_k2; off_k2 = (off_k2 == 5 * SLOTB) ? 0 : off_k2 + SLOTB; off_d = off_d2; off_d2 = (off_d2 == 5 * SLOTB) ? 0 : off_d2 + SLOTB; \
    } while (0)
    int t = 0;
    for (; t < 62; t += 2) { A64H_STEP(false, false); A64H_STEP(false, true); }
    A64H_STEP(false, false); A64H_STEP(true, true);
    const int q0 = qb512 * 512 + wid * 64;
    attn_epi64(p, OA0, OA1, lsA, bh, q0, lane);
    attn_epi64(p, OB0, OB1, lsB, bh, q0 + 32, lane);
    asm volatile("s_waitcnt vmcnt(0) lgkmcnt(0)\n\ts_barrier" ::: "memory");
#undef ATT_DMA
#undef ATT_WAIT_MINE
#undef ATT_WAIT_ALL
#undef A64H_STEP
#undef SBAR
#undef EX
#undef LD
#undef MF
}
DI void attn_phase64(LAS unsigned char* lds, const Ptrs& p, int vcu, int G) {
    const int lane = threadIdx.x & 63, wid = __builtin_amdgcn_readfirstlane(threadIdx.x >> 6);
    for (int U = vcu; U < 256; U += G) attn_unit64(lds, p, U >> 3, U & 7, wid, lane);
}
}


namespace p2 {
typedef short bf16x8 __attribute__((ext_vector_type(8)));
typedef short s16x4 __attribute__((ext_vector_type(4)));
typedef unsigned u32x4v __attribute__((ext_vector_type(4)));
typedef float f32x16 __attribute__((ext_vector_type(16)));
using att::cvtpk; using att::glds16;
DI int crow(int i, int h) { return (i & 3) + 8 * (i >> 2) + 4 * h; }
DI float lo16(unsigned u) { return __uint_as_float(u << 16); }
DI float hi16(unsigned u) { return __uint_as_float(u & 0xffff0000u); }
DI float frag_ssq(const bf16x8& f) { const uint4 u = __builtin_bit_cast(uint4, f); float s = 0.f;
    s += lo16(u.x) * lo16(u.x) + hi16(u.x) * hi16(u.x); s += lo16(u.y) * lo16(u.y) + hi16(u.y) * hi16(u.y);
    s += lo16(u.z) * lo16(u.z) + hi16(u.z) * hi16(u.z); s += lo16(u.w) * lo16(u.w) + hi16(u.w) * hi16(u.w); return s; }
DI bf16x8 frag_scale(const bf16x8& f, float sc) { const uint4 u = __builtin_bit_cast(uint4, f); uint4 o;
    o.x = cvtpk(lo16(u.x) * sc, hi16(u.x) * sc); o.y = cvtpk(lo16(u.y) * sc, hi16(u.y) * sc); o.z = cvtpk(lo16(u.z) * sc, hi16(u.z) * sc); o.w = cvtpk(lo16(u.w) * sc, hi16(u.w) * sc);
    return __builtin_bit_cast(bf16x8, o); }
DI uint4 pack8(const f32x16& a, int g, float sc, const float (&gv)[16]) {
    float v[8];
#pragma unroll
    for (int j = 0; j < 8; ++j) v[j] = a[8 * g + j] * sc * gv[8 * g + j];
    uint4 o; o.x = cvtpk(v[0], v[1]); o.y = cvtpk(v[2], v[3]); o.z = cvtpk(v[4], v[5]); o.w = cvtpk(v[6], v[7]); return o;
}
DI uint4 pack8n(const f32x16& a, int g, float sc) {
    uint4 o; o.x = cvtpk(a[8 * g + 0] * sc, a[8 * g + 1] * sc); o.y = cvtpk(a[8 * g + 2] * sc, a[8 * g + 3] * sc); o.z = cvtpk(a[8 * g + 4] * sc, a[8 * g + 5] * sc); o.w = cvtpk(a[8 * g + 6] * sc, a[8 * g + 7] * sc); return o;
}
DI s16x4 vtr(const LAS unsigned char* q) { return __builtin_bit_cast(s16x4, __builtin_amdgcn_ds_read_tr16_b64_v4i16((LAS s16x4*)q)); }
DI void glds16s(const void* sbase, unsigned voff, unsigned lds_dst) { unsigned keep;
    asm volatile("s_mov_b32 %0, m0\n\ts_mov_b32 m0, %3\n\ts_nop 0\n\tglobal_load_lds_dwordx4 %1, %2\n\ts_mov_b32 m0, %0" : "=&s"(keep) : "v"(voff), "s"(sbase), "s"(lds_dst) : "memory"); }
template <int NP8> DI void dma_copy(const unsigned char* gsrc, unsigned lds_dst, int wid, int lane) {
    const unsigned voff = (unsigned)(wid * 1024 + lane * 16);
#pragma unroll
    for (int i = 0; i < NP8; ++i) glds16s(gsrc + (size_t)i * 8192, voff, (unsigned)__builtin_amdgcn_readfirstlane(lds_dst + (i * 8 + wid) * 1024));
}
#define P2_BAR_V(N) asm volatile("s_waitcnt vmcnt(" #N ") lgkmcnt(0)\n\ts_barrier" ::: "memory")

DI void q_head(const Ptrs& p, const LAS unsigned char* wb, const bf16x8 (&cf)[16], float rq, const float (&cs)[8], const float (&sn)[8], int bh, int qblk, int lane) {
    const int h = lane >> 5;
    f32x16 acc[3];
#pragma unroll
    for (int nt = 0; nt < 3; ++nt) {
#pragma unroll
        for (int i = 0; i < 16; ++i) acc[nt][i] = 0.f;
#pragma unroll
        for (int ks = 0; ks < 16; ++ks) acc[nt] = MFMA32(*(const LAS bf16x8*)(wb + (nt * 16 + ks) * 1024 + lane * 16), cf[ks], acc[nt]);
    }
#pragma unroll
    for (int nt = 0; nt < 3; ++nt)
#pragma unroll
        for (int i = 0; i < 16; ++i) acc[nt][i] *= rq;
#pragma unroll
    for (int i = 0; i < 8; ++i) { const float a = acc[2][i], bb = acc[2][i + 8]; acc[2][i] = a * cs[i] - bb * sn[i]; acc[2][i + 8] = bb * cs[i] + a * sn[i]; }
    float sh = 0.f;
#pragma unroll
    for (int nt = 0; nt < 3; ++nt)
#pragma unroll
        for (int i = 0; i < 16; ++i) sh += acc[nt][i] * acc[nt][i];
    sh += __shfl_xor(sh, 32);
    const float rh = QSCALE * rsqrt_fast(sh * (1.f / 96.f) + EPS);
    uint4* dst = (uint4*)(p.ws + WS_QIMG) + ((size_t)(bh * 128 + qblk) * 6) * 64 + lane;
#pragma unroll
    for (int nt = 0; nt < 3; ++nt)
#pragma unroll
        for (int g = 0; g < 2; ++g) dst[(2 * nt + g) * 64] = pack8n(acc[nt], g, rh);
}
DI void kv_head(const Ptrs& p, const LAS unsigned char* wb, const bf16x8 (&cf)[8], const f32x16& kpe, float sspe, const float (&gk)[3][16], int bh, int tile, int c, int lane) {
    const int h = lane >> 5;
    f32x16 acc[2];
#pragma unroll
    for (int nt = 0; nt < 2; ++nt) {
#pragma unroll
        for (int i = 0; i < 16; ++i) acc[nt][i] = 0.f;
#pragma unroll
        for (int ks = 0; ks < 8; ++ks) acc[nt] = MFMA32(*(const LAS bf16x8*)(wb + (nt * 8 + ks) * 1024 + lane * 16), cf[ks], acc[nt]);
    }
    float sk = sspe;
#pragma unroll
    for (int nt = 0; nt < 2; ++nt)
#pragma unroll
        for (int i = 0; i < 16; ++i) sk += acc[nt][i] * acc[nt][i];
    sk += __shfl_xor(sk, 32);
    const float rk = rsqrt_fast(sk * (1.f / 96.f) + EPS);
    uint4* kd = (uint4*)(p.ws + WS_KIMG) + (size_t)(bh * 64 + tile) * 6 * 2 * 64 + c * 64 + lane;
#pragma unroll
    for (int nt = 0; nt < 2; ++nt)
#pragma unroll
        for (int g = 0; g < 2; ++g) kd[(2 * nt + g) * 128] = pack8(acc[nt], g, rk, gk[nt]);
#pragma unroll
    for (int g = 0; g < 2; ++g) kd[(4 + g) * 128] = pack8(kpe, g, rk, gk[2]);
    uint4* vd = (uint4*)(p.ws + WS_VIMG) + (size_t)(bh * 64 + tile) * 8 * 64 + c * 4 * 64 + lane;
#pragma unroll
    for (int dt = 0; dt < 2; ++dt) {
        f32x16 av;
#pragma unroll
        for (int i = 0; i < 16; ++i) av[i] = 0.f;
#pragma unroll
        for (int ks = 0; ks < 8; ++ks) av = MFMA32(cf[ks], *(const LAS bf16x8*)(wb + ((2 + dt) * 8 + ks) * 1024 + lane * 16), av);
#pragma unroll
        for (int s = 0; s < 2; ++s) { uint4 o; o.x = cvtpk(av[8 * s + 0], av[8 * s + 1]); o.y = cvtpk(av[8 * s + 2], av[8 * s + 3]); o.z = cvtpk(av[8 * s + 4], av[8 * s + 5]); o.w = cvtpk(av[8 * s + 6], av[8 * s + 7]);
            vd[(s * 2 + dt) * 64] = o; }
    }
}
DI uint4 pack8l(const f32x16& a, int g, float sc, const LAS float* G) {
    const f32x4_t g0 = *(const LAS f32x4_t*)(G + 16 * g), g1 = *(const LAS f32x4_t*)(G + 16 * g + 8);
    uint4 o; o.x = cvtpk(a[8 * g + 0] * sc * g0[0], a[8 * g + 1] * sc * g0[1]); o.y = cvtpk(a[8 * g + 2] * sc * g0[2], a[8 * g + 3] * sc * g0[3]);
    o.z = cvtpk(a[8 * g + 4] * sc * g1[0], a[8 * g + 5] * sc * g1[1]); o.w = cvtpk(a[8 * g + 6] * sc * g1[2], a[8 * g + 7] * sc * g1[3]); return o;
}
DI void kv_head_l(const Ptrs& p, const LAS unsigned char* wb, const bf16x8 (&cf)[8], const f32x16& kpe, float sspe, const LAS float* G, int bh, int tile, int c, int lane) {
    f32x16 acc[2];
#pragma unroll
    for (int nt = 0; nt < 2; ++nt) {
#pragma unroll
        for (int i = 0; i < 16; ++i) acc[nt][i] = 0.f;
#pragma unroll
        for (int ks = 0; ks < 8; ++ks) acc[nt] = MFMA32(*(const LAS bf16x8*)(wb + (nt * 8 + ks) * 1024 + lane * 16), cf[ks], acc[nt]);
    }
    float sk = sspe;
#pragma unroll
    for (int nt = 0; nt < 2; ++nt)
#pragma unroll
        for (int i = 0; i < 16; ++i) sk += acc[nt][i] * acc[nt][i];
    sk += __shfl_xor(sk, 32);
    const float rk = rsqrt_fast(sk * (1.f / 96.f) + EPS);
    uint4* kd = (uint4*)(p.ws + WS_KIMG) + (size_t)(bh * 64 + tile) * 6 * 2 * 64 + c * 64 + lane;
#pragma unroll
    for (int nt = 0; nt < 2; ++nt)
#pragma unroll
        for (int g = 0; g < 2; ++g) kd[(2 * nt + g) * 128] = pack8l(acc[nt], g, rk, G + 32 * nt);
#pragma unroll
    for (int g = 0; g < 2; ++g) kd[(4 + g) * 128] = pack8l(kpe, g, rk, G + 64);
    uint4* vd = (uint4*)(p.ws + WS_VIMG) + (size_t)(bh * 64 + tile) * 8 * 64 + c * 4 * 64 + lane;
#pragma unroll
    for (int dt = 0; dt < 2; ++dt) {
        f32x16 av;
#pragma unroll
        for (int i = 0; i < 16; ++i) av[i] = 0.f;
#pragma unroll
        for (int ks = 0; ks < 8; ++ks) av = MFMA32(cf[ks], *(const LAS bf16x8*)(wb + ((2 + dt) * 8 + ks) * 1024 + lane * 16), av);
#pragma unroll
        for (int s = 0; s < 2; ++s) { uint4 o; o.x = cvtpk(av[8 * s + 0], av[8 * s + 1]); o.y = cvtpk(av[8 * s + 2], av[8 * s + 3]); o.z = cvtpk(av[8 * s + 4], av[8 * s + 5]); o.w = cvtpk(av[8 * s + 6], av[8 * s + 7]);
            vd[(s * 2 + dt) * 64] = o; }
    }
}
template <bool DO_QKV, bool DO_GMLP>
DI void wg_item(LAS unsigned char* lds, const Ptrs& p, int tg, int hp, int wid, int lane) {
    const int r = lane & 31, h = lane >> 5;
    const unsigned lds0 = (unsigned)(uintptr_t)lds, ldsA = lds0, ldsB = lds0 + 65536;
    const LAS unsigned char* bufA = lds; const LAS unsigned char* bufB = lds + 65536;
    const unsigned char* WqF = p.ws + WS_WUQT; const unsigned char* WkvF = p.ws + WS_WUKVT; const unsigned char* WsF = p.ws + WS_WSB;
    const int hA = 2 * hp, tb = tg * 8 + wid, t = tb * 32 + r, b = t >> 12, s0 = (tb * 32) & 4095, qblk = s0 >> 5, tile = s0 >> 6, c = (s0 >> 5) & 1;
    if constexpr (DO_QKV) {
    const bf16_t* CQ = (const bf16_t*)(p.ws + WS_CQ);
    bf16x8 cf[16];
#pragma unroll
    for (int ks = 0; ks < 16; ++ks) cf[ks] = *(const bf16x8*)(CQ + (((size_t)(tb * 32 + 2 * ks + h) * 32 + r) << 3));
    float cs[8], sn[8];
    { const float* ct = (const float*)(p.ws + WS_COS) + t * 16; const float* st = (const float*)(p.ws + WS_SIN) + t * 16;
#pragma unroll
      for (int i = 0; i < 8; ++i) { cs[i] = ct[crow(i, h)]; sn[i] = st[crow(i, h)]; } }
    dma_copy<6>(WqF + (size_t)hA * 49152, ldsA, wid, lane);
    dma_copy<6>(WqF + (size_t)(hA + 1) * 49152, ldsB, wid, lane);
    float ss = 0.f;
#pragma unroll
    for (int ks = 0; ks < 16; ++ks) ss += frag_ssq(cf[ks]);
    ss += __shfl_xor(ss, 32);
    const float rq = rsqrt_fast(ss * (1.f / 256.f) + EPS);
    P2_BAR_V(6);
    q_head(p, bufA, cf, rq, cs, sn, b * 8 + hA, qblk, lane);
    P2_BAR_V(0);
    dma_copy<8>(WkvF + (size_t)hA * 32768, ldsA, wid, lane);
    q_head(p, bufB, cf, rq, cs, sn, b * 8 + hA + 1, qblk, lane);
    const bf16_t* CKV = (const bf16_t*)(p.ws + WS_CKV);
    bf16x8 kf[8]; float ssk = 0.f;
#pragma unroll
    for (int ks = 0; ks < 8; ++ks) { kf[ks] = *(const bf16x8*)(CKV + (((size_t)(tb * 20 + 2 * ks + h) * 32 + r) << 3)); ssk += frag_ssq(kf[ks]); }
    ssk += __shfl_xor(ssk, 32);
    const float rkv = rsqrt_fast(ssk * (1.f / 128.f) + EPS);
#pragma unroll
    for (int ks = 0; ks < 8; ++ks) kf[ks] = frag_scale(kf[ks], rkv);
    f32x16 kpe; float sspe = 0.f;
    {
        float kr[16];
#pragma unroll
        for (int g = 0; g < 4; ++g) { const uint2 w = *(const uint2*)(CKV + (((size_t)(tb * 20 + 16 + g) * 32 + r) << 3) + 4 * h);
            kr[4 * g + 0] = lo16(w.x); kr[4 * g + 1] = hi16(w.x); kr[4 * g + 2] = lo16(w.y); kr[4 * g + 3] = hi16(w.y); }
#pragma unroll
        for (int i = 0; i < 8; ++i) { const float a = kr[i], bb = kr[i + 8];
            kpe[i] = a * cs[i] - bb * sn[i]; kpe[i + 8] = bb * cs[i] + a * sn[i]; sspe += kpe[i] * kpe[i] + kpe[i + 8] * kpe[i + 8]; }
    }
    float gk[3][16];
#pragma unroll
    for (int nt = 0; nt < 3; ++nt)
#pragma unroll
        for (int i = 0; i < 16; ++i) gk[nt][i] = p.g_kh[32 * nt + crow(i, h)] * p.g_qh[32 * nt + crow(i, h)];
    P2_BAR_V(0);
    if constexpr (DO_GMLP) dma_copy<8>(WsF + (size_t)hA * 32768, ldsB, wid, lane);
    kv_head(p, bufA, kf, kpe, sspe, gk, b * 8 + hA, tile, c, lane);
    kv_head(p, bufA + 32768, kf, kpe, sspe, gk, b * 8 + hA + 1, tile, c, lane);
    P2_BAR_V(0);
    } else { if constexpr (DO_GMLP) dma_copy<8>(WsF + (size_t)hA * 32768, ldsB, wid, lane); }
    if constexpr (DO_GMLP) {
    const bf16_t* Z = (const bf16_t*)(p.ws + WS_Z);
    const int pair = wid >> 1, cl = pair >> 1, hl = pair & 1, hd = hA + hl, tc0 = (2 * tg + cl) * 128;
    uint2 uld[2][2][4], zld[2][2][4];
#pragma unroll
    for (int ii = 0; ii < 2; ++ii) { const bf16_t* zr = Z + (size_t)(tc0 + 32 * (2 * (wid & 1) + ii) + r) * 2048 + hd * 64 + 4 * h;
#pragma unroll
        for (int nt = 0; nt < 2; ++nt)
#pragma unroll
            for (int g = 0; g < 4; ++g) { uld[ii][nt][g] = *(const uint2*)(zr + 512 + 32 * nt + 8 * g); zld[ii][nt][g] = *(const uint2*)(zr + 1536 + 32 * nt + 8 * g); } }
    {
        const int j = 64 * (wid & 1) + lane;
        const uint4* srcv = (const uint4*)(Z + (size_t)(tc0 + j) * 2048 + 1024 + hd * 64);
        float gv[64]; float sg = 0.f;
#pragma unroll
        for (int c8 = 0; c8 < 8; ++c8) { const uint4 u = srcv[c8];
            gv[8 * c8 + 0] = gelu_tanh(lo16(u.x)); gv[8 * c8 + 1] = gelu_tanh(hi16(u.x)); gv[8 * c8 + 2] = gelu_tanh(lo16(u.y)); gv[8 * c8 + 3] = gelu_tanh(hi16(u.y));
            gv[8 * c8 + 4] = gelu_tanh(lo16(u.z)); gv[8 * c8 + 5] = gelu_tanh(hi16(u.z)); gv[8 * c8 + 6] = gelu_tanh(lo16(u.w)); gv[8 * c8 + 7] = gelu_tanh(hi16(u.w)); }
#pragma unroll
        for (int d = 0; d < 64; ++d) sg += gv[d] * gv[d];
        const float rv = rsqrt_fast(sg * (1.f / 64.f) + EPS);
        const float* gg = p.g_vg + hd * 64;
        LAS unsigned char* img = lds + pair * 16384;
#pragma unroll
        for (int c8 = 0; c8 < 8; ++c8) { u32x4v o;
            o.x = cvtpk(gv[8 * c8 + 0] * rv * gg[8 * c8 + 0], gv[8 * c8 + 1] * rv * gg[8 * c8 + 1]); o.y = cvtpk(gv[8 * c8 + 2] * rv * gg[8 * c8 + 2], gv[8 * c8 + 3] * rv * gg[8 * c8 + 3]);
            o.z = cvtpk(gv[8 * c8 + 4] * rv * gg[8 * c8 + 4], gv[8 * c8 + 5] * rv * gg[8 * c8 + 5]); o.w = cvtpk(gv[8 * c8 + 6] * rv * gg[8 * c8 + 6], gv[8 * c8 + 7] * rv * gg[8 * c8 + 7]);
            *(LAS u32x4v*)(img + (c8 >> 2) * 8192 + j * 64 + (c8 & 3) * 16) = o; }
    }
    P2_BAR_V(0);
    {
        bf16x8 vf[8][2];
        { const int q = (lane & 15) >> 2, pp = lane & 3, blk = (lane >> 4) & 1;
          const LAS unsigned char* base = bufA + pair * 16384 + (8 * h + q) * 64 + (16 * blk + 4 * pp) * 2;
#pragma unroll
          for (int ks = 0; ks < 8; ++ks)
#pragma unroll
              for (int nt = 0; nt < 2; ++nt) { const s16x4 lo = vtr(base + nt * 8192 + ks * 1024), hi = vtr(base + nt * 8192 + ks * 1024 + 256);
                  vf[ks][nt] = __builtin_shufflevector(lo, hi, 0, 1, 2, 3, 4, 5, 6, 7); } }
#pragma unroll
        for (int ii = 0; ii < 2; ++ii) { const int it = 2 * (wid & 1) + ii;
            f32x16 acc[2];
#pragma unroll
            for (int i = 0; i < 16; ++i) { acc[0][i] = 0.f; acc[1][i] = 0.f; }
            const LAS unsigned char* wsb = bufB + hl * 32768 + it * 8192 + lane * 16;
#pragma unroll
            for (int ks = 0; ks < 8; ++ks) { const bf16x8 wf = *(const LAS bf16x8*)(wsb + ks * 1024); acc[0] = MFMA32(vf[ks][0], wf, acc[0]); acc[1] = MFMA32(vf[ks][1], wf, acc[1]); }
            const int tt = tc0 + 32 * it + r; const float bs = p.b_s[hd * 128 + 32 * it + r];
            bf16_t* ar = (bf16_t*)(p.ws + WS_AMIX) + (size_t)tt * 1024 + 512 + hd * 64 + 4 * h;
            float sq = 0.f;
#pragma unroll
            for (int nt = 0; nt < 2; ++nt)
#pragma unroll
                for (int g = 0; g < 4; ++g) { const uint2 uu = uld[ii][nt][g], zz = zld[ii][nt][g];
                    const float uv[4] = {lo16(uu.x), hi16(uu.x), lo16(uu.y), hi16(uu.y)}, zv[4] = {lo16(zz.x), hi16(zz.x), lo16(zz.y), hi16(zz.y)}; float a[4];
#pragma unroll
                    for (int e = 0; e < 4; ++e) { const float o = gelu_tanh(uv[e]) * (acc[nt][4 * g + e] + bs); sq += o * o; a[e] = o * silu(zv[e]); }
                    uint2 w; w.x = cvtpk(a[0], a[1]); w.y = cvtpk(a[2], a[3]); *(uint2*)(ar + 32 * nt + 8 * g) = w; }
            sq += __shfl_xor(sq, 32);
            if (h == 0) ((float*)(p.ws + WS_SSQB))[(size_t)hd * T + tt] = sq;
        }
    }
    P2_BAR_V(0);
    }
}
#undef P2_BAR_V
}


typedef unsigned f_u32x2 __attribute__((ext_vector_type(2)));
#define F_BAR_V(N) asm volatile("s_waitcnt vmcnt(" #N ") lgkmcnt(0)\n\ts_barrier" ::: "memory")
#define F_BAR_L() asm volatile("s_waitcnt lgkmcnt(0)\n\ts_barrier" ::: "memory")
DI void p1_fused_q_a(const f32x4_t (&acc)[2][2][4][2], int pm, int wr, int wc, int fr, int fq, LAS unsigned char* lds, const Ptrs* pp) {
    using namespace p2;
    const Ptrs& p = *pp;
    const LAS float* rsx = (const LAS float*)(lds + 131072 + 4096 + 2048);
    LAS float* tab = (LAS float*)(lds + 131072);
#pragma unroll
    for (int ai = 0; ai < 2; ++ai)
#pragma unroll
        for (int m = 0; m < 4; ++m) {
            const int row = ai * 128 + wr * 64 + m * 16 + fr; const float rs = rsx[row]; float part = 0.f;
#pragma unroll
            for (int bj = 0; bj < 2; ++bj) { const f32x4_t v0 = acc[ai][bj][m][0] * rs, v1 = acc[ai][bj][m][1] * rs;
                part += (v0[0] * v0[0] + v0[1] * v0[1]) + (v0[2] * v0[2] + v0[3] * v0[3]) + (v1[0] * v1[0] + v1[1] * v1[1]) + (v1[2] * v1[2] + v1[3] * v1[3]);
                u32x4v w; w.x = cvtpk(v0[0], v0[1]); w.y = cvtpk(v0[2], v0[3]); w.z = cvtpk(v1[0], v1[1]); w.w = cvtpk(v1[2], v1[3]);
                const int chunk = 16 * bj + 4 * wc + fq;
                *(LAS u32x4v*)(lds + ((((row >> 5) * 16 + (chunk >> 1)) * 64 + (chunk & 1) * 32 + (row & 31)) << 4)) = w; }
            part += __shfl_xor(part, 16); part += __shfl_xor(part, 32);
            if (fq == 0) tab[row * 4 + wc] = part;
        }
}
DI void p1_fused_q_b(int pm, LAS unsigned char* lds, const Ptrs* pp, int wid, int lane) {
    using namespace p2;
    const Ptrs& p = *pp;
    const int r = lane & 31, h = lane >> 5;
    const LAS float* tab = (const LAS float*)(lds + 131072);
    bf16x8 cf[16];
#pragma unroll
    for (int ks = 0; ks < 16; ++ks) cf[ks] = *(const LAS bf16x8*)(lds + (((wid * 16 + ks) * 64 + lane) << 4));
    const int row = 32 * wid + r, t = pm * 256 + row, b = t >> 12, s0 = (pm * 256 + 32 * wid) & 4095, qblk = s0 >> 5;
    const float rq = rsqrt_fast((tab[row * 4] + tab[row * 4 + 1] + tab[row * 4 + 2] + tab[row * 4 + 3]) * (1.f / 256.f) + EPS);
    float cs[8], sn[8];
    { const float* ct = (const float*)(p.ws + WS_COS) + t * 16; const float* st = (const float*)(p.ws + WS_SIN) + t * 16;
#pragma unroll
      for (int i = 0; i < 8; ++i) { cs[i] = ct[crow(i, h)]; sn[i] = st[crow(i, h)]; } }
    F_BAR_L();
    const unsigned lds0 = (unsigned)(uintptr_t)lds, ldsA = lds0, ldsB = lds0 + 65536;
    const LAS unsigned char* bufA = lds; const LAS unsigned char* bufB = lds + 65536;
    const unsigned char* WqF = p.ws + WS_WUQT;
    dma_copy<6>(WqF, ldsA, wid, lane);
    dma_copy<6>(WqF + 49152, ldsB, wid, lane);
#pragma nounroll
    for (int hp = 0; hp < 4; ++hp) {
        F_BAR_V(6);
        q_head(p, bufA, cf, rq, cs, sn, b * 8 + 2 * hp, qblk, lane);
        F_BAR_V(0);
        if (hp < 3) dma_copy<6>(WqF + (size_t)(2 * hp + 2) * 49152, ldsA, wid, lane);
        q_head(p, bufB, cf, rq, cs, sn, b * 8 + 2 * hp + 1, qblk, lane);
        F_BAR_L();
        if (hp < 3) dma_copy<6>(WqF + (size_t)(2 * hp + 3) * 49152, ldsB, wid, lane);
    }
    F_BAR_V(0);
}
DI void p1_fused_kv_a(const f32x4_t (&acc)[2][2][4][2], int pm, int wr, int wc, int fr, int fq, LAS unsigned char* lds, const Ptrs* pp) {
    using namespace p2;
    const Ptrs& p = *pp;
    const LAS float* rsx = (const LAS float*)(lds + 131072 + 4096 + 2048);
    LAS float* tab = (LAS float*)(lds + 131072);
#pragma unroll
    for (int ai = 0; ai < 2; ++ai)
#pragma unroll
        for (int m = 0; m < 4; ++m) {
            const int row = ai * 128 + wr * 64 + m * 16 + fr; const float rs = rsx[row];
            { const f32x4_t v0 = acc[ai][0][m][0] * rs, v1 = acc[ai][0][m][1] * rs;
              float part = (v0[0] * v0[0] + v0[1] * v0[1]) + (v0[2] * v0[2] + v0[3] * v0[3]) + (v1[0] * v1[0] + v1[1] * v1[1]) + (v1[2] * v1[2] + v1[3] * v1[3]);
              u32x4v w; w.x = cvtpk(v0[0], v0[1]); w.y = cvtpk(v0[2], v0[3]); w.z = cvtpk(v1[0], v1[1]); w.w = cvtpk(v1[2], v1[3]);
              const int chunk = 4 * wc + fq;
              *(LAS u32x4v*)(lds + ((((row >> 5) * 8 + (chunk >> 1)) * 64 + (chunk & 1) * 32 + (row & 31)) << 4)) = w;
              part += __shfl_xor(part, 16); part += __shfl_xor(part, 32);
              if (fq == 0) tab[row * 4 + wc] = part; }
            if (wc == 0) { const f32x4_t v0 = acc[ai][1][m][0] * rs, v1 = acc[ai][1][m][1] * rs;
              u32x4v w; w.x = cvtpk(v0[0], v0[1]); w.y = cvtpk(v0[2], v0[3]); w.z = cvtpk(v1[0], v1[1]); w.w = cvtpk(v1[2], v1[3]);
              *(LAS u32x4v*)(lds + 65536 + ((((row >> 5) * 4 + fq) * 32 + (row & 31)) << 4)) = w; }
        }
}
DI void p1_fused_kv_b(int pm, LAS unsigned char* lds, const Ptrs* pp, int wid, int lane) {
    using namespace p2;
    const Ptrs& p = *pp;
    const int r = lane & 31, h = lane >> 5;
    LAS float* tab = (LAS float*)(lds + 131072);
    bf16x8 kf[8];
#pragma unroll
    for (int ks = 0; ks < 8; ++ks) kf[ks] = *(const LAS bf16x8*)(lds + (((wid * 8 + ks) * 64 + lane) << 4));
    const int row = 32 * wid + r, t = pm * 256 + row, b = t >> 12, s0 = (pm * 256 + 32 * wid) & 4095, tile = s0 >> 6, c = (s0 >> 5) & 1;
    const float rkv = rsqrt_fast((tab[row * 4] + tab[row * 4 + 1] + tab[row * 4 + 2] + tab[row * 4 + 3]) * (1.f / 128.f) + EPS);
#pragma unroll
    for (int ks = 0; ks < 8; ++ks) kf[ks] = frag_scale(kf[ks], rkv);
    f32x16 kpe; float sspe = 0.f;
    {
        float kr[16];
#pragma unroll
        for (int g = 0; g < 4; ++g) { const f_u32x2 w = *(const LAS f_u32x2*)(lds + 65536 + (((wid * 4 + g) * 32 + r) << 4) + 8 * h);
            kr[4 * g + 0] = lo16(w.x); kr[4 * g + 1] = hi16(w.x); kr[4 * g + 2] = lo16(w.y); kr[4 * g + 3] = hi16(w.y); }
        const float* ct = (const float*)(p.ws + WS_COS) + t * 16; const float* st = (const float*)(p.ws + WS_SIN) + t * 16;
#pragma unroll
        for (int i = 0; i < 8; ++i) { const float a = kr[i], bb = kr[i + 8], cc = ct[crow(i, h)], sv = st[crow(i, h)];
            kpe[i] = a * cc - bb * sv; kpe[i + 8] = bb * cc + a * sv; sspe += kpe[i] * kpe[i] + kpe[i + 8] * kpe[i + 8]; }
    }
    const float gprod = (wid == 0 && lane < 48) ? p.g_kh[lane] * p.g_qh[lane] : 0.f, gprod2 = (wid == 0 && lane < 48) ? p.g_kh[lane + 48] * p.g_qh[lane + 48] : 0.f;
    F_BAR_L();
    if (wid == 0 && lane < 48) { tab[lane] = gprod; tab[lane + 48] = gprod2; }
    const LAS float* G = tab + 4 * h;
    const unsigned lds0 = (unsigned)(uintptr_t)lds, ldsA = lds0, ldsB = lds0 + 65536;
    const LAS unsigned char* bufA = lds; const LAS unsigned char* bufB = lds + 65536;
    const unsigned char* WkvF = p.ws + WS_WUKVT;
    dma_copy<8>(WkvF, ldsA, wid, lane);
    dma_copy<8>(WkvF + 65536, ldsB, wid, lane);
#pragma nounroll
    for (int hq = 0; hq < 2; ++hq) {
        F_BAR_V(8);
        kv_head_l(p, bufA, kf, kpe, sspe, G, b * 8 + 4 * hq, tile, c, lane);
        kv_head_l(p, bufA + 32768, kf, kpe, sspe, G, b * 8 + 4 * hq + 1, tile, c, lane);
        F_BAR_V(0);
        if (hq == 0) dma_copy<8>(WkvF + 2 * 65536, ldsA, wid, lane);
        kv_head_l(p, bufB, kf, kpe, sspe, G, b * 8 + 4 * hq + 2, tile, c, lane);
        kv_head_l(p, bufB + 32768, kf, kpe, sspe, G, b * 8 + 4 * hq + 3, tile, c, lane);
        F_BAR_L();
        if (hq == 0) dma_copy<8>(WkvF + 3 * 65536, ldsB, wid, lane);
    }
    F_BAR_V(0);
}
#undef F_BAR_V
#undef F_BAR_L

#define FB_V(k)      (0x5EED0000u + (unsigned)(k))
#define FB_OK(f, k)  ((((f) & 0xFFFFF0FFu) - FB_V(k)) <= 1u)
#define FB_SPIN_CAP  (1u << 22)
__device__ __forceinline__ unsigned xb_ld(unsigned* p)              { return __hip_atomic_load(p, __ATOMIC_RELAXED, __HIP_MEMORY_SCOPE_AGENT); }
__device__ __forceinline__ void xb_st(unsigned* p, unsigned v)      { __hip_atomic_store(p, v, __ATOMIC_RELAXED, __HIP_MEMORY_SCOPE_AGENT); }
__device__ __forceinline__ unsigned xb_xcc_id() { return (unsigned)__builtin_amdgcn_s_getreg((3 << 11) | 20) & 0xFu; }
__device__ __forceinline__ void flag_barrier(unsigned* bar, volatile LAS unsigned* st, int k) {
    asm volatile("s_waitcnt vmcnt(0)" ::: "memory");
    __syncthreads();
    if (threadIdx.x < 64) {
        const unsigned lane = threadIdx.x, bx = blockIdx.x, x = xb_xcc_id();
        __builtin_amdgcn_s_waitcnt(0);
        if (lane == 0) xb_st(&bar[bx], FB_V(k) | (x << 8));
        unsigned f0, f1, f2, f3, sp = 0u, m; bool leader;
        if (k == 0) {
            for (;;) {
                f0 = xb_ld(&bar[lane]); f1 = xb_ld(&bar[64 + lane]); f2 = xb_ld(&bar[128 + lane]); f3 = xb_ld(&bar[192 + lane]);
                if (__all(FB_OK(f0, k) && FB_OK(f1, k) && FB_OK(f2, k) && FB_OK(f3, k))) break;
                __builtin_amdgcn_s_sleep(2);
                if (++sp > FB_SPIN_CAP) break;
            }
            const unsigned x0 = (f0 >> 8) & 15u, x1 = (f1 >> 8) & 15u, x2 = (f2 >> 8) & 15u, x3 = (f3 >> 8) & 15u;
            const bool lower = (x0 == x && lane < bx) || (x1 == x && 64u + lane < bx) || (x2 == x && 128u + lane < bx) || (x3 == x && 192u + lane < bx);
            leader = !__any(lower);
            m = (1u << x0) | (1u << x1) | (1u << x2) | (1u << x3);
#pragma unroll
            for (int o = 1; o < 64; o <<= 1) m |= __shfl_xor(m, o);
            st[16 + lane] = (x0 == x ? 1u : 0u) | (x1 == x ? 2u : 0u) | (x2 == x ? 4u : 0u) | (x3 == x ? 8u : 0u);
            if (lane == 0) { st[0] = leader ? 1u : 0u; st[1] = m; }
        } else {
            leader = st[0] != 0u; m = st[1];
            if (leader) {
                const unsigned loc = st[16 + lane];
                for (;;) {
                    f0 = (loc & 1u) ? xb_ld(&bar[lane]) : FB_V(k); f1 = (loc & 2u) ? xb_ld(&bar[64 + lane]) : FB_V(k); f2 = (loc & 4u) ? xb_ld(&bar[128 + lane]) : FB_V(k); f3 = (loc & 8u) ? xb_ld(&bar[192 + lane]) : FB_V(k);
                    if (__all(FB_OK(f0, k) && FB_OK(f1, k) && FB_OK(f2, k) && FB_OK(f3, k))) break;
                    __builtin_amdgcn_s_sleep(1);
                    if (++sp > FB_SPIN_CAP) break;
                }
            }
        }
        if (leader) {
            __builtin_amdgcn_fence(__ATOMIC_RELEASE, "agent");
            asm volatile("s_waitcnt vmcnt(0)" ::: "memory");
            if (lane == 0) xb_st(&bar[256 + x], FB_V(k));
        }
        for (sp = 0u;;) {
            const unsigned t = lane < 16u ? xb_ld(&bar[256 + lane]) : 0u;
            const bool need = lane < 16u && ((m >> lane) & 1u);
            if (__all(!need || FB_OK(t, k))) break;
            __builtin_amdgcn_s_sleep(2);
            if (++sp > FB_SPIN_CAP) break;
        }
        __builtin_amdgcn_fence(__ATOMIC_ACQUIRE, "agent");
        asm volatile("s_waitcnt vmcnt(0)" ::: "memory");
    }
    __syncthreads();
}

constexpr int LDS_BYTES = 147456;
constexpr int NPHASE = 5;
constexpr int MISC_OFF = 131072 + 4096;
struct Args { Ptrs p; int ph_lo, ph_hi; };

DI size_t frag_off(int n, int k, int K) { return ((((size_t)(n >> 5) * (K >> 4) + (k >> 4)) * 64 + ((k >> 3) & 1) * 32 + (n & 31)) << 3) + (k & 7); }
template <bool FRAG>
DI void p0_transpose_item(const float* W, int K, int Nsrc, const float* gain, bf16_t* WT, int dst_row0, LAS float* scr, int k0, int n0, int lane) {
#pragma unroll 8
    for (int i = 0; i < 32; ++i) { const int kk = 2 * i + (lane >> 5); scr[kk * 33 + (lane & 31)] = W[(size_t)(k0 + kk) * Nsrc + n0 + (lane & 31)] * gain[k0 + kk]; }
    asm volatile("s_waitcnt lgkmcnt(0)" ::: "memory");
#pragma unroll
    for (int j = 0; j < 4; ++j) {
        const int c = FRAG ? (lane >> 5) + 2 * j : (lane & 7), n = FRAG ? (lane & 31) : (lane >> 3) + 8 * j; const LAS float* s = scr + (8 * c) * 33 + n;
        uint4 o; o.x = f2bf(s[0 * 33]) | ((unsigned)f2bf(s[1 * 33]) << 16); o.y = f2bf(s[2 * 33]) | ((unsigned)f2bf(s[3 * 33]) << 16);
        o.z = f2bf(s[4 * 33]) | ((unsigned)f2bf(s[5 * 33]) << 16); o.w = f2bf(s[6 * 33]) | ((unsigned)f2bf(s[7 * 33]) << 16);
        if (FRAG) *(uint4*)(WT + frag_off(dst_row0 + n, k0 + 8 * c, K)) = o; else *(uint4*)(WT + (size_t)(dst_row0 + n) * K + k0 + 8 * c) = o; }
    asm volatile("s_waitcnt lgkmcnt(0)" ::: "memory");
}
DI void p0_prologue(const Ptrs& p, LAS unsigned char* lds, int vcu, int G) {
    const int tid = threadIdx.x, lane = tid & 63, wave = __builtin_amdgcn_readfirstlane(tid >> 6);
    const int gw = vcu * 8 + wave, NGW = G * 8;
    LAS float* scr = (LAS float*)(lds + wave * 16384);
    bf16_t* WinT = (bf16_t*)(p.ws + WS_WINT); bf16_t* WuqT = (bf16_t*)(p.ws + WS_WUQT); bf16_t* WukvT = (bf16_t*)(p.ws + WS_WUKVT);
    bf16_t* WoutT = (bf16_t*)(p.ws + WS_WOUTT); bf16_t* Wsb = (bf16_t*)(p.ws + WS_WSB);
    {
    bf16_t* xb = (bf16_t*)(p.ws + WS_XB); float* rs = (float*)(p.ws + WS_RSTDX);
    for (int row = gw; row < T; row += NGW) {
        typedef float f32x4v __attribute__((ext_vector_type(4)));
        const f32x4v* xr = (const f32x4v*)(p.x + (size_t)row * DM) + lane;
        float s = 0.f; f32x4v v[4];
#pragma unroll
        for (int j = 0; j < 4; ++j) { v[j] = __builtin_nontemporal_load(xr + 64 * j); s += v[j].x * v[j].x + v[j].y * v[j].y + v[j].z * v[j].z + v[j].w * v[j].w; }
#pragma unroll
        for (int o = 1; o < 64; o <<= 1) s += __shfl_xor(s, o);
        if (lane == 0) rs[row] = rsqrt_fast(s * (1.f / DM) + EPS);
        uint2* o8 = (uint2*)(xb + (size_t)row * DM) + lane;
#pragma unroll
        for (int j = 0; j < 4; ++j) { uint2 w; w.x = f2bf(v[j].x) | ((unsigned)f2bf(v[j].y) << 16); w.y = f2bf(v[j].z) | ((unsigned)f2bf(v[j].w) << 16); o8[64 * j] = w; }
    }
    }
    constexpr int I_IN = 16 * 77, I_UQ = 4 * 24, I_UKV = 2 * 32, I_OUT = 16 * 32, NITEMS = I_IN + I_UQ + I_UKV + I_OUT;
    for (int it = gw; it < NITEMS; it += NGW) {
        int r = it;
        if (r < I_IN) { const int kb = r / 77, nb = r % 77; p0_transpose_item<false>(p.w_in, 1024, 2464, p.g_in, WinT, nb < 8 ? 1024 + 32 * nb : nb < 13 ? 1280 + 32 * (nb - 8) : nb < 29 ? 2048 + 32 * (nb - 13) : nb < 61 ? 32 * (nb - 29) : 1536 + 32 * (nb - 61), scr, 64 * kb, 32 * nb, lane);   continue; } r -= I_IN;
        if (r < I_UQ) { const int kb = r / 24, nb = r % 24; p0_transpose_item<true>(p.w_uq, 256, 768, p.g_ql, WuqT, 32 * nb, scr, 64 * kb, 32 * nb, lane); continue; } r -= I_UQ;
        if (r < I_UKV) { const int kb = r / 32, nb = r % 32; p0_transpose_item<true>(p.w_ukv, 128, 1024, p.g_kvl, WukvT, 32 * nb, scr, 64 * kb, 32 * nb, lane); continue; } r -= I_UKV;
        { const int kb = r / 32, nb = r % 32; p0_transpose_item<false>(p.w_out, 1024, 1024, kb < 8 ? p.g_oa : p.g_ob - 512, WoutT, 32 * nb, scr, 64 * kb, 32 * nb, lane); }
    }
    const size_t gid = (size_t)vcu * 512 + tid, gsz = (size_t)G * 512;
    for (size_t i = gid; i < (size_t)96 * 1024 / 8; i += gsz) ((uint4*)(WinT + (size_t)1440 * 1024))[i] = make_uint4(0u, 0u, 0u, 0u);
    for (size_t i = gid; i < (size_t)8 * 128 * 16; i += gsz) { const int n = (int)(i >> 4), kc = (int)(i & 15); const float4 a = *(const float4*)(p.w_s + (size_t)n * 128 + 8 * kc), bq = *(const float4*)(p.w_s + (size_t)n * 128 + 8 * kc + 4);
        uint4 o; o.x = f2bf(a.x) | ((unsigned)f2bf(a.y) << 16); o.y = f2bf(a.z) | ((unsigned)f2bf(a.w) << 16); o.z = f2bf(bq.x) | ((unsigned)f2bf(bq.y) << 16); o.w = f2bf(bq.z) | ((unsigned)f2bf(bq.w) << 16);
        *(uint4*)(Wsb + frag_off(n, 8 * kc, 128)) = o; }
    float* ct = (float*)(p.ws + WS_COS); float* st = (float*)(p.ws + WS_SIN);
    for (size_t i = gid; i < (size_t)T * 16; i += gsz) { const int t = (int)(i >> 4), f = (int)(i & 15);
        const float invf = 1.0f / powf(10000.0f, (float)(2 * f) / 32.0f);
        const float ang = (float)p.pos[t] * invf;
        const double rev = (double)ang * 0.15915494309189535; const float fr = (float)(rev - rint(rev));
        ct[i] = __builtin_amdgcn_cosf(fr); st[i] = __builtin_amdgcn_sinf(fr); }
}

__global__ void __launch_bounds__(512, 2) mega(Args a) {
    extern __shared__ __attribute__((aligned(16))) unsigned char lds_all[];
    LAS unsigned char* lds = (LAS unsigned char*)lds_all;
    cg::grid_group grid = cg::this_grid();
    const Ptrs& p = a.p;
#define GRID_BAR(k) flag_barrier((unsigned*)(p.ws + WS_CTL) + 1024, (volatile LAS unsigned*)(lds + MISC_OFF), (k))
    if (a.ph_lo > 1000) grid.sync();
    const int lo = a.ph_lo, hi = a.ph_hi, G = gridDim.x, bx = blockIdx.x;
    const int vcu = (G % 8 == 0) ? (bx % 8) * (G / 8) + bx / 8 : bx;
#define IN(k) (lo <= (k) && (k) < hi)
#define BOTH(k) (IN(k) && IN((k) + 1))
    if (IN(0)) { p0_prologue(p, lds, vcu, G); if (BOTH(0)) GRID_BAR(0); }
    if (IN(1)) {
        {
        __syncthreads();
        pg8::Gemm g{(const bf16_t*)(p.ws + WS_XB), (const bf16_t*)(p.ws + WS_WINT), T, NP + 512, DM}; pg8::P1Order S; S.init(T, NP, G, bx);
        { pg8::Unit u0; S.next(0, u0); if (threadIdx.x < 256) ((LAS float*)(lds + MISC_OFF + 2048))[threadIdx.x] = ((const float*)(p.ws + WS_RSTDX))[u0.pm * 256 + threadIdx.x];
          asm volatile("s_waitcnt vmcnt(0) lgkmcnt(0)" ::: "memory"); __syncthreads(); }
        pg8::EpiProj E{(bf16_t*)(p.ws + WS_Z), (const LAS float*)(lds + MISC_OFF + 2048), &p};
        pg8::gemm_phase<pg8::EpiProj, pg8::P1Order, true, true>(lds, g, S, E);
        }
        if (BOTH(1)) GRID_BAR(1);
    }
    if (IN(2)) {
        const int lane = threadIdx.x & 63, wid = __builtin_amdgcn_readfirstlane(threadIdx.x >> 6);
        __syncthreads();
        p2::wg_item<false, true>(lds, p, 8 * (bx & 7) + ((bx >> 3) & 7), bx >> 6, wid, lane);
        asm volatile("s_waitcnt vmcnt(0) lgkmcnt(0)" ::: "memory");
    }
    if (IN(3)) { __syncthreads(); att::attn_phase64(lds, p, vcu, G); if (BOTH(3)) GRID_BAR(2); }
    if (IN(4)) {
        {
        __syncthreads();
        pg8::StaticOrder S; S.init(T, DM, G, bx); pg8::Unit u0;
        if (S.next(0, u0) && threadIdx.x < 256) {
            const float* ssqa = (const float*)(p.ws + WS_SSQA); const float* ssqb = (const float*)(p.ws + WS_SSQB); const int t = u0.pm * 256 + threadIdx.x;
            float sa = 0.f, sb = 0.f;
#pragma unroll
            for (int h = 0; h < 8; ++h) { sa += ssqa[(size_t)h * T + t]; sb += ssqb[(size_t)h * T + t]; }
            const float ra = rsqrt_fast(sa * (1.f / 512.f) + EPS), rb = rsqrt_fast(sb * (1.f / 512.f) + EPS);
            ((LAS float*)(lds + pg8::STAGE_BYTES))[threadIdx.x] = ra / rb; ((LAS float*)(lds + pg8::STAGE_BYTES + 1024))[threadIdx.x] = rb;
        }
        asm volatile("s_waitcnt vmcnt(0) lgkmcnt(0)" ::: "memory"); __syncthreads();
        pg8::Gemm g{(const bf16_t*)(p.ws + WS_AMIX), (const bf16_t*)(p.ws + WS_WOUTT), T, DM, DM};
        pg8::EpiOut E{p.x, p.out, lds, (const bf16_t*)(p.ws + WS_XB)};
        pg8::gemm_phase<pg8::EpiOut, pg8::StaticOrder, false, true>(lds, g, S, E);
        }
    }
#undef IN
#undef BOTH
}

static int g_grid = 0;
static void launch_mega(const Ptrs& p, int lo, int hi, hipStream_t stream) {
    if (g_grid == 0) {
        int dev = 0, cus = 0, per_cu = 0;
        hipGetDevice(&dev); hipDeviceGetAttribute(&cus, hipDeviceAttributeMultiprocessorCount, dev);
        hipFuncSetAttribute((const void*)mega, hipFuncAttributeMaxDynamicSharedMemorySize, LDS_BYTES);
        hipOccupancyMaxActiveBlocksPerMultiprocessor(&per_cu, (const void*)mega, 512, LDS_BYTES);
        g_grid = cus;
        if (per_cu < 1 || cus != 256) { fprintf(stderr, "mega: built for 256 CUs x 1 resident workgroup; device has %d CUs, occupancy query says %d per CU; nothing launched\n", cus, per_cu); g_grid = -1; }
    }
    if (g_grid < 0) return;
    Args a{}; a.p = p; a.ph_lo = lo; a.ph_hi = hi;
    void* args[] = {&a};
    hipError_t e = hipLaunchCooperativeKernel((const void*)mega, dim3(g_grid), dim3(512), args, LDS_BYTES, stream);
    if (e != hipSuccess) fprintf(stderr, "cooperative launch failed: %s (grid %d)\n", hipGetErrorString(e), g_grid);
}
extern "C" void kernel_launch(void* const* d_in, const int* in_sizes, int n_in, void* d_out, int out_size, void* d_ws, size_t ws_size, hipStream_t stream) {
    if (n_in != 16 || out_size != T * DM || ws_size < WS_END) { fprintf(stderr, "kernel_launch: unexpected shapes n_in %d out %d ws %zu\n", n_in, out_size, ws_size); return; }
    Ptrs p{};
    p.x = (const float*)d_in[0]; p.pos = (const int*)d_in[1]; p.g_in = (const float*)d_in[2]; p.w_in = (const float*)d_in[3]; p.g_ql = (const float*)d_in[4]; p.w_uq = (const float*)d_in[5];
    p.g_kvl = (const float*)d_in[6]; p.w_ukv = (const float*)d_in[7]; p.g_qh = (const float*)d_in[8]; p.g_kh = (const float*)d_in[9]; p.g_vg = (const float*)d_in[10]; p.w_s = (const float*)d_in[11];
    p.b_s = (const float*)d_in[12]; p.g_oa = (const float*)d_in[13]; p.g_ob = (const float*)d_in[14]; p.w_out = (const float*)d_in[15];
    p.out = (float*)d_out; p.ws = (unsigned char*)d_ws;
    launch_mega(p, 0, 5, stream);
}
```

```cpp
#include <hip/hip_runtime.h>
#include <stdint.h>
#include <stdio.h>
#include <hip/hip_cooperative_groups.h>
namespace cg = cooperative_groups;

#define DI __device__ __forceinline__
#define LAS __attribute__((address_space(3)))
typedef unsigned short bf16_t;

constexpr int T = 16384, SEQ = 4096, NB = 4, DM = 1024, NH = 8, QK = 96, DV = 64;
constexpr int NP = 2048;
constexpr float EPS = 1e-6f;
constexpr float QSCALE = 0.10206207261596575f * 1.4426950408889634f;

constexpr size_t MiB = 1u << 20;
constexpr size_t WS_CTL = 0;
constexpr size_t WS_XB = 1 * MiB;
constexpr size_t WS_RSTDX = 33 * MiB;
constexpr size_t WS_COS = 34 * MiB;
constexpr size_t WS_SIN = 35 * MiB;
constexpr size_t WS_WINT = 36 * MiB;
constexpr size_t WS_WUQT = 41 * MiB;
constexpr size_t WS_WUKVT = 42 * MiB;
constexpr size_t WS_WOUTT = 43 * MiB;
constexpr size_t WS_WSB = 45 * MiB;
constexpr size_t WS_SSQA = 46 * MiB;
constexpr size_t WS_SSQB = 47 * MiB;
constexpr size_t WS_CQ = 48 * MiB;
constexpr size_t WS_CKV = 56 * MiB;
constexpr size_t WS_Z = 62 * MiB;
constexpr size_t WS_QIMG = 126 * MiB;
constexpr size_t WS_KIMG = 150 * MiB;
constexpr size_t WS_VIMG = 174 * MiB;
constexpr size_t WS_AMIX = 190 * MiB;
constexpr size_t WS_END = 222 * MiB;

DI float bf2f(bf16_t b) { return __uint_as_float(((unsigned)b) << 16); }
DI bf16_t f2bf(float f) { unsigned u = __float_as_uint(f); return (bf16_t)((u + 0x7fffu + ((u >> 16) & 1u)) >> 16); }
DI float gelu_tanh(float x) {
    const float y = x * (0.7978845608028654f + 0.035677408136300125f * x * x);
    return x * __builtin_amdgcn_rcpf(1.f + __builtin_amdgcn_exp2f(-2.885390081777927f * y));
}
DI float silu(float x) { return x * __builtin_amdgcn_rcpf(1.f + __builtin_amdgcn_exp2f(-1.4426950408889634f * x)); }
DI float rsqrt_fast(float x) { return __builtin_amdgcn_rsqf(x); }
typedef float f2_t __attribute__((ext_vector_type(2)));
DI f2_t gelu2(f2_t x) {
    const f2_t y = x * __builtin_elementwise_fma(x * x, (f2_t)(-2.885390081777927f * 0.035677408136300125f), (f2_t)(-2.885390081777927f * 0.7978845608028654f));
    f2_t e; e.x = __builtin_amdgcn_exp2f(y.x); e.y = __builtin_amdgcn_exp2f(y.y); e = e + 1.f;
    f2_t r; r.x = __builtin_amdgcn_rcpf(e.x); r.y = __builtin_amdgcn_rcpf(e.y); return x * r; }
DI f2_t silu2(f2_t x) {
    const f2_t y = x * -1.4426950408889634f;
    f2_t e; e.x = __builtin_amdgcn_exp2f(y.x); e.y = __builtin_amdgcn_exp2f(y.y); e = e + 1.f;
    f2_t r; r.x = __builtin_amdgcn_rcpf(e.x); r.y = __builtin_amdgcn_rcpf(e.y); return x * r; }
DI f2_t bf2x(unsigned w) { f2_t v; v.x = __uint_as_float(w << 16); v.y = __uint_as_float(w & 0xffff0000u); return v; }

DI size_t cq_idx(int t, int k) { return ((((size_t)(t >> 5) * 32 + (k >> 3)) * 32 + (t & 31)) << 3) + (k & 7); }
DI size_t ckv_idx(int t, int k) { return ((((size_t)(t >> 5) * 20 + (k >> 3)) * 32 + (t & 31)) << 3) + (k & 7); }
DI size_t qimg_idx(int bh, int s, int d) {
    const int qb = s >> 5, r = s & 31, kk = d >> 4, e = d & 15, h = (e >> 2) & 1, j = 4 * (e >> 3) + (e & 3);
    return (((((size_t)bh * 128 + qb) * 6 + kk) * 64 + (h * 32 + r)) << 3) + j;
}
DI size_t kimg_idx(int bh, int s, int d) {
    const int tile = s >> 6, c = (s >> 5) & 1, r = s & 31, kk = d >> 4, e = d & 15, h = (e >> 2) & 1, j = 4 * (e >> 3) + (e & 3);
    return ((((((size_t)bh * 64 + tile) * 6 + kk) * 2 + c) * 64 + (h * 32 + r)) << 3) + j;
}
DI size_t vimg_idx(int bh, int s, int d) {
    const int tile = s >> 6, kin = s & 63, c = kin >> 5, s2 = (kin >> 4) & 1, e = kin & 15, h = (e >> 2) & 1, j = 4 * (e >> 3) + (e & 3), dt = d >> 5, r = d & 31;
    return (((((((size_t)bh * 64 + tile) * 2 + c) * 2 + s2) * 2 + dt) * 64 + (h * 32 + r)) << 3) + j;
}

struct Ptrs {
    const float *x; const int* pos; const float *g_in, *w_in, *g_ql, *w_uq, *g_kvl, *w_ukv, *g_qh, *g_kh, *g_vg, *w_s, *b_s, *g_oa, *g_ob, *w_out;
    float* out; unsigned char* ws;
};

typedef float f32x4_t __attribute__((ext_vector_type(4)));
DI void p1_fused_q_a(const f32x4_t (&acc)[2][2][4][2], int pm, int wr, int wc, int fr, int fq, LAS unsigned char* lds, const Ptrs* pp);
DI void p1_fused_kv_a(const f32x4_t (&acc)[2][2][4][2], int pm, int wr, int wc, int fr, int fq, LAS unsigned char* lds, const Ptrs* pp);
DI void p1_fused_q_b(int pm, LAS unsigned char* lds, const Ptrs* pp, int wid, int lane);
DI void p1_fused_kv_b(int pm, LAS unsigned char* lds, const Ptrs* pp, int wid, int lane);
namespace pg8 {
#define PG8_LAS __attribute__((address_space(3)))
typedef short bf16x8 __attribute__((ext_vector_type(8)));
typedef float f32x4 __attribute__((ext_vector_type(4)));
typedef unsigned u32x4 __attribute__((ext_vector_type(4)));
constexpr int BM = 256, BK = 64, HALF = 128, HTB = HALF * BK * 2  , STAGE_BYTES = 8 * HTB, NXCD = 8, WGM = 8;

__host__ __device__ __forceinline__ int lds_byte(int r, int c) { const int st = (r >> 4) * 2 + (c >> 5), rr = r & 15, cc = c & 31, ob = rr * 64 + cc * 2; return st * 1024 + (ob ^ (((ob >> 9) & 1) << 5)); }
__host__ __device__ __forceinline__ void stage_rc(int b, int& R, int& C) { const int st = b / 1024, sb = b % 1024, swz = sb ^ (((sb >> 9) & 1) << 5); R = (st >> 1) * 16 + swz / 64; C = (st & 1) * 32 + (swz % 64) / 2; }
__host__ __device__ __forceinline__ int perm32(int rho) { const int n = rho >> 4, i = rho & 15; return 8 * (i >> 2) + 4 * n + (i & 3); }

struct Unit { int pm, pn; };
struct Gemm { const bf16_t* A; const bf16_t* Bt; int M, N, K; };

struct StaticOrder {
    int nM, nN, nwg, G, c;
    __host__ __device__ void init(int M, int N, int G_, int c_) { nM = M / BM; nN = N / BM; nwg = nM * nN; G = G_; c = c_; }
    __host__ __device__ bool next(int i, Unit& u) const {
        const long L = (long)i * G + c; if (L >= nwg) return false;
        int wgid = (int)L; { const int q = nwg / NXCD, r = nwg % NXCD, xcd = wgid % NXCD, off = wgid / NXCD; wgid = (xcd < r ? xcd * (q + 1) : r * (q + 1) + (xcd - r) * q) + off; }
        const int nig = WGM * nN, gid = wgid / nig, fm = gid * WGM, gsz = (nM - fm) < WGM ? (nM - fm) : WGM;
        u.pm = fm + ((wgid % nig) % gsz); u.pn = (wgid % nig) / gsz; return true;
    }
    __device__ __forceinline__ void a_ready(const Unit&) const {}
    __device__ __forceinline__ void done(const Unit&) const {}
};
__device__ __forceinline__ unsigned cvt_pk_bf16(float lo, float hi) { unsigned r; asm volatile("v_cvt_pk_bf16_f32 %0, %1, %2" : "=v"(r) : "v"(lo), "v"(hi)); return r; }

struct OneUnit { int pm, pn;
    __device__ __forceinline__ bool next(int i, Unit& u) const { if (i) return false; u.pm = pm; u.pn = pn; return true; }
    __device__ __forceinline__ void a_ready(const Unit&) const {}
    __device__ __forceinline__ void done(const Unit&) const {}
};
struct P1Order { StaticOrder S;
    __host__ __device__ void init(int M, int N, int G_, int c_) { S.init(M, N, G_, c_); }
    __host__ __device__ bool next(int i, Unit& u) const {
        if (i < 2) return S.next(i, u);
        if (i == 2 && S.c >= 128) { S.next(1, u); u.pn += 2; return true; }
        return false; }
    __device__ __forceinline__ void a_ready(const Unit&) const {}
    __device__ __forceinline__ void done(const Unit&) const {}
};
struct EpiProj {
    static constexpr bool PERM = true, AFTER_DRAIN = false, HAS_MID = false, FUSE_LAST = true; static constexpr int MID_T = -1;
    bf16_t *Z; const PG8_LAS float* rtab; const Ptrs* pp;
    __device__ __forceinline__ bool fused_unit(const Unit& u) const { return u.pn == 4 || u.pn == 5; }
    __device__ __forceinline__ void fused(const f32x4 (&acc)[2][2][4][2], const Unit& u, int wr, int wc, int fr, int fq, PG8_LAS unsigned char* lds, int wid, int lane) const {
        if (u.pn == 4) p1_fused_q_a(acc, u.pm, wr, wc, fr, fq, lds, pp); else p1_fused_kv_a(acc, u.pm, wr, wc, fr, fq, lds, pp);
        asm volatile("s_waitcnt lgkmcnt(0)\n\ts_barrier" ::: "memory");
        if (u.pn == 4) p1_fused_q_b(u.pm, lds, pp, wid, lane); else p1_fused_kv_b(u.pm, lds, pp, wid, lane); }
    __device__ __forceinline__ void mid(f32x4 (&)[2][2][4][2], int, int, PG8_LAS unsigned char*) const {}
    __device__ __forceinline__ void operator()(const f32x4 (&acc)[2][2][4][2], const Unit& u, int wr, int wc, int fr, int fq) const {
        const int row0 = u.pm * BM + wr * 64 + fr;
        const int zc = (u.pn < 4 ? 512 + u.pn * BM : u.pn < 8 ? u.pn * BM : (u.pn - 8) * BM);
        float rsv[2][4];
#pragma unroll
        for (int ai = 0; ai < 2; ++ai)
#pragma unroll
            for (int m = 0; m < 4; ++m) rsv[ai][m] = rtab[wr * 64 + fr + ai * HALF + m * 16];
#pragma unroll
        for (int ai = 0; ai < 2; ++ai)
#pragma unroll
            for (int m = 0; m < 4; ++m) { const int row = row0 + ai * HALF + m * 16; const float rs = rsv[ai][m];
#pragma unroll
                for (int bj = 0; bj < 2; ++bj) { const int lc = bj * HALF + wc * 32 + 8 * fq;
                    const f32x4 v0 = acc[ai][bj][m][0] * rs, v1 = acc[ai][bj][m][1] * rs;
                    u32x4 w; w.x = cvt_pk_bf16(v0[0], v0[1]); w.y = cvt_pk_bf16(v0[2], v0[3]); w.z = cvt_pk_bf16(v1[0], v1[1]); w.w = cvt_pk_bf16(v1[2], v1[3]);
                    *(u32x4*)(Z + (size_t)row * 2048 + zc + lc) = w; } }

    }
};
struct EpiOut {
    static constexpr bool PERM = false, AFTER_DRAIN = true, HAS_MID = true, FUSE_LAST = false; static constexpr int MID_T = 8;
    __device__ __forceinline__ bool fused_unit(const Unit&) const { return false; }
    __device__ __forceinline__ void fused(const f32x4 (&acc)[2][2][4][2], const Unit& u, int wr, int wc, int fr, int fq, PG8_LAS unsigned char* lds, int wid, int lane) const {
        typedef float nt4 __attribute__((ext_vector_type(4)));
        const PG8_LAS float* rstdb = (const PG8_LAS float*)(lds + STAGE_BYTES + 1024);
#pragma unroll
        for (int ai = 0; ai < 2; ++ai) {
            const size_t g0 = (size_t)(u.pm * BM + ai * HALF + wid * 16) * 1024 + u.pn * BM + 4 * lane;
            typedef unsigned nt2 __attribute__((ext_vector_type(2)));
            nt2 xv[16];
#pragma unroll
            for (int i = 0; i < 16; ++i) xv[i] = __builtin_nontemporal_load((const nt2*)(xb + g0 + (size_t)i * 1024));
#pragma unroll
            for (int m = 0; m < 4; ++m) { const int r = wr * 64 + m * 16 + fr; const float rb = rstdb[ai * HALF + r];
#pragma unroll
                for (int bj = 0; bj < 2; ++bj)
#pragma unroll
                    for (int n = 0; n < 2; ++n) { const int c = bj * 32 + wc * 8 + n * 4 + fq;
                        *(PG8_LAS f32x4*)(lds + r * 1024 + ((c ^ (r & 15)) << 4)) = acc[ai][bj][m][n] * rb; } }
            asm volatile("s_waitcnt lgkmcnt(0)\n\ts_barrier" ::: "memory");
#pragma unroll
            for (int i = 0; i < 16; ++i) { const f32x4 v = *(const PG8_LAS f32x4*)(lds + (wid * 16 + i) * 1024 + ((lane ^ i) << 4));
                const f32x4 xr = {__builtin_bit_cast(float, xv[i].x << 16), __builtin_bit_cast(float, xv[i].x & 0xffff0000u), __builtin_bit_cast(float, xv[i].y << 16), __builtin_bit_cast(float, xv[i].y & 0xffff0000u)};
                __builtin_nontemporal_store(xr + v, (nt4*)(out + g0 + (size_t)i * 1024)); }
            if (ai == 0) asm volatile("s_waitcnt lgkmcnt(0)\n\ts_barrier" ::: "memory");
        }
    }
    const float* x; float* out; PG8_LAS unsigned char* ldsb; const bf16_t* xb;
    __device__ __forceinline__ void mid(f32x4 (&acc)[2][2][4][2], int wr, int fr, PG8_LAS unsigned char* lds) const {
        const PG8_LAS float* ratio = (const PG8_LAS float*)(lds + STAGE_BYTES);
#pragma unroll
        for (int ai = 0; ai < 2; ++ai)
#pragma unroll
            for (int m = 0; m < 4; ++m) { const float r = ratio[ai * HALF + wr * 64 + m * 16 + fr];
#pragma unroll
                for (int bj = 0; bj < 2; ++bj)
#pragma unroll
                    for (int n = 0; n < 2; ++n) acc[ai][bj][m][n] = acc[ai][bj][m][n] * r; }
    }
    __device__ __forceinline__ void operator()(const f32x4 (&acc)[2][2][4][2], const Unit& u, int wr, int wc, int fr, int fq) const {
        const PG8_LAS float* rstdb = (const PG8_LAS float*)(ldsb + STAGE_BYTES + 1024);
        const int row0 = u.pm * BM + wr * 64 + fr, col0 = u.pn * BM + wc * 32 + 4 * fq;
#pragma unroll
        for (int ai = 0; ai < 2; ++ai) {
            f32x4 xv[4][2][2]; float rb[4];
#pragma unroll
            for (int m = 0; m < 4; ++m) { rb[m] = rstdb[ai * HALF + wr * 64 + m * 16 + fr]; const size_t off = (size_t)(row0 + ai * HALF + m * 16) * 1024 + col0;
#pragma unroll
                for (int bj = 0; bj < 2; ++bj)
#pragma unroll
                    for (int n = 0; n < 2; ++n) xv[m][bj][n] = __builtin_nontemporal_load((const f32x4*)(x + off + bj * HALF + n * 16)); }
#pragma unroll
            for (int m = 0; m < 4; ++m) { const size_t off = (size_t)(row0 + ai * HALF + m * 16) * 1024 + col0;
#pragma unroll
                for (int bj = 0; bj < 2; ++bj)
#pragma unroll
                    for (int n = 0; n < 2; ++n) __builtin_nontemporal_store(xv[m][bj][n] + acc[ai][bj][m][n] * rb[m], (f32x4*)(out + off + bj * HALF + n * 16)); }
        }
    }
};
template <class Epi, class Sched, bool ALIGN_EPI = false, bool SP2 = false>
__device__ __forceinline__ void gemm_phase(PG8_LAS unsigned char* lds, const Gemm g, const Sched& S, const Epi& E) {
    const int tid = threadIdx.x, wid = __builtin_amdgcn_readfirstlane(tid >> 6), lane = tid & 63, wr = wid >> 2, wc = wid & 3, fr = lane & 15, fq = lane >> 4;
    const int K = g.K, nt = K / BK;
    unsigned voffA[2], voffB[2];
#pragma unroll
    for (int i = 0; i < 2; ++i) { int R, C; stage_rc(tid * 16 + i * 8192, R, C); const int Rb = Epi::PERM ? ((R & ~31) + perm32(R & 31)) : R;
        voffA[i] = (unsigned)(R * K + C) * 2u; voffB[i] = (unsigned)(Rb * K + C) * 2u; }
    const size_t kstep = (size_t)(BK * 2);
    const size_t hstep = (size_t)HALF * K * 2;
    const size_t tstep = 2 * hstep;
    const unsigned ldsw = (unsigned)wid * 1024u;
    const int aoff = lds_byte(wr * 64 + fr, fq * 8), boff = lds_byte(wc * 32 + fr, fq * 8);
#define PG8_SA(b, h) (((b) * 2 + (h)) * HTB)
#define PG8_SB(b, h) ((4 + (b) * 2 + (h)) * HTB)
#define PG8_STAGE(bufoff, gbase, voff) do { _Pragma("unroll") for (int _i = 0; _i < 2; ++_i) \
        __builtin_amdgcn_global_load_lds((const unsigned*)((const char*)(gbase) + (voff)[_i]), (PG8_LAS unsigned*)(lds + (bufoff) + ldsw + _i * 8192), 16, 0, 0); } while (0)
#define PG8_LDA(dst, b, h) do { _Pragma("unroll") for (int m = 0; m < 4; ++m) _Pragma("unroll") for (int k = 0; k < 2; ++k) dst[m][k] = *(const PG8_LAS bf16x8*)(lds + PG8_SA(b, h) + aoff + m * 2048 + k * 1024); } while (0)
#define PG8_LDB(dst, b, h) do { _Pragma("unroll") for (int n = 0; n < 2; ++n) _Pragma("unroll") for (int k = 0; k < 2; ++k) dst[n][k] = *(const PG8_LAS bf16x8*)(lds + PG8_SB(b, h) + boff + n * 2048 + k * 1024); } while (0)
#define PG8_MMA(ai, bj, At, Bt) do { __builtin_amdgcn_s_setprio(1); _Pragma("unroll") for (int m = 0; m < 4; ++m) _Pragma("unroll") for (int n = 0; n < 2; ++n) _Pragma("unroll") for (int k = 0; k < 2; ++k) \
        acc[ai][bj][m][n] = __builtin_amdgcn_mfma_f32_16x16x32_bf16(Bt[n][k], At[m][k], acc[ai][bj][m][n], 0, 0, 0); __builtin_amdgcn_s_setprio(0); } while (0)
#define PG8_WAIT_V(n) asm volatile("s_waitcnt vmcnt(" #n ")" ::: "memory")
#define PG8_WAIT_L(n) asm volatile("s_waitcnt lgkmcnt(" #n ")" ::: "memory")
#define PG8_BAR __builtin_amdgcn_s_barrier()
#define PG8_SCHED __builtin_amdgcn_sched_barrier(0)
    Unit cur, nxt; int ui = 0;
    if (!S.next(0, cur)) return;
    f32x4 acc[2][2][4][2];
#pragma unroll
    for (int a = 0; a < 2; ++a)
#pragma unroll
        for (int b = 0; b < 2; ++b)
#pragma unroll
            for (int m = 0; m < 4; ++m)
#pragma unroll
                for (int n = 0; n < 2; ++n) acc[a][b][m][n] = (f32x4){0.f, 0.f, 0.f, 0.f};
    bf16x8 At[4][2], B0[2][2], B1[2][2];
    const char* cA = (const char*)g.A + (size_t)cur.pm * tstep; const char* cB = (const char*)g.Bt + (size_t)cur.pn * tstep;
    S.a_ready(cur);
    if constexpr (SP2) {
        PG8_STAGE(PG8_SB(0, 0), cB, voffB); PG8_STAGE(PG8_SB(0, 1), cB + hstep, voffB); PG8_STAGE(PG8_SA(0, 0), cA, voffA); PG8_STAGE(PG8_SA(0, 1), cA + hstep, voffA);
        if (wr == 1) PG8_BAR;
        PG8_WAIT_V(2); PG8_BAR;
        PG8_STAGE(PG8_SB(1, 0), cB + kstep, voffB); PG8_STAGE(PG8_SA(1, 0), cA + kstep, voffA); PG8_STAGE(PG8_SB(1, 1), cB + hstep + kstep, voffB);
        PG8_WAIT_V(6); PG8_BAR;
    } else {
        PG8_STAGE(PG8_SB(0, 0), cB, voffB); PG8_STAGE(PG8_SA(0, 0), cA, voffA); PG8_STAGE(PG8_SB(0, 1), cB + hstep, voffB); PG8_STAGE(PG8_SA(0, 1), cA + hstep, voffA);
        if (wr == 1) PG8_BAR;
        PG8_WAIT_V(4); PG8_BAR;
        PG8_STAGE(PG8_SB(1, 0), cB + kstep, voffB); PG8_STAGE(PG8_SA(1, 0), cA + kstep, voffA); PG8_STAGE(PG8_SB(1, 1), cB + hstep + kstep, voffB);
        PG8_WAIT_V(6); PG8_BAR;
    }
    for (;;) {
        const bool has_next = S.next(ui + 1, nxt);
        const char* nA = has_next ? (const char*)g.A + (size_t)nxt.pm * tstep : cA; const char* nB = has_next ? (const char*)g.Bt + (size_t)nxt.pn * tstep : cB;
        for (int t = 0; t < nt; t += 2) {
            const bool last = (t == nt - 2);
            const char* a1 = cA + (size_t)(t + 1) * kstep;
            const char* a2 = last ? nA : cA + (size_t)(t + 2) * kstep; const char* b2 = last ? nB : cB + (size_t)(t + 2) * kstep;
            const char* a3 = a2 + kstep; const char* b3 = b2 + kstep;
            if (last && has_next) S.a_ready(nxt);
            if constexpr (Epi::HAS_MID) { if (t == Epi::MID_T) { PG8_SCHED; E.mid(acc, wr, fr, lds); PG8_SCHED; } }
            if constexpr (SP2) {
            PG8_LDB(B0, 0, 0); PG8_LDB(B1, 0, 1); PG8_SCHED; PG8_LDA(At, 0, 0); PG8_STAGE(PG8_SA(1, 1), a1 + hstep, voffA);
            PG8_WAIT_V(8); PG8_WAIT_L(0); PG8_BAR; PG8_MMA(0, 0, At, B0); PG8_MMA(0, 1, At, B1); PG8_BAR; PG8_SCHED;
            PG8_LDA(At, 0, 1); PG8_STAGE(PG8_SB(0, 0), b2, voffB); PG8_STAGE(PG8_SB(0, 1), b2 + hstep, voffB); PG8_STAGE(PG8_SA(0, 0), a2, voffA);
            PG8_WAIT_V(8); PG8_WAIT_L(0); PG8_BAR; PG8_MMA(1, 0, At, B0); PG8_MMA(1, 1, At, B1); PG8_BAR; PG8_SCHED;
            PG8_LDB(B0, 1, 0); PG8_LDB(B1, 1, 1); PG8_SCHED; PG8_LDA(At, 1, 0); PG8_STAGE(PG8_SA(0, 1), a2 + hstep, voffA);
            PG8_WAIT_V(8); PG8_WAIT_L(0); PG8_BAR; PG8_MMA(0, 0, At, B0); PG8_MMA(0, 1, At, B1); PG8_BAR; PG8_SCHED;
            PG8_LDA(At, 1, 1); PG8_STAGE(PG8_SB(1, 0), b3, voffB); PG8_STAGE(PG8_SB(1, 1), b3 + hstep, voffB); PG8_STAGE(PG8_SA(1, 0), a3, voffA);
            PG8_WAIT_V(8); PG8_WAIT_L(0); PG8_BAR; PG8_MMA(1, 0, At, B0); PG8_MMA(1, 1, At, B1); PG8_BAR; PG8_SCHED;
            } else {
            PG8_LDB(B0, 0, 0); PG8_SCHED; PG8_LDA(At, 0, 0); PG8_STAGE(PG8_SA(1, 1), a1 + hstep, voffA);
            PG8_WAIT_L(8); PG8_BAR; PG8_WAIT_L(0); PG8_MMA(0, 0, At, B0); PG8_BAR; PG8_SCHED;
            PG8_LDB(B1, 0, 1); PG8_STAGE(PG8_SB(0, 0), b2, voffB);
            PG8_BAR; PG8_WAIT_L(0); PG8_MMA(0, 1, At, B1); PG8_BAR;
            PG8_LDA(At, 0, 1); PG8_STAGE(PG8_SA(0, 0), a2, voffA);
            PG8_BAR; PG8_WAIT_L(0); PG8_MMA(1, 0, At, B0); PG8_BAR; PG8_SCHED;
            PG8_STAGE(PG8_SB(0, 1), b2 + hstep, voffB);
            PG8_WAIT_V(6); PG8_BAR; PG8_MMA(1, 1, At, B1); PG8_BAR;
            PG8_LDB(B0, 1, 0); PG8_SCHED; PG8_LDA(At, 1, 0); PG8_STAGE(PG8_SA(0, 1), a2 + hstep, voffA);
            PG8_WAIT_L(8); PG8_BAR; PG8_WAIT_L(0); PG8_MMA(0, 0, At, B0); PG8_BAR; PG8_SCHED;
            PG8_LDB(B1, 1, 1); PG8_STAGE(PG8_SB(1, 0), b3, voffB);
            PG8_BAR; PG8_WAIT_L(0); PG8_MMA(0, 1, At, B1); PG8_BAR;
            PG8_LDA(At, 1, 1); PG8_STAGE(PG8_SA(1, 0), a3, voffA);
            PG8_BAR; PG8_WAIT_L(0); PG8_MMA(1, 0, At, B0); PG8_BAR; PG8_SCHED;
            PG8_STAGE(PG8_SB(1, 1), b3 + hstep, voffB);
            PG8_WAIT_V(6); PG8_BAR; PG8_MMA(1, 1, At, B1); PG8_BAR;
            }
        }
        if constexpr (ALIGN_EPI) { if (wr == 0) PG8_BAR; }
        if constexpr (Epi::FUSE_LAST) { if (has_next || !E.fused_unit(cur)) E(acc, cur, wr, wc, fr, fq); S.done(cur); }
        else if constexpr (!Epi::AFTER_DRAIN) { E(acc, cur, wr, wc, fr, fq); S.done(cur); }
        if (!has_next) break;
#pragma unroll
        for (int a = 0; a < 2; ++a)
#pragma unroll
            for (int b = 0; b < 2; ++b)
#pragma unroll
                for (int m = 0; m < 4; ++m)
#pragma unroll
                    for (int n = 0; n < 2; ++n) acc[a][b][m][n] = (f32x4){0.f, 0.f, 0.f, 0.f};
        cur = nxt; cA = nA; cB = nB; ++ui;
        if constexpr (ALIGN_EPI) { if (wr == 1) PG8_BAR; }
    }
    PG8_WAIT_V(0);
    if constexpr (!ALIGN_EPI) { if (wr == 0) PG8_BAR; }
    PG8_BAR;
    if constexpr (Epi::FUSE_LAST) { if (E.fused_unit(cur)) E.fused(acc, cur, wr, wc, fr, fq, lds, wid, lane); }
    else if constexpr (Epi::AFTER_DRAIN) { E.fused(acc, cur, wr, wc, fr, fq, lds, wid, lane); S.done(cur); }
#undef PG8_SA
#undef PG8_SB
#undef PG8_STAGE
#undef PG8_LDA
#undef PG8_LDB
#undef PG8_MMA
#undef PG8_WAIT_V
#undef PG8_WAIT_L
#undef PG8_BAR
#undef PG8_SCHED
}
}


namespace att {
typedef short bf16x8 __attribute__((ext_vector_type(8)));
typedef float f32x16 __attribute__((ext_vector_type(16)));
typedef float f32x2_t __attribute__((ext_vector_type(2))); typedef __bf16 bf16x2_t __attribute__((ext_vector_type(2)));
DI unsigned cvtpk(float lo, float hi) { f32x2_t v = {lo, hi}; bf16x2_t b = __builtin_convertvector(v, bf16x2_t); return __builtin_bit_cast(unsigned, b); }
DI void glds16(const void* gsrc, unsigned lds_dst) { unsigned keep;
    asm volatile("s_mov_b32 %0, m0\n\ts_mov_b32 m0, %2\n\ts_nop 0\n\tglobal_load_lds_dwordx4 %1, off\n\ts_mov_b32 m0, %0" : "=&s"(keep) : "v"(gsrc), "s"(lds_dst) : "memory"); }
constexpr int SLOTB = 20480, KBYTES = 12288, VBYTES = 8192;
#define MFMA32(a, b, c) __builtin_amdgcn_mfma_f32_32x32x16_bf16((a), (b), (c), 0, 0, 0)
DI void attn_epi64(const Ptrs& p, const f32x16& o0, const f32x16& o1, float lsum, int bh, int q0, int lane) {
    const int r = lane & 31, h = lane >> 5;
    lsum += __shfl_xor(lsum, 32);
    const float rl = __builtin_amdgcn_rcpf(lsum);
    const int b = bh >> 3, hd = bh & 7, t = b * SEQ + q0 + r;
    const bf16_t* Z = (const bf16_t*)(p.ws + WS_Z) + (size_t)t * 2048 + hd * 64 + 4 * h;
    bf16_t* A = (bf16_t*)(p.ws + WS_AMIX) + (size_t)t * 1024 + hd * 64 + 4 * h;
    float sq = 0.f;
    uint2 zld[2][4];
#pragma unroll
    for (int dt = 0; dt < 2; ++dt)
#pragma unroll
        for (int g = 0; g < 4; ++g) zld[dt][g] = *(const uint2*)(Z + 32 * dt + 8 * g);
#pragma unroll
    for (int dt = 0; dt < 2; ++dt)
#pragma unroll
        for (int g = 0; g < 4; ++g) {
            const uint2 zz2 = zld[dt][g];
            float ov[4];
#pragma unroll
            for (int e = 0; e < 4; ++e) { ov[e] = (dt ? o1[4 * g + e] : o0[4 * g + e]) * rl; sq += ov[e] * ov[e]; }
            const float z0 = __uint_as_float(zz2.x << 16), z1 = __uint_as_float(zz2.x & 0xffff0000u), z2 = __uint_as_float(zz2.y << 16), z3 = __uint_as_float(zz2.y & 0xffff0000u);
            uint2 w; w.x = cvtpk(ov[0] * silu(z0), ov[1] * silu(z1)); w.y = cvtpk(ov[2] * silu(z2), ov[3] * silu(z3));
            *(uint2*)(A + 32 * dt + 8 * g) = w;
        }
    sq += __shfl_xor(sq, 32);
    if (h == 0) ((float*)(p.ws + WS_SSQA))[(size_t)hd * T + t] = sq;
}
DI void attn_unit64(LAS unsigned char* lds, const Ptrs& p, int bh, int qb512, int wid, int lane) {
    const unsigned lds0 = (unsigned)(uintptr_t)lds;
    const unsigned char* Kg = p.ws + WS_KIMG + (size_t)bh * 64 * KBYTES + lane * 16;
    const unsigned char* Vg = p.ws + WS_VIMG + (size_t)bh * 64 * VBYTES + lane * 16;
    const bf16x8* Qg = (const bf16x8*)(p.ws + WS_QIMG + ((size_t)(bh * 128 + qb512 * 16 + 2 * wid) * 6 * 64 + lane) * 16);
    bf16x8 qa[6], qb[6];
#pragma unroll
    for (int kk = 0; kk < 6; ++kk) { qa[kk] = Qg[kk * 64]; qb[kk] = Qg[(6 + kk) * 64]; }
#define ATT_DMA(t, slotoff) do { const unsigned char* kt_ = Kg + (size_t)(t) * KBYTES; const unsigned char* vt_ = Vg + (size_t)(t) * VBYTES; \
        glds16(kt_ + wid * 1024, (unsigned)__builtin_amdgcn_readfirstlane(lds0 + (slotoff) + wid * 1024)); \
        if (wid < 4) { glds16(kt_ + (wid + 8) * 1024, (unsigned)__builtin_amdgcn_readfirstlane(lds0 + (slotoff) + (wid + 8) * 1024)); \
                       glds16(vt_ + (wid + 4) * 1024, (unsigned)__builtin_amdgcn_readfirstlane(lds0 + (slotoff) + KBYTES + (wid + 4) * 1024)); } \
        else glds16(vt_ + (wid - 4) * 1024, (unsigned)__builtin_amdgcn_readfirstlane(lds0 + (slotoff) + KBYTES + (wid - 4) * 1024)); } while (0)
#define ATT_WAIT_MINE() do { if (wid < 4) asm volatile("s_waitcnt vmcnt(3) lgkmcnt(0)\n\ts_barrier" ::: "memory"); else asm volatile("s_waitcnt vmcnt(2) lgkmcnt(0)\n\ts_barrier" ::: "memory"); } while (0)
#define ATT_WAIT_ALL() asm volatile("s_waitcnt vmcnt(0) lgkmcnt(0)\n\ts_barrier" ::: "memory")
#define SBAR() __builtin_amdgcn_sched_barrier(0)
#define EX(v) __builtin_amdgcn_exp2f(v)
#define LD(ptr) (*(const LAS bf16x8*)(ptr))
#define MF(a, b, c) MFMA32((a), (b), (c))
    ATT_DMA(0, 0); ATT_DMA(1, SLOTB); ATT_DMA(2, 2 * SLOTB); ATT_DMA(3, 3 * SLOTB);
    ATT_WAIT_ALL();
    f32x16 OA0, OA1, OB0, OB1, SA0, SA1, SB0, SB1, zz;
#pragma unroll
    for (int i = 0; i < 16; ++i) { OA0[i] = 0.f; OA1[i] = 0.f; OB0[i] = 0.f; OB1[i] = 0.f; zz[i] = 0.f; }
    float lsA = 0.f, lsB = 0.f;
    uint4 pA0_0, pA0_1, pA1_0, pA1_1, pB0_0, pB0_1, pB1_0, pB1_1;
    bf16x8 fr0, fr1, fr2, fr3;
    {
        const LAS unsigned char* kp0 = lds + lane * 16;
        SA0 = zz; SA1 = zz; SB0 = zz; SB1 = zz;
#pragma unroll
        for (int kk = 0; kk < 6; ++kk) { const bf16x8 k0 = LD(kp0 + (2 * kk) * 1024), k1 = LD(kp0 + (2 * kk + 1) * 1024);
            SA0 = MFMA32(k0, qa[kk], SA0); SA1 = MFMA32(k1, qa[kk], SA1); SB0 = MFMA32(k0, qb[kk], SB0); SB1 = MFMA32(k1, qb[kk], SB1); }
#pragma unroll
        for (int i = 0; i < 16; ++i) { SA0[i] = EX(SA0[i]); SB0[i] = EX(SB0[i]); lsA += SA0[i]; lsB += SB0[i]; }
        pA0_0 = make_uint4(cvtpk(SA0[0], SA0[1]), cvtpk(SA0[2], SA0[3]), cvtpk(SA0[4], SA0[5]), cvtpk(SA0[6], SA0[7]));
        pA0_1 = make_uint4(cvtpk(SA0[8], SA0[9]), cvtpk(SA0[10], SA0[11]), cvtpk(SA0[12], SA0[13]), cvtpk(SA0[14], SA0[15]));
        pB0_0 = make_uint4(cvtpk(SB0[0], SB0[1]), cvtpk(SB0[2], SB0[3]), cvtpk(SB0[4], SB0[5]), cvtpk(SB0[6], SB0[7]));
        pB0_1 = make_uint4(cvtpk(SB0[8], SB0[9]), cvtpk(SB0[10], SB0[11]), cvtpk(SB0[12], SB0[13]), cvtpk(SB0[14], SB0[15]));
        fr0 = LD(kp0 + SLOTB + 0 * 1024); fr1 = LD(kp0 + SLOTB + 2 * 1024);
        pA1_0 = pA0_0; pA1_1 = pA0_1; pB1_0 = pB0_0; pB1_1 = pB0_1; fr2 = fr0; fr3 = fr1;
    }
    int off_v = 0, off_k1 = SLOTB, off_k2 = 2 * SLOTB, off_d = 4 * SLOTB, off_d2 = 5 * SLOTB;
#define A64H_STEP(LAST, ODD) do { \
        if (!(ODD)) { if (t + 4 < 64) ATT_DMA(t + 4, off_d); if (t + 5 < 64) ATT_DMA(t + 5, off_d2); } \
        const LAS unsigned char* vp_ = lds + off_v + KBYTES + lane * 16; const LAS unsigned char* kp_ = lds + off_k1 + lane * 16; const LAS unsigned char* kn_ = lds + off_k2 + lane * 16; \
        float la_ = 0.f, lb_ = 0.f; SBAR(); \
        if (!(LAST)) SA0 = MF(fr0, qa[0], zz); fr2 = LD(kp_ + 4096); SA1[0] = EX(SA1[0]); SA1[1] = EX(SA1[1]); SA1[2] = EX(SA1[2]); SBAR(); \
        if (!(LAST)) SB0 = MF(fr0, qb[0], zz); SA1[3] = EX(SA1[3]); SA1[4] = EX(SA1[4]); SA1[5] = EX(SA1[5]); SBAR(); \
        if (!(LAST)) SA0 = MF(fr1, qa[1], SA0); fr3 = LD(kp_ + 6144); SA1[6] = EX(SA1[6]); SA1[7] = EX(SA1[7]); SA1[8] = EX(SA1[8]); SBAR(); \
        if (!(LAST)) SB0 = MF(fr1, qb[1], SB0); SA1[9] = EX(SA1[9]); SA1[10] = EX(SA1[10]); SA1[11] = EX(SA1[11]); SBAR(); \
        if (!(LAST)) SA0 = MF(fr2, qa[2], SA0); fr0 = LD(kp_ + 8192); SA1[12] = EX(SA1[12]); SA1[13] = EX(SA1[13]); SA1[14] = EX(SA1[14]); SBAR(); \
        if (!(LAST)) SB0 = MF(fr2, qb[2], SB0); SA1[15] = EX(SA1[15]); SB1[0] = EX(SB1[0]); SB1[1] = EX(SB1[1]); SBAR(); \
        if (!(LAST)) SA0 = MF(fr3, qa[3], SA0); fr1 = LD(kp_ + 10240); SB1[2] = EX(SB1[2]); SB1[3] = EX(SB1[3]); SB1[4] = EX(SB1[4]); SBAR(); \
        if (!(LAST)) SB0 = MF(fr3, qb[3], SB0); SB1[5] = EX(SB1[5]); SB1[6] = EX(SB1[6]); SB1[7] = EX(SB1[7]); SBAR(); \
        if (!(LAST)) SA0 = MF(fr0, qa[4], SA0); fr2 = LD(vp_ + 0); SB1[8] = EX(SB1[8]); SB1[9] = EX(SB1[9]); SBAR(); \
        if (!(LAST)) SB0 = MF(fr0, qb[4], SB0); SB1[10] = EX(SB1[10]); SB1[11] = EX(SB1[11]); SBAR(); \
        if (!(LAST)) SA0 = MF(fr1, qa[5], SA0); fr3 = LD(vp_ + 1024); SB1[12] = EX(SB1[12]); SB1[13] = EX(SB1[13]); SBAR(); \
        if (!(LAST)) SB0 = MF(fr1, qb[5], SB0); SB1[14] = EX(SB1[14]); SB1[15] = EX(SB1[15]); SBAR(); \
        OA0 = MF(fr2, __builtin_bit_cast(bf16x8, pA0_0), OA0); fr0 = LD(vp_ + 2048); pA1_0.x = cvtpk(SA1[0], SA1[1]); pA1_0.y = cvtpk(SA1[2], SA1[3]); la_ += SA1[0]; la_ += SA1[1]; la_ += SA1[2]; la_ += SA1[3]; asm volatile("" : "+v"(la_), "+v"(lb_)); SBAR(); \
        OB0 = MF(fr2, __builtin_bit_cast(bf16x8, pB0_0), OB0); pA1_0.z = cvtpk(SA1[4], SA1[5]); pA1_0.w = cvtpk(SA1[6], SA1[7]); la_ += SA1[4]; la_ += SA1[5]; la_ += SA1[6]; la_ += SA1[7]; asm volatile("" : "+v"(la_), "+v"(lb_)); SBAR(); \
        OA1 = MF(fr3, __builtin_bit_cast(bf16x8, pA0_0), OA1); fr1 = LD(vp_ + 3072); pA1_1.x = cvtpk(SA1[8], SA1[9]); pA1_1.y = cvtpk(SA1[10], SA1[11]); la_ += SA1[8]; la_ += SA1[9]; la_ += SA1[10]; la_ += SA1[11]; asm volatile("" : "+v"(la_), "+v"(lb_)); SBAR(); \
        OB1 = MF(fr3, __builtin_bit_cast(bf16x8, pB0_0), OB1); pA1_1.z = cvtpk(SA1[12], SA1[13]); pA1_1.w = cvtpk(SA1[14], SA1[15]); la_ += SA1[12]; la_ += SA1[13]; la_ += SA1[14]; la_ += SA1[15]; asm volatile("" : "+v"(la_), "+v"(lb_)); SBAR(); \
        OA0 = MF(fr0, __builtin_bit_cast(bf16x8, pA0_1), OA0); fr2 = LD(kp_ + 1024); pB1_0.x = cvtpk(SB1[0], SB1[1]); pB1_0.y = cvtpk(SB1[2], SB1[3]); lb_ += SB1[0]; lb_ += SB1[1]; lb_ += SB1[2]; lb_ += SB1[3]; asm volatile("" : "+v"(la_), "+v"(lb_)); SBAR(); \
        OB0 = MF(fr0, __builtin_bit_cast(bf16x8, pB0_1), OB0); pB1_0.z = cvtpk(SB1[4], SB1[5]); pB1_0.w = cvtpk(SB1[6], SB1[7]); lb_ += SB1[4]; lb_ += SB1[5]; lb_ += SB1[6]; lb_ += SB1[7]; asm volatile("" : "+v"(la_), "+v"(lb_)); SBAR(); \
        OA1 = MF(fr1, __builtin_bit_cast(bf16x8, pA0_1), OA1); fr3 = LD(kp_ + 3072); pB1_1.x = cvtpk(SB1[8], SB1[9]); pB1_1.y = cvtpk(SB1[10], SB1[11]); lb_ += SB1[8]; lb_ += SB1[9]; lb_ += SB1[10]; lb_ += SB1[11]; asm volatile("" : "+v"(la_), "+v"(lb_)); SBAR(); \
        OB1 = MF(fr1, __builtin_bit_cast(bf16x8, pB0_1), OB1); pB1_1.z = cvtpk(SB1[12], SB1[13]); pB1_1.w = cvtpk(SB1[14], SB1[15]); lb_ += SB1[12]; lb_ += SB1[13]; lb_ += SB1[14]; lb_ += SB1[15]; asm volatile("" : "+v"(la_), "+v"(lb_)); SBAR(); \
        if (!(LAST)) SA1 = MF(fr2, qa[0], zz); fr0 = LD(kp_ + 5120); if (!(LAST)) { SA0[0] = EX(SA0[0]); SA0[1] = EX(SA0[1]); SA0[2] = EX(SA0[2]); } SBAR(); \
        if (!(LAST)) SB1 = MF(fr2, qb[0], zz); if (!(LAST)) { SA0[3] = EX(SA0[3]); SA0[4] = EX(SA0[4]); SA0[5] = EX(SA0[5]); } SBAR(); \
        if (!(LAST)) SA1 = MF(fr3, qa[1], SA1); fr1 = LD(kp_ + 7168); if (!(LAST)) { SA0[6] = EX(SA0[6]); SA0[7] = EX(SA0[7]); SA0[8] = EX(SA0[8]); } SBAR(); \
        if (!(LAST)) SB1 = MF(fr3, qb[1], SB1); if (!(LAST)) { SA0[9] = EX(SA0[9]); SA0[10] = EX(SA0[10]); SA0[11] = EX(SA0[11]); } SBAR(); \
        if (!(LAST)) SA1 = MF(fr0, qa[2], SA1); fr2 = LD(kp_ + 9216); if (!(LAST)) { SA0[12] = EX(SA0[12]); SA0[13] = EX(SA0[13]); SA0[14] = EX(SA0[14]); } SBAR(); \
        if (!(LAST)) SB1 = MF(fr0, qb[2], SB1); if (!(LAST)) { SA0[15] = EX(SA0[15]); SB0[0] = EX(SB0[0]); SB0[1] = EX(SB0[1]); } SBAR(); \
        if (!(LAST)) SA1 = MF(fr1, qa[3], SA1); fr3 = LD(kp_ + 11264); if (!(LAST)) { SB0[2] = EX(SB0[2]); SB0[3] = EX(SB0[3]); SB0[4] = EX(SB0[4]); } SBAR(); \
        if (!(LAST)) SB1 = MF(fr1, qb[3], SB1); if (!(LAST)) { SB0[5] = EX(SB0[5]); SB0[6] = EX(SB0[6]); SB0[7] = EX(SB0[7]); } SBAR(); \
        if (!(LAST)) SA1 = MF(fr2, qa[4], SA1); fr0 = LD(vp_ + 4096); if (!(LAST)) { SB0[8] = EX(SB0[8]); SB0[9] = EX(SB0[9]); } SBAR(); \
        if (!(LAST)) SB1 = MF(fr2, qb[4], SB1); if (!(LAST)) { SB0[10] = EX(SB0[10]); SB0[11] = EX(SB0[11]); } SBAR(); \
        if (!(LAST)) SA1 = MF(fr3, qa[5], SA1); fr1 = LD(vp_ + 5120); if (!(LAST)) { SB0[12] = EX(SB0[12]); SB0[13] = EX(SB0[13]); } SBAR(); \
        if (!(LAST)) SB1 = MF(fr3, qb[5], SB1); if (!(LAST)) { SB0[14] = EX(SB0[14]); SB0[15] = EX(SB0[15]); } SBAR(); \
        OA0 = MF(fr0, __builtin_bit_cast(bf16x8, pA1_0), OA0); fr2 = LD(vp_ + 6144); if (!(LAST)) { pA0_0.x = cvtpk(SA0[0], SA0[1]); pA0_0.y = cvtpk(SA0[2], SA0[3]); la_ += SA0[0]; la_ += SA0[1]; la_ += SA0[2]; la_ += SA0[3]; asm volatile("" : "+v"(la_), "+v"(lb_), "+v"(pA0_0.x), "+v"(pA0_0.y)); } SBAR(); \
        OB0 = MF(fr0, __builtin_bit_cast(bf16x8, pB1_0), OB0); if (!(LAST)) { pA0_0.z = cvtpk(SA0[4], SA0[5]); pA0_0.w = cvtpk(SA0[6], SA0[7]); la_ += SA0[4]; la_ += SA0[5]; la_ += SA0[6]; la_ += SA0[7]; asm volatile("" : "+v"(la_), "+v"(lb_), "+v"(pA0_0.z), "+v"(pA0_0.w)); } SBAR(); \
        OA1 = MF(fr1, __builtin_bit_cast(bf16x8, pA1_0), OA1); fr3 = LD(vp_ + 7168); if (!(LAST)) { pA0_1.x = cvtpk(SA0[8], SA0[9]); pA0_1.y = cvtpk(SA0[10], SA0[11]); la_ += SA0[8]; la_ += SA0[9]; la_ += SA0[10]; la_ += SA0[11]; asm volatile("" : "+v"(la_), "+v"(lb_), "+v"(pA0_1.x), "+v"(pA0_1.y)); } SBAR(); \
        OB1 = MF(fr1, __builtin_bit_cast(bf16x8, pB1_0), OB1); if (!(LAST)) { pA0_1.z = cvtpk(SA0[12], SA0[13]); pA0_1.w = cvtpk(SA0[14], SA0[15]); la_ += SA0[12]; la_ += SA0[13]; la_ += SA0[14]; la_ += SA0[15]; asm volatile("" : "+v"(la_), "+v"(lb_), "+v"(pA0_1.z), "+v"(pA0_1.w)); } SBAR(); \
        OA0 = MF(fr2, __builtin_bit_cast(bf16x8, pA1_1), OA0); if (!(LAST) || 20 < 20) fr0 = LD(kn_ + 0); if (!(LAST)) { pB0_0.x = cvtpk(SB0[0], SB0[1]); pB0_0.y = cvtpk(SB0[2], SB0[3]); lb_ += SB0[0]; lb_ += SB0[1]; lb_ += SB0[2]; lb_ += SB0[3]; asm volatile("" : "+v"(la_), "+v"(lb_), "+v"(pB0_0.x), "+v"(pB0_0.y)); } SBAR(); \
        OB0 = MF(fr2, __builtin_bit_cast(bf16x8, pB1_1), OB0); if (!(LAST)) { pB0_0.z = cvtpk(SB0[4], SB0[5]); pB0_0.w = cvtpk(SB0[6], SB0[7]); lb_ += SB0[4]; lb_ += SB0[5]; lb_ += SB0[6]; lb_ += SB0[7]; asm volatile("" : "+v"(la_), "+v"(lb_), "+v"(pB0_0.z), "+v"(pB0_0.w)); } SBAR(); \
        OA1 = MF(fr3, __builtin_bit_cast(bf16x8, pA1_1), OA1); if (!(LAST) || 21 < 20) fr1 = LD(kn_ + 2048); if (!(LAST)) { pB0_1.x = cvtpk(SB0[8], SB0[9]); pB0_1.y = cvtpk(SB0[10], SB0[11]); lb_ += SB0[8]; lb_ += SB0[9]; lb_ += SB0[10]; lb_ += SB0[11]; asm volatile("" : "+v"(la_), "+v"(lb_), "+v"(pB0_1.x), "+v"(pB0_1.y)); } SBAR(); \
        OB1 = MF(fr3, __builtin_bit_cast(bf16x8, pB1_1), OB1); if (!(LAST)) { pB0_1.z = cvtpk(SB0[12], SB0[13]); pB0_1.w = cvtpk(SB0[14], SB0[15]); lb_ += SB0[12]; lb_ += SB0[13]; lb_ += SB0[14]; lb_ += SB0[15]; asm volatile("" : "+v"(la_), "+v"(lb_), "+v"(pB0_1.z), "+v"(pB0_1.w)); } SBAR(); \
        lsA += la_; lsB += lb_; \
        if (ODD) ATT_WAIT_ALL(); \
        off_v = off_k1; off_k1 = off_k2; off_k2 = (off_k2 == 5 * SLOTB) ? 0 : off_k2 + SLOTB; off_d = off_d2; off_d2 = (off_d2 == 5 * SLOTB) ? 0 : off_d2 + SLOTB; \
    } while (0)
    int t = 0;
    for (; t < 62; t += 2) { A64H_STEP(false, false); A64H_STEP(false, true); }
    A64H_STEP(false, false); A64H_STEP(true, true);
    const int q0 = qb512 * 512 + wid * 64;
    attn_epi64(p, OA0, OA1, lsA, bh, q0, lane);
    attn_epi64(p, OB0, OB1, lsB, bh, q0 + 32, lane);
    asm volatile("s_waitcnt vmcnt(0) lgkmcnt(0)\n\ts_barrier" ::: "memory");
#undef ATT_DMA
#undef ATT_WAIT_MINE
#undef ATT_WAIT_ALL
#undef A64H_STEP
#undef SBAR
#undef EX
#undef LD
#undef MF
}
DI void attn_phase64(LAS unsigned char* lds, const Ptrs& p, int vcu, int G) {
    const int lane = threadIdx.x & 63, wid = __builtin_amdgcn_readfirstlane(threadIdx.x >> 6);
    for (int U = vcu; U < 256; U += G) attn_unit64(lds, p, U >> 3, U & 7, wid, lane);
}
}


namespace p2 {
typedef short bf16x8 __attribute__((ext_vector_type(8)));
typedef short s16x4 __attribute__((ext_vector_type(4)));
typedef unsigned u32x4v __attribute__((ext_vector_type(4)));
typedef float f32x16 __attribute__((ext_vector_type(16)));
using att::cvtpk; using att::glds16;
DI int crow(int i, int h) { return (i & 3) + 8 * (i >> 2) + 4 * h; }
DI float lo16(unsigned u) { return __uint_as_float(u << 16); }
DI float hi16(unsigned u) { return __uint_as_float(u & 0xffff0000u); }
DI float frag_ssq(const bf16x8& f) { const uint4 u = __builtin_bit_cast(uint4, f); float s = 0.f;
    s += lo16(u.x) * lo16(u.x) + hi16(u.x) * hi16(u.x); s += lo16(u.y) * lo16(u.y) + hi16(u.y) * hi16(u.y);
    s += lo16(u.z) * lo16(u.z) + hi16(u.z) * hi16(u.z); s += lo16(u.w) * lo16(u.w) + hi16(u.w) * hi16(u.w); return s; }
DI bf16x8 frag_scale(const bf16x8& f, float sc) { const uint4 u = __builtin_bit_cast(uint4, f); uint4 o;
    o.x = cvtpk(lo16(u.x) * sc, hi16(u.x) * sc); o.y = cvtpk(lo16(u.y) * sc, hi16(u.y) * sc); o.z = cvtpk(lo16(u.z) * sc, hi16(u.z) * sc); o.w = cvtpk(lo16(u.w) * sc, hi16(u.w) * sc);
    return __builtin_bit_cast(bf16x8, o); }
DI uint4 pack8(const f32x16& a, int g, float sc, const float (&gv)[16]) {
    float v[8];
#pragma unroll
    for (int j = 0; j < 8; ++j) v[j] = a[8 * g + j] * sc * gv[8 * g + j];
    uint4 o; o.x = cvtpk(v[0], v[1]); o.y = cvtpk(v[2], v[3]); o.z = cvtpk(v[4], v[5]); o.w = cvtpk(v[6], v[7]); return o;
}
DI uint4 pack8n(const f32x16& a, int g, float sc) {
    uint4 o; o.x = cvtpk(a[8 * g + 0] * sc, a[8 * g + 1] * sc); o.y = cvtpk(a[8 * g + 2] * sc, a[8 * g + 3] * sc); o.z = cvtpk(a[8 * g + 4] * sc, a[8 * g + 5] * sc); o.w = cvtpk(a[8 * g + 6] * sc, a[8 * g + 7] * sc); return o;
}
DI s16x4 vtr(const LAS unsigned char* q) { return __builtin_bit_cast(s16x4, __builtin_amdgcn_ds_read_tr16_b64_v4i16((LAS s16x4*)q)); }
DI void glds16s(const void* sbase, unsigned voff, unsigned lds_dst) { unsigned keep;
    asm volatile("s_mov_b32 %0, m0\n\ts_mov_b32 m0, %3\n\ts_nop 0\n\tglobal_load_lds_dwordx4 %1, %2\n\ts_mov_b32 m0, %0" : "=&s"(keep) : "v"(voff), "s"(sbase), "s"(lds_dst) : "memory"); }
template <int NP8> DI void dma_copy(const unsigned char* gsrc, unsigned lds_dst, int wid, int lane) {
    const unsigned voff = (unsigned)(wid * 1024 + lane * 16);
#pragma unroll
    for (int i = 0; i < NP8; ++i) glds16s(gsrc + (size_t)i * 8192, voff, (unsigned)__builtin_amdgcn_readfirstlane(lds_dst + (i * 8 + wid) * 1024));
}
#define P2_BAR_V(N) asm volatile("s_waitcnt vmcnt(" #N ") lgkmcnt(0)\n\ts_barrier" ::: "memory")

DI void q_head(const Ptrs& p, const LAS unsigned char* wb, const bf16x8 (&cf)[16], float rq, const float (&cs)[8], const float (&sn)[8], int bh, int qblk, int lane) {
    const int h = lane >> 5;
    f32x16 acc[3];
#pragma unroll
    for (int nt = 0; nt < 3; ++nt) {
#pragma unroll
        for (int i = 0; i < 16; ++i) acc[nt][i] = 0.f;
#pragma unroll
        for (int ks = 0; ks < 16; ++ks) acc[nt] = MFMA32(*(const LAS bf16x8*)(wb + (nt * 16 + ks) * 1024 + lane * 16), cf[ks], acc[nt]);
    }
#pragma unroll
    for (int nt = 0; nt < 3; ++nt)
#pragma unroll
        for (int i = 0; i < 16; ++i) acc[nt][i] *= rq;
#pragma unroll
    for (int i = 0; i < 8; ++i) { const float a = acc[2][i], bb = acc[2][i + 8]; acc[2][i] = a * cs[i] - bb * sn[i]; acc[2][i + 8] = bb * cs[i] + a * sn[i]; }
    float sh = 0.f;
#pragma unroll
    for (int nt = 0; nt < 3; ++nt)
#pragma unroll
        for (int i = 0; i < 16; ++i) sh += acc[nt][i] * acc[nt][i];
    sh += __shfl_xor(sh, 32);
    const float rh = QSCALE * rsqrt_fast(sh * (1.f / 96.f) + EPS);
    uint4* dst = (uint4*)(p.ws + WS_QIMG) + ((size_t)(bh * 128 + qblk) * 6) * 64 + lane;
#pragma unroll
    for (int nt = 0; nt < 3; ++nt)
#pragma unroll
        for (int g = 0; g < 2; ++g) dst[(2 * nt + g) * 64] = pack8n(acc[nt], g, rh);
}
DI void kv_head(const Ptrs& p, const LAS unsigned char* wb, const bf16x8 (&cf)[8], const f32x16& kpe, float sspe, const float (&gk)[3][16], int bh, int tile, int c, int lane) {
    const int h = lane >> 5;
    f32x16 acc[2];
#pragma unroll
    for (int nt = 0; nt < 2; ++nt) {
#pragma unroll
        for (int i = 0; i < 16; ++i) acc[nt][i] = 0.f;
#pragma unroll
        for (int ks = 0; ks < 8; ++ks) acc[nt] = MFMA32(*(const LAS bf16x8*)(wb + (nt * 8 + ks) * 1024 + lane * 16), cf[ks], acc[nt]);
    }
    float sk = sspe;
#pragma unroll
    for (int nt = 0; nt < 2; ++nt)
#pragma unroll
        for (int i = 0; i < 16; ++i) sk += acc[nt][i] * acc[nt][i];
    sk += __shfl_xor(sk, 32);
    const float rk = rsqrt_fast(sk * (1.f / 96.f) + EPS);
    uint4* kd = (uint4*)(p.ws + WS_KIMG) + (size_t)(bh * 64 + tile) * 6 * 2 * 64 + c * 64 + lane;
#pragma unroll
    for (int nt = 0; nt < 2; ++nt)
#pragma unroll
        for (int g = 0; g < 2; ++g) kd[(2 * nt + g) * 128] = pack8(acc[nt], g, rk, gk[nt]);
#pragma unroll
    for (int g = 0; g < 2; ++g) kd[(4 + g) * 128] = pack8(kpe, g, rk, gk[2]);
    uint4* vd = (uint4*)(p.ws + WS_VIMG) + (size_t)(bh * 64 + tile) * 8 * 64 + c * 4 * 64 + lane;
#pragma unroll
    for (int dt = 0; dt < 2; ++dt) {
        f32x16 av;
#pragma unroll
        for (int i = 0; i < 16; ++i) av[i] = 0.f;
#pragma unroll
        for (int ks = 0; ks < 8; ++ks) av = MFMA32(cf[ks], *(const LAS bf16x8*)(wb + ((2 + dt) * 8 + ks) * 1024 + lane * 16), av);
#pragma unroll
        for (int s = 0; s < 2; ++s) { uint4 o; o.x = cvtpk(av[8 * s + 0], av[8 * s + 1]); o.y = cvtpk(av[8 * s + 2], av[8 * s + 3]); o.z = cvtpk(av[8 * s + 4], av[8 * s + 5]); o.w = cvtpk(av[8 * s + 6], av[8 * s + 7]);
            vd[(s * 2 + dt) * 64] = o; }
    }
}
DI uint4 pack8l(const f32x16& a, int g, float sc, const LAS float* G) {
    const f32x4_t g0 = *(const LAS f32x4_t*)(G + 16 * g), g1 = *(const LAS f32x4_t*)(G + 16 * g + 8);
    uint4 o; o.x = cvtpk(a[8 * g + 0] * sc * g0[0], a[8 * g + 1] * sc * g0[1]); o.y = cvtpk(a[8 * g + 2] * sc * g0[2], a[8 * g + 3] * sc * g0[3]);
    o.z = cvtpk(a[8 * g + 4] * sc * g1[0], a[8 * g + 5] * sc * g1[1]); o.w = cvtpk(a[8 * g + 6] * sc * g1[2], a[8 * g + 7] * sc * g1[3]); return o;
}
DI void kv_head_l(const Ptrs& p, const LAS unsigned char* wb, const bf16x8 (&cf)[8], const f32x16& kpe, float sspe, const LAS float* G, int bh, int tile, int c, int lane) {
    f32x16 acc[2];
#pragma unroll
    for (int nt = 0; nt < 2; ++nt) {
#pragma unroll
        for (int i = 0; i < 16; ++i) acc[nt][i] = 0.f;
#pragma unroll
        for (int ks = 0; ks < 8; ++ks) acc[nt] = MFMA32(*(const LAS bf16x8*)(wb + (nt * 8 + ks) * 1024 + lane * 16), cf[ks], acc[nt]);
    }
    float sk = sspe;
#pragma unroll
    for (int nt = 0; nt < 2; ++nt)
#pragma unroll
        for (int i = 0; i < 16; ++i) sk += acc[nt][i] * acc[nt][i];
    sk += __shfl_xor(sk, 32);
    const float rk = rsqrt_fast(sk * (1.f / 96.f) + EPS);
    uint4* kd = (uint4*)(p.ws + WS_KIMG) + (size_t)(bh * 64 + tile) * 6 * 2 * 64 + c * 64 + lane;
#pragma unroll
    for (int nt = 0; nt < 2; ++nt)
#pragma unroll
        for (int g = 0; g < 2; ++g) kd[(2 * nt + g) * 128] = pack8l(acc[nt], g, rk, G + 32 * nt);
#pragma unroll
    for (int g = 0; g < 2; ++g) kd[(4 + g) * 128] = pack8l(kpe, g, rk, G + 64);
    uint4* vd = (uint4*)(p.ws + WS_VIMG) + (size_t)(bh * 64 + tile) * 8 * 64 + c * 4 * 64 + lane;
#pragma unroll
    for (int dt = 0; dt < 2; ++dt) {
        f32x16 av;
#pragma unroll
        for (int i = 0; i < 16; ++i) av[i] = 0.f;
#pragma unroll
        for (int ks = 0; ks < 8; ++ks) av = MFMA32(cf[ks], *(const LAS bf16x8*)(wb + ((2 + dt) * 8 + ks) * 1024 + lane * 16), av);
#pragma unroll
        for (int s = 0; s < 2; ++s) { uint4 o; o.x = cvtpk(av[8 * s + 0], av[8 * s + 1]); o.y = cvtpk(av[8 * s + 2], av[8 * s + 3]); o.z = cvtpk(av[8 * s + 4], av[8 * s + 5]); o.w = cvtpk(av[8 * s + 6], av[8 * s + 7]);
            vd[(s * 2 + dt) * 64] = o; }
    }
}
template <bool DO_QKV, bool DO_GMLP>
DI void wg_item(LAS unsigned char* lds, const Ptrs& p, int tg, int hp, int wid, int lane) {
    const int r = lane & 31, h = lane >> 5;
    const unsigned lds0 = (unsigned)(uintptr_t)lds, ldsA = lds0, ldsB = lds0 + 65536;
    const LAS unsigned char* bufA = lds; const LAS unsigned char* bufB = lds + 65536;
    const unsigned char* WqF = p.ws + WS_WUQT; const unsigned char* WkvF = p.ws + WS_WUKVT; const unsigned char* WsF = p.ws + WS_WSB;
    const int hA = 2 * hp, tb = tg * 8 + wid, t = tb * 32 + r, b = t >> 12, s0 = (tb * 32) & 4095, qblk = s0 >> 5, tile = s0 >> 6, c = (s0 >> 5) & 1;
    if constexpr (DO_QKV) {
    const bf16_t* CQ = (const bf16_t*)(p.ws + WS_CQ);
    bf16x8 cf[16];
#pragma unroll
    for (int ks = 0; ks < 16; ++ks) cf[ks] = *(const bf16x8*)(CQ + (((size_t)(tb * 32 + 2 * ks + h) * 32 + r) << 3));
    float cs[8], sn[8];
    { const float* ct = (const float*)(p.ws + WS_COS) + t * 16; const float* st = (const float*)(p.ws + WS_SIN) + t * 16;
#pragma unroll
      for (int i = 0; i < 8; ++i) { cs[i] = ct[crow(i, h)]; sn[i] = st[crow(i, h)]; } }
    dma_copy<6>(WqF + (size_t)hA * 49152, ldsA, wid, lane);
    dma_copy<6>(WqF + (size_t)(hA + 1) * 49152, ldsB, wid, lane);
    float ss = 0.f;
#pragma unroll
    for (int ks = 0; ks < 16; ++ks) ss += frag_ssq(cf[ks]);
    ss += __shfl_xor(ss, 32);
    const float rq = rsqrt_fast(ss * (1.f / 256.f) + EPS);
    P2_BAR_V(6);
    q_head(p, bufA, cf, rq, cs, sn, b * 8 + hA, qblk, lane);
    P2_BAR_V(0);
    dma_copy<8>(WkvF + (size_t)hA * 32768, ldsA, wid, lane);
    q_head(p, bufB, cf, rq, cs, sn, b * 8 + hA + 1, qblk, lane);
    const bf16_t* CKV = (const bf16_t*)(p.ws + WS_CKV);
    bf16x8 kf[8]; float ssk = 0.f;
#pragma unroll
    for (int ks = 0; ks < 8; ++ks) { kf[ks] = *(const bf16x8*)(CKV + (((size_t)(tb * 20 + 2 * ks + h) * 32 + r) << 3)); ssk += frag_ssq(kf[ks]); }
    ssk += __shfl_xor(ssk, 32);
    const float rkv = rsqrt_fast(ssk * (1.f / 128.f) + EPS);
#pragma unroll
    for (int ks = 0; ks < 8; ++ks) kf[ks] = frag_scale(kf[ks], rkv);
    f32x16 kpe; float sspe = 0.f;
    {
        float kr[16];
#pragma unroll
        for (int g = 0; g < 4; ++g) { const uint2 w = *(const uint2*)(CKV + (((size_t)(tb * 20 + 16 + g) * 32 + r) << 3) + 4 * h);
            kr[4 * g + 0] = lo16(w.x); kr[4 * g + 1] = hi16(w.x); kr[4 * g + 2] = lo16(w.y); kr[4 * g + 3] = hi16(w.y); }
#pragma unroll
        for (int i = 0; i < 8; ++i) { const float a = kr[i], bb = kr[i + 8];
            kpe[i] = a * cs[i] - bb * sn[i]; kpe[i + 8] = bb * cs[i] + a * sn[i]; sspe += kpe[i] * kpe[i] + kpe[i + 8] * kpe[i + 8]; }
    }
    float gk[3][16];
#pragma unroll
    for (int nt = 0; nt < 3; ++nt)
#pragma unroll
        for (int i = 0; i < 16; ++i) gk[nt][i] = p.g_kh[32 * nt + crow(i, h)] * p.g_qh[32 * nt + crow(i, h)];
    P2_BAR_V(0);
    if constexpr (DO_GMLP) dma_copy<8>(WsF + (size_t)hA * 32768, ldsB, wid, lane);
    kv_head(p, bufA, kf, kpe, sspe, gk, b * 8 + hA, tile, c, lane);
    kv_head(p, bufA + 32768, kf, kpe, sspe, gk, b * 8 + hA + 1, tile, c, lane);
    P2_BAR_V(0);
    } else { if constexpr (DO_GMLP) dma_copy<8>(WsF + (size_t)hA * 32768, ldsB, wid, lane); }
    if constexpr (DO_GMLP) {
    const bf16_t* Z = (const bf16_t*)(p.ws + WS_Z);
    const int pair = wid >> 1, cl = pair >> 1, hl = pair & 1, hd = hA + hl, tc0 = (2 * tg + cl) * 128;
    const int rw = lane >> 3, c8 = lane & 7;
    typedef unsigned u32x4g __attribute__((ext_vector_type(4)));
    {
        const int j0 = 64 * (wid & 1);
        u32x4g vraw[8];
#pragma unroll
        for (int i = 0; i < 8; ++i) vraw[i] = *(const u32x4g*)(Z + (size_t)(tc0 + j0 + 8 * i + rw) * 2048 + 1024 + hd * 64 + 8 * c8);
        f2_t gg[4];
#pragma unroll
        for (int e = 0; e < 4; ++e) { gg[e].x = p.g_vg[hd * 64 + 8 * c8 + 2 * e]; gg[e].y = p.g_vg[hd * 64 + 8 * c8 + 2 * e + 1]; }
        LAS unsigned char* img = lds + pair * 16384 + (c8 >> 2) * 8192 + (c8 & 3) * 16;
#pragma unroll
        for (int i = 0; i < 8; ++i) { const u32x4g u = vraw[i];
            const f2_t g0 = gelu2(bf2x(u.x)), g1 = gelu2(bf2x(u.y)), g2 = gelu2(bf2x(u.z)), g3 = gelu2(bf2x(u.w));
            const f2_t s2 = __builtin_elementwise_fma(g3, g3, __builtin_elementwise_fma(g2, g2, __builtin_elementwise_fma(g1, g1, g0 * g0)));
            float sg = s2.x + s2.y;
            sg += __shfl_xor(sg, 1); sg += __shfl_xor(sg, 2); sg += __shfl_xor(sg, 4);
            const float rv = rsqrt_fast(sg * (1.f / 64.f) + EPS);
            const f2_t o0 = g0 * (gg[0] * rv), o1 = g1 * (gg[1] * rv), o2 = g2 * (gg[2] * rv), o3 = g3 * (gg[3] * rv);
            u32x4v o; o.x = cvtpk(o0.x, o0.y); o.y = cvtpk(o1.x, o1.y); o.z = cvtpk(o2.x, o2.y); o.w = cvtpk(o3.x, o3.y);
            *(LAS u32x4v*)(img + (j0 + 8 * i + rw) * 64) = o; }
    }
    u32x4g uld[2][4], zld[2][4];
#pragma unroll
    for (int ii = 0; ii < 2; ++ii)
#pragma unroll
        for (int q = 0; q < 4; ++q) { const bf16_t* zr = Z + (size_t)(tc0 + 32 * (2 * (wid & 1) + ii) + 8 * q + rw) * 2048 + hd * 64 + 8 * c8;
            uld[ii][q] = *(const u32x4g*)(zr + 512); zld[ii][q] = *(const u32x4g*)(zr + 1536); }
    P2_BAR_V(0);
    {
        bf16x8 vf[8][2];
        { const int q = (lane & 15) >> 2, pp = lane & 3, blk = (lane >> 4) & 1;
          const LAS unsigned char* base = bufA + pair * 16384 + (8 * h + q) * 64 + (16 * blk + 4 * pp) * 2;
#pragma unroll
          for (int ks = 0; ks < 8; ++ks)
#pragma unroll
              for (int nt = 0; nt < 2; ++nt) { const s16x4 lo = vtr(base + nt * 8192 + ks * 1024), hi = vtr(base + nt * 8192 + ks * 1024 + 256);
                  vf[ks][nt] = __builtin_shufflevector(lo, hi, 0, 1, 2, 3, 4, 5, 6, 7); } }
        asm volatile("s_waitcnt lgkmcnt(0)\n\ts_barrier" ::: "memory");
        LAS unsigned char* stg = lds + wid * 8192;
#pragma unroll
        for (int ii = 0; ii < 2; ++ii) { const int it = 2 * (wid & 1) + ii;
            f32x16 acc[2];
#pragma unroll
            for (int i = 0; i < 16; ++i) { acc[0][i] = 0.f; acc[1][i] = 0.f; }
            const LAS unsigned char* wsb = bufB + hl * 32768 + it * 8192 + lane * 16;
#pragma unroll
            for (int ks = 0; ks < 8; ++ks) { const bf16x8 wf = *(const LAS bf16x8*)(wsb + ks * 1024); acc[0] = MFMA32(vf[ks][0], wf, acc[0]); acc[1] = MFMA32(vf[ks][1], wf, acc[1]); }
#pragma unroll
            for (int nt = 0; nt < 2; ++nt)
#pragma unroll
                for (int g = 0; g < 4; ++g) { const f32x4_t v4 = {acc[nt][4 * g + 0], acc[nt][4 * g + 1], acc[nt][4 * g + 2], acc[nt][4 * g + 3]};
                    *(LAS f32x4_t*)(stg + r * 256 + (((8 * nt + 2 * g + h) ^ (r & 15)) << 4)) = v4; }
            asm volatile("s_waitcnt lgkmcnt(0)" ::: "memory");
#pragma unroll
            for (int q = 0; q < 4; ++q) { const int tl = 8 * q + rw, tt = tc0 + 32 * it + tl; const float bs = p.b_s[hd * 128 + 32 * it + tl];
                const f32x4_t m0 = *(const LAS f32x4_t*)(stg + tl * 256 + (((2 * c8) ^ (tl & 15)) << 4)), m1 = *(const LAS f32x4_t*)(stg + tl * 256 + (((2 * c8 + 1) ^ (tl & 15)) << 4));
                const u32x4g uu = uld[ii][q], zz = zld[ii][q];
                const f2_t mm[4] = {{m0[0], m0[1]}, {m0[2], m0[3]}, {m1[0], m1[1]}, {m1[2], m1[3]}};
                const unsigned uw[4] = {uu.x, uu.y, uu.z, uu.w}, zw[4] = {zz.x, zz.y, zz.z, zz.w};
                f2_t a[4], sq2 = {0.f, 0.f};
#pragma unroll
                for (int e = 0; e < 4; ++e) { const f2_t o = gelu2(bf2x(uw[e])) * (mm[e] + bs); sq2 = __builtin_elementwise_fma(o, o, sq2); a[e] = o * silu2(bf2x(zw[e])); }
                float sq = sq2.x + sq2.y;
                sq += __shfl_xor(sq, 1); sq += __shfl_xor(sq, 2); sq += __shfl_xor(sq, 4);
                u32x4g w; w.x = cvtpk(a[0].x, a[0].y); w.y = cvtpk(a[1].x, a[1].y); w.z = cvtpk(a[2].x, a[2].y); w.w = cvtpk(a[3].x, a[3].y);
                *(u32x4g*)((bf16_t*)(p.ws + WS_AMIX) + (size_t)tt * 1024 + 512 + hd * 64 + 8 * c8) = w;
                if (c8 == 0) ((float*)(p.ws + WS_SSQB))[(size_t)hd * T + tt] = sq; }
        }
    }
    P2_BAR_V(0);
    }
}
#undef P2_BAR_V
}


typedef unsigned f_u32x2 __attribute__((ext_vector_type(2)));
#define F_BAR_V(N) asm volatile("s_waitcnt vmcnt(" #N ") lgkmcnt(0)\n\ts_barrier" ::: "memory")
#define F_BAR_L() asm volatile("s_waitcnt lgkmcnt(0)\n\ts_barrier" ::: "memory")
DI void p1_fused_q_a(const f32x4_t (&acc)[2][2][4][2], int pm, int wr, int wc, int fr, int fq, LAS unsigned char* lds, const Ptrs* pp) {
    using namespace p2;
    const Ptrs& p = *pp;
    const LAS float* rsx = (const LAS float*)(lds + 131072 + 4096 + 2048);
    LAS float* tab = (LAS float*)(lds + 131072);
#pragma unroll
    for (int ai = 0; ai < 2; ++ai)
#pragma unroll
        for (int m = 0; m < 4; ++m) {
            const int row = ai * 128 + wr * 64 + m * 16 + fr; const float rs = rsx[row]; float part = 0.f;
#pragma unroll
            for (int bj = 0; bj < 2; ++bj) { const f32x4_t v0 = acc[ai][bj][m][0] * rs, v1 = acc[ai][bj][m][1] * rs;
                part += (v0[0] * v0[0] + v0[1] * v0[1]) + (v0[2] * v0[2] + v0[3] * v0[3]) + (v1[0] * v1[0] + v1[1] * v1[1]) + (v1[2] * v1[2] + v1[3] * v1[3]);
                u32x4v w; w.x = cvtpk(v0[0], v0[1]); w.y = cvtpk(v0[2], v0[3]); w.z = cvtpk(v1[0], v1[1]); w.w = cvtpk(v1[2], v1[3]);
                const int chunk = 16 * bj + 4 * wc + fq;
                *(LAS u32x4v*)(lds + ((((row >> 5) * 16 + (chunk >> 1)) * 64 + (chunk & 1) * 32 + (row & 31)) << 4)) = w; }
            part += __shfl_xor(part, 16); part += __shfl_xor(part, 32);
            if (fq == 0) tab[row * 4 + wc] = part;
        }
}
DI void p1_fused_q_b(int pm, LAS unsigned char* lds, const Ptrs* pp, int wid, int lane) {
    using namespace p2;
    const Ptrs& p = *pp;
    const int r = lane & 31, h = lane >> 5;
    const LAS float* tab = (const LAS float*)(lds + 131072);
    bf16x8 cf[16];
#pragma unroll
    for (int ks = 0; ks < 16; ++ks) cf[ks] = *(const LAS bf16x8*)(lds + (((wid * 16 + ks) * 64 + lane) << 4));
    const int row = 32 * wid + r, t = pm * 256 + row, b = t >> 12, s0 = (pm * 256 + 32 * wid) & 4095, qblk = s0 >> 5;
    const float rq = rsqrt_fast((tab[row * 4] + tab[row * 4 + 1] + tab[row * 4 + 2] + tab[row * 4 + 3]) * (1.f / 256.f) + EPS);
    float cs[8], sn[8];
    { const float* ct = (const float*)(p.ws + WS_COS) + t * 16; const float* st = (const float*)(p.ws + WS_SIN) + t * 16;
#pragma unroll
      for (int i = 0; i < 8; ++i) { cs[i] = ct[crow(i, h)]; sn[i] = st[crow(i, h)]; } }
    F_BAR_L();
    const unsigned lds0 = (unsigned)(uintptr_t)lds, ldsA = lds0, ldsB = lds0 + 65536;
    const LAS unsigned char* bufA = lds; const LAS unsigned char* bufB = lds + 65536;
    const unsigned char* WqF = p.ws + WS_WUQT;
    dma_copy<6>(WqF, ldsA, wid, lane);
    dma_copy<6>(WqF + 49152, ldsB, wid, lane);
#pragma nounroll
    for (int hp = 0; hp < 4; ++hp) {
        F_BAR_V(6);
        q_head(p, bufA, cf, rq, cs, sn, b * 8 + 2 * hp, qblk, lane);
        F_BAR_V(0);
        if (hp < 3) dma_copy<6>(WqF + (size_t)(2 * hp + 2) * 49152, ldsA, wid, lane);
        q_head(p, bufB, cf, rq, cs, sn, b * 8 + 2 * hp + 1, qblk, lane);
        F_BAR_L();
        if (hp < 3) dma_copy<6>(WqF + (size_t)(2 * hp + 3) * 49152, ldsB, wid, lane);
    }
    F_BAR_V(0);
}
DI void p1_fused_kv_a(const f32x4_t (&acc)[2][2][4][2], int pm, int wr, int wc, int fr, int fq, LAS unsigned char* lds, const Ptrs* pp) {
    using namespace p2;
    const Ptrs& p = *pp;
    const LAS float* rsx = (const LAS float*)(lds + 131072 + 4096 + 2048);
    LAS float* tab = (LAS float*)(lds + 131072);
#pragma unroll
    for (int ai = 0; ai < 2; ++ai)
#pragma unroll
        for (int m = 0; m < 4; ++m) {
            const int row = ai * 128 + wr * 64 + m * 16 + fr; const float rs = rsx[row];
            { const f32x4_t v0 = acc[ai][0][m][0] * rs, v1 = acc[ai][0][m][1] * rs;
              float part = (v0[0] * v0[0] + v0[1] * v0[1]) + (v0[2] * v0[2] + v0[3] * v0[3]) + (v1[0] * v1[0] + v1[1] * v1[1]) + (v1[2] * v1[2] + v1[3] * v1[3]);
              u32x4v w; w.x = cvtpk(v0[0], v0[1]); w.y = cvtpk(v0[2], v0[3]); w.z = cvtpk(v1[0], v1[1]); w.w = cvtpk(v1[2], v1[3]);
              const int chunk = 4 * wc + fq;
              *(LAS u32x4v*)(lds + ((((row >> 5) * 8 + (chunk >> 1)) * 64 + (chunk & 1) * 32 + (row & 31)) << 4)) = w;
              part += __shfl_xor(part, 16); part += __shfl_xor(part, 32);
              if (fq == 0) tab[row * 4 + wc] = part; }
            if (wc == 0) { const f32x4_t v0 = acc[ai][1][m][0] * rs, v1 = acc[ai][1][m][1] * rs;
              u32x4v w; w.x = cvtpk(v0[0], v0[1]); w.y = cvtpk(v0[2], v0[3]); w.z = cvtpk(v1[0], v1[1]); w.w = cvtpk(v1[2], v1[3]);
              *(LAS u32x4v*)(lds + 65536 + ((((row >> 5) * 4 + fq) * 32 + (row & 31)) << 4)) = w; }
        }
}
DI void p1_fused_kv_b(int pm, LAS unsigned char* lds, const Ptrs* pp, int wid, int lane) {
    using namespace p2;
    const Ptrs& p = *pp;
    const int r = lane & 31, h = lane >> 5;
    LAS float* tab = (LAS float*)(lds + 131072);
    bf16x8 kf[8];
#pragma unroll
    for (int ks = 0; ks < 8; ++ks) kf[ks] = *(const LAS bf16x8*)(lds + (((wid * 8 + ks) * 64 + lane) << 4));
    const int row = 32 * wid + r, t = pm * 256 + row, b = t >> 12, s0 = (pm * 256 + 32 * wid) & 4095, tile = s0 >> 6, c = (s0 >> 5) & 1;
    const float rkv = rsqrt_fast((tab[row * 4] + tab[row * 4 + 1] + tab[row * 4 + 2] + tab[row * 4 + 3]) * (1.f / 128.f) + EPS);
#pragma unroll
    for (int ks = 0; ks < 8; ++ks) kf[ks] = frag_scale(kf[ks], rkv);
    f32x16 kpe; float sspe = 0.f;
    {
        float kr[16];
#pragma unroll
        for (int g = 0; g < 4; ++g) { const f_u32x2 w = *(const LAS f_u32x2*)(lds + 65536 + (((wid * 4 + g) * 32 + r) << 4) + 8 * h);
            kr[4 * g + 0] = lo16(w.x); kr[4 * g + 1] = hi16(w.x); kr[4 * g + 2] = lo16(w.y); kr[4 * g + 3] = hi16(w.y); }
        const float* ct = (const float*)(p.ws + WS_COS) + t * 16; const float* st = (const float*)(p.ws + WS_SIN) + t * 16;
#pragma unroll
        for (int i = 0; i < 8; ++i) { const float a = kr[i], bb = kr[i + 8], cc = ct[crow(i, h)], sv = st[crow(i, h)];
            kpe[i] = a * cc - bb * sv; kpe[i + 8] = bb * cc + a * sv; sspe += kpe[i] * kpe[i] + kpe[i + 8] * kpe[i + 8]; }
    }
    const float gprod = (wid == 0 && lane < 48) ? p.g_kh[lane] * p.g_qh[lane] : 0.f, gprod2 = (wid == 0 && lane < 48) ? p.g_kh[lane + 48] * p.g_qh[lane + 48] : 0.f;
    F_BAR_L();
    if (wid == 0 && lane < 48) { tab[lane] = gprod; tab[lane + 48] = gprod2; }
    const LAS float* G = tab + 4 * h;
    const unsigned lds0 = (unsigned)(uintptr_t)lds, ldsA = lds0, ldsB = lds0 + 65536;
    const LAS unsigned char* bufA = lds; const LAS unsigned char* bufB = lds + 65536;
    const unsigned char* WkvF = p.ws + WS_WUKVT;
    dma_copy<8>(WkvF, ldsA, wid, lane);
    dma_copy<8>(WkvF + 65536, ldsB, wid, lane);
#pragma nounroll
    for (int hq = 0; hq < 2; ++hq) {
        F_BAR_V(8);
        kv_head_l(p, bufA, kf, kpe, sspe, G, b * 8 + 4 * hq, tile, c, lane);
        kv_head_l(p, bufA + 32768, kf, kpe, sspe, G, b * 8 + 4 * hq + 1, tile, c, lane);
        F_BAR_V(0);
        if (hq == 0) dma_copy<8>(WkvF + 2 * 65536, ldsA, wid, lane);
        kv_head_l(p, bufB, kf, kpe, sspe, G, b * 8 + 4 * hq + 2, tile, c, lane);
        kv_head_l(p, bufB + 32768, kf, kpe, sspe, G, b * 8 + 4 * hq + 3, tile, c, lane);
        F_BAR_L();
        if (hq == 0) dma_copy<8>(WkvF + 3 * 65536, ldsB, wid, lane);
    }
    F_BAR_V(0);
}
#undef F_BAR_V
#undef F_BAR_L

#define FB_V(k)      (0x5EED0000u + (unsigned)(k))
#define FB_OK(f, k)  ((((f) & 0xFFFFF0FFu) - FB_V(k)) <= 1u)
#define FB_SPIN_CAP  (1u << 22)
__device__ __forceinline__ unsigned xb_ld(unsigned* p)              { return __hip_atomic_load(p, __ATOMIC_RELAXED, __HIP_MEMORY_SCOPE_AGENT); }
__device__ __forceinline__ void xb_st(unsigned* p, unsigned v)      { __hip_atomic_store(p, v, __ATOMIC_RELAXED, __HIP_MEMORY_SCOPE_AGENT); }
__device__ __forceinline__ unsigned xb_xcc_id() { return (unsigned)__builtin_amdgcn_s_getreg((3 << 11) | 20) & 0xFu; }
__device__ __forceinline__ void flag_barrier(unsigned* bar, volatile LAS unsigned* st, int k) {
    asm volatile("s_waitcnt vmcnt(0)" ::: "memory");
    __syncthreads();
    if (threadIdx.x < 64) {
        const unsigned lane = threadIdx.x, bx = blockIdx.x, x = xb_xcc_id();
        __builtin_amdgcn_s_waitcnt(0);
        if (lane == 0) xb_st(&bar[bx], FB_V(k) | (x << 8));
        unsigned f0, f1, f2, f3, sp = 0u, m; bool leader;
        if (k == 0) {
            for (;;) {
                f0 = xb_ld(&bar[lane]); f1 = xb_ld(&bar[64 + lane]); f2 = xb_ld(&bar[128 + lane]); f3 = xb_ld(&bar[192 + lane]);
                if (__all(FB_OK(f0, k) && FB_OK(f1, k) && FB_OK(f2, k) && FB_OK(f3, k))) break;
                __builtin_amdgcn_s_sleep(2);
                if (++sp > FB_SPIN_CAP) break;
            }
            const unsigned x0 = (f0 >> 8) & 15u, x1 = (f1 >> 8) & 15u, x2 = (f2 >> 8) & 15u, x3 = (f3 >> 8) & 15u;
            const bool lower = (x0 == x && lane < bx) || (x1 == x && 64u + lane < bx) || (x2 == x && 128u + lane < bx) || (x3 == x && 192u + lane < bx);
            leader = !__any(lower);
            m = (1u << x0) | (1u << x1) | (1u << x2) | (1u << x3);
#pragma unroll
            for (int o = 1; o < 64; o <<= 1) m |= __shfl_xor(m, o);
            st[16 + lane] = (x0 == x ? 1u : 0u) | (x1 == x ? 2u : 0u) | (x2 == x ? 4u : 0u) | (x3 == x ? 8u : 0u);
            if (lane == 0) { st[0] = leader ? 1u : 0u; st[1] = m; }
        } else {
            leader = st[0] != 0u; m = st[1];
            if (leader) {
                const unsigned loc = st[16 + lane];
                for (;;) {
                    f0 = (loc & 1u) ? xb_ld(&bar[lane]) : FB_V(k); f1 = (loc & 2u) ? xb_ld(&bar[64 + lane]) : FB_V(k); f2 = (loc & 4u) ? xb_ld(&bar[128 + lane]) : FB_V(k); f3 = (loc & 8u) ? xb_ld(&bar[192 + lane]) : FB_V(k);
                    if (__all(FB_OK(f0, k) && FB_OK(f1, k) && FB_OK(f2, k) && FB_OK(f3, k))) break;
                    __builtin_amdgcn_s_sleep(1);
                    if (++sp > FB_SPIN_CAP) break;
                }
            }
        }
        if (leader) {
            __builtin_amdgcn_fence(__ATOMIC_RELEASE, "agent");
            asm volatile("s_waitcnt vmcnt(0)" ::: "memory");
            if (lane == 0) xb_st(&bar[256 + x], FB_V(k));
        }
        for (sp = 0u;;) {
            const unsigned t = lane < 16u ? xb_ld(&bar[256 + lane]) : 0u;
            const bool need = lane < 16u && ((m >> lane) & 1u);
            if (__all(!need || FB_OK(t, k))) break;
            __builtin_amdgcn_s_sleep(2);
            if (++sp > FB_SPIN_CAP) break;
        }
        __builtin_amdgcn_fence(__ATOMIC_ACQUIRE, "agent");
        asm volatile("s_waitcnt vmcnt(0)" ::: "memory");
    }
    __syncthreads();
}

constexpr int LDS_BYTES = 147456;
constexpr int NPHASE = 5;
constexpr int MISC_OFF = 131072 + 4096;
struct Args { Ptrs p; int ph_lo, ph_hi; };

DI size_t frag_off(int n, int k, int K) { return ((((size_t)(n >> 5) * (K >> 4) + (k >> 4)) * 64 + ((k >> 3) & 1) * 32 + (n & 31)) << 3) + (k & 7); }
template <bool FRAG>
DI void p0_transpose_item(const float* W, int K, int Nsrc, const float* gain, bf16_t* WT, int dst_row0, LAS float* scr, int k0, int n0, int lane) {
#pragma unroll 8
    for (int i = 0; i < 32; ++i) { const int kk = 2 * i + (lane >> 5); scr[kk * 33 + (lane & 31)] = W[(size_t)(k0 + kk) * Nsrc + n0 + (lane & 31)] * gain[k0 + kk]; }
    asm volatile("s_waitcnt lgkmcnt(0)" ::: "memory");
#pragma unroll
    for (int j = 0; j < 4; ++j) {
        const int c = FRAG ? (lane >> 5) + 2 * j : (lane & 7), n = FRAG ? (lane & 31) : (lane >> 3) + 8 * j; const LAS float* s = scr + (8 * c) * 33 + n;
        uint4 o; o.x = f2bf(s[0 * 33]) | ((unsigned)f2bf(s[1 * 33]) << 16); o.y = f2bf(s[2 * 33]) | ((unsigned)f2bf(s[3 * 33]) << 16);
        o.z = f2bf(s[4 * 33]) | ((unsigned)f2bf(s[5 * 33]) << 16); o.w = f2bf(s[6 * 33]) | ((unsigned)f2bf(s[7 * 33]) << 16);
        if (FRAG) *(uint4*)(WT + frag_off(dst_row0 + n, k0 + 8 * c, K)) = o; else *(uint4*)(WT + (size_t)(dst_row0 + n) * K + k0 + 8 * c) = o; }
    asm volatile("s_waitcnt lgkmcnt(0)" ::: "memory");
}
DI void p0_prologue(const Ptrs& p, LAS unsigned char* lds, int vcu, int G) {
    const int tid = threadIdx.x, lane = tid & 63, wave = __builtin_amdgcn_readfirstlane(tid >> 6);
    const int gw = vcu * 8 + wave, NGW = G * 8;
    LAS float* scr = (LAS float*)(lds + wave * 16384);
    bf16_t* WinT = (bf16_t*)(p.ws + WS_WINT); bf16_t* WuqT = (bf16_t*)(p.ws + WS_WUQT); bf16_t* WukvT = (bf16_t*)(p.ws + WS_WUKVT);
    bf16_t* WoutT = (bf16_t*)(p.ws + WS_WOUTT); bf16_t* Wsb = (bf16_t*)(p.ws + WS_WSB);
    {
    bf16_t* xb = (bf16_t*)(p.ws + WS_XB); float* rs = (float*)(p.ws + WS_RSTDX);
    for (int row = gw; row < T; row += NGW) {
        typedef float f32x4v __attribute__((ext_vector_type(4)));
        const f32x4v* xr = (const f32x4v*)(p.x + (size_t)row * DM) + lane;
        float s = 0.f; f32x4v v[4];
#pragma unroll
        for (int j = 0; j < 4; ++j) { v[j] = __builtin_nontemporal_load(xr + 64 * j); s += v[j].x * v[j].x + v[j].y * v[j].y + v[j].z * v[j].z + v[j].w * v[j].w; }
#pragma unroll
        for (int o = 1; o < 64; o <<= 1) s += __shfl_xor(s, o);
        if (lane == 0) rs[row] = rsqrt_fast(s * (1.f / DM) + EPS);
        uint2* o8 = (uint2*)(xb + (size_t)row * DM) + lane;
#pragma unroll
        for (int j = 0; j < 4; ++j) { uint2 w; w.x = f2bf(v[j].x) | ((unsigned)f2bf(v[j].y) << 16); w.y = f2bf(v[j].z) | ((unsigned)f2bf(v[j].w) << 16); o8[64 * j] = w; }
    }
    }
    constexpr int I_IN = 16 * 77, I_UQ = 4 * 24, I_UKV = 2 * 32, I_OUT = 16 * 32, NITEMS = I_IN + I_UQ + I_UKV + I_OUT;
    for (int it = gw; it < NITEMS; it += NGW) {
        int r = it;
        if (r < I_IN) { const int kb = r / 77, nb = r % 77; p0_transpose_item<false>(p.w_in, 1024, 2464, p.g_in, WinT, nb < 8 ? 1024 + 32 * nb : nb < 13 ? 1280 + 32 * (nb - 8) : nb < 29 ? 2048 + 32 * (nb - 13) : nb < 61 ? 32 * (nb - 29) : 1536 + 32 * (nb - 61), scr, 64 * kb, 32 * nb, lane);   continue; } r -= I_IN;
        if (r < I_UQ) { const int kb = r / 24, nb = r % 24; p0_transpose_item<true>(p.w_uq, 256, 768, p.g_ql, WuqT, 32 * nb, scr, 64 * kb, 32 * nb, lane); continue; } r -= I_UQ;
        if (r < I_UKV) { const int kb = r / 32, nb = r % 32; p0_transpose_item<true>(p.w_ukv, 128, 1024, p.g_kvl, WukvT, 32 * nb, scr, 64 * kb, 32 * nb, lane); continue; } r -= I_UKV;
        { const int kb = r / 32, nb = r % 32; p0_transpose_item<false>(p.w_out, 1024, 1024, kb < 8 ? p.g_oa : p.g_ob - 512, WoutT, 32 * nb, scr, 64 * kb, 32 * nb, lane); }
    }
    const size_t gid = (size_t)vcu * 512 + tid, gsz = (size_t)G * 512;
    for (size_t i = gid; i < (size_t)96 * 1024 / 8; i += gsz) ((uint4*)(WinT + (size_t)1440 * 1024))[i] = make_uint4(0u, 0u, 0u, 0u);
    for (size_t i = gid; i < (size_t)8 * 128 * 16; i += gsz) { const int n = (int)(i >> 4), kc = (int)(i & 15); const float4 a = *(const float4*)(p.w_s + (size_t)n * 128 + 8 * kc), bq = *(const float4*)(p.w_s + (size_t)n * 128 + 8 * kc + 4);
        uint4 o; o.x = f2bf(a.x) | ((unsigned)f2bf(a.y) << 16); o.y = f2bf(a.z) | ((unsigned)f2bf(a.w) << 16); o.z = f2bf(bq.x) | ((unsigned)f2bf(bq.y) << 16); o.w = f2bf(bq.z) | ((unsigned)f2bf(bq.w) << 16);
        *(uint4*)(Wsb + frag_off(n, 8 * kc, 128)) = o; }
    float* ct = (float*)(p.ws + WS_COS); float* st = (float*)(p.ws + WS_SIN);
    for (size_t i = gid; i < (size_t)T * 16; i += gsz) { const int t = (int)(i >> 4), f = (int)(i & 15);
        const float invf = 1.0f / powf(10000.0f, (float)(2 * f) / 32.0f);
        const float ang = (float)p.pos[t] * invf;
        const double rev = (double)ang * 0.15915494309189535; const float fr = (float)(rev - rint(rev));
        ct[i] = __builtin_amdgcn_cosf(fr); st[i] = __builtin_amdgcn_sinf(fr); }
}

__global__ void __launch_bounds__(512, 2) mega(Args a) {
    extern __shared__ __attribute__((aligned(16))) unsigned char lds_all[];
    LAS unsigned char* lds = (LAS unsigned char*)lds_all;
    cg::grid_group grid = cg::this_grid();
    const Ptrs& p = a.p;
#define GRID_BAR(k) flag_barrier((unsigned*)(p.ws + WS_CTL) + 1024, (volatile LAS unsigned*)(lds + MISC_OFF), (k))
    if (a.ph_lo > 1000) grid.sync();
    const int lo = a.ph_lo, hi = a.ph_hi, G = gridDim.x, bx = blockIdx.x;
    const int vcu = (G % 8 == 0) ? (bx % 8) * (G / 8) + bx / 8 : bx;
#define IN(k) (lo <= (k) && (k) < hi)
#define BOTH(k) (IN(k) && IN((k) + 1))
    if (IN(0)) { p0_prologue(p, lds, vcu, G); if (BOTH(0)) GRID_BAR(0); }
    if (IN(1)) {
        {
        __syncthreads();
        pg8::Gemm g{(const bf16_t*)(p.ws + WS_XB), (const bf16_t*)(p.ws + WS_WINT), T, NP + 512, DM}; pg8::P1Order S; S.init(T, NP, G, bx);
        { pg8::Unit u0; S.next(0, u0); if (threadIdx.x < 256) ((LAS float*)(lds + MISC_OFF + 2048))[threadIdx.x] = ((const float*)(p.ws + WS_RSTDX))[u0.pm * 256 + threadIdx.x];
          asm volatile("s_waitcnt vmcnt(0) lgkmcnt(0)" ::: "memory"); __syncthreads(); }
        pg8::EpiProj E{(bf16_t*)(p.ws + WS_Z), (const LAS float*)(lds + MISC_OFF + 2048), &p};
        pg8::gemm_phase<pg8::EpiProj, pg8::P1Order, true, true>(lds, g, S, E);
        }
        if (BOTH(1)) GRID_BAR(1);
    }
    if (IN(2)) {
        const int lane = threadIdx.x & 63, wid = __builtin_amdgcn_readfirstlane(threadIdx.x >> 6);
        __syncthreads();
        p2::wg_item<false, true>(lds, p, 8 * (bx & 7) + ((bx >> 3) & 7), bx >> 6, wid, lane);
        asm volatile("s_waitcnt vmcnt(0) lgkmcnt(0)" ::: "memory");
    }
    if (IN(3)) { __syncthreads(); att::attn_phase64(lds, p, vcu, G); if (BOTH(3)) GRID_BAR(2); }
    if (IN(4)) {
        {
        __syncthreads();
        pg8::StaticOrder S; S.init(T, DM, G, bx); pg8::Unit u0;
        if (S.next(0, u0) && threadIdx.x < 256) {
            const float* ssqa = (const float*)(p.ws + WS_SSQA); const float* ssqb = (const float*)(p.ws + WS_SSQB); const int t = u0.pm * 256 + threadIdx.x;
            float sa = 0.f, sb = 0.f;
#pragma unroll
            for (int h = 0; h < 8; ++h) { sa += ssqa[(size_t)h * T + t]; sb += ssqb[(size_t)h * T + t]; }
            const float ra = rsqrt_fast(sa * (1.f / 512.f) + EPS), rb = rsqrt_fast(sb * (1.f / 512.f) + EPS);
            ((LAS float*)(lds + pg8::STAGE_BYTES))[threadIdx.x] = ra / rb; ((LAS float*)(lds + pg8::STAGE_BYTES + 1024))[threadIdx.x] = rb;
        }
        asm volatile("s_waitcnt vmcnt(0) lgkmcnt(0)" ::: "memory"); __syncthreads();
        pg8::Gemm g{(const bf16_t*)(p.ws + WS_AMIX), (const bf16_t*)(p.ws + WS_WOUTT), T, DM, DM};
        pg8::EpiOut E{p.x, p.out, lds, (const bf16_t*)(p.ws + WS_XB)};
        pg8::gemm_phase<pg8::EpiOut, pg8::StaticOrder, false, true>(lds, g, S, E);
        }
    }
#undef IN
#undef BOTH
}

static int g_grid = 0;
static void launch_mega(const Ptrs& p, int lo, int hi, hipStream_t stream) {
    if (g_grid == 0) {
        int dev = 0, cus = 0, per_cu = 0;
        hipGetDevice(&dev); hipDeviceGetAttribute(&cus, hipDeviceAttributeMultiprocessorCount, dev);
        hipFuncSetAttribute((const void*)mega, hipFuncAttributeMaxDynamicSharedMemorySize, LDS_BYTES);
        hipOccupancyMaxActiveBlocksPerMultiprocessor(&per_cu, (const void*)mega, 512, LDS_BYTES);
        g_grid = cus;
        if (per_cu < 1 || cus != 256) { fprintf(stderr, "mega: built for 256 CUs x 1 resident workgroup; device has %d CUs, occupancy query says %d per CU; nothing launched\n", cus, per_cu); g_grid = -1; }
    }
    if (g_grid < 0) return;
    Args a{}; a.p = p; a.ph_lo = lo; a.ph_hi = hi;
    void* args[] = {&a};
    hipError_t e = hipLaunchCooperativeKernel((const void*)mega, dim3(g_grid), dim3(512), args, LDS_BYTES, stream);
    if (e != hipSuccess) fprintf(stderr, "cooperative launch failed: %s (grid %d)\n", hipGetErrorString(e), g_grid);
}
extern "C" void kernel_launch(void* const* d_in, const int* in_sizes, int n_in, void* d_out, int out_size, void* d_ws, size_t ws_size, hipStream_t stream) {
    if (n_in != 16 || out_size != T * DM || ws_size < WS_END) { fprintf(stderr, "kernel_launch: unexpected shapes n_in %d out %d ws %zu\n", n_in, out_size, ws_size); return; }
    Ptrs p{};
    p.x = (const float*)d_in[0]; p.pos = (const int*)d_in[1]; p.g_in = (const float*)d_in[2]; p.w_in = (const float*)d_in[3]; p.g_ql = (const float*)d_in[4]; p.w_uq = (const float*)d_in[5];
    p.g_kvl = (const float*)d_in[6]; p.w_ukv = (const float*)d_in[7]; p.g_qh = (const float*)d_in[8]; p.g_kh = (const float*)d_in[9]; p.g_vg = (const float*)d_in[10]; p.w_s = (const float*)d_in[11];
    p.b_s = (const float*)d_in[12]; p.g_oa = (const float*)d_in[13]; p.g_ob = (const float*)d_in[14]; p.w_out = (const float*)d_in[15];
    p.out = (float*)d_out; p.ws = (unsigned char*)d_ws;
    launch_mega(p, 0, 5, stream);
}
```

```cpp
#include <hip/hip_runtime.h>
#include <stdint.h>
#include <stdio.h>
#include <hip/hip_cooperative_groups.h>
namespace cg = cooperative_groups;

#define DI __device__ __forceinline__
#define LAS __attribute__((address_space(3)))
typedef unsigned short bf16_t;

constexpr int T = 16384, SEQ = 4096, NB = 4, DM = 1024, NH = 8, QK = 96, DV = 64;
constexpr int NP = 2048;
constexpr float EPS = 1e-6f;
constexpr float QSCALE = 0.10206207261596575f * 1.4426950408889634f;

constexpr size_t MiB = 1u << 20;
constexpr size_t WS_CTL = 0;
constexpr size_t WS_XB = 1 * MiB;
constexpr size_t WS_RSTDX = 33 * MiB;
constexpr size_t WS_COS = 34 * MiB;
constexpr size_t WS_SIN = 35 * MiB;
constexpr size_t WS_WINT = 36 * MiB;
constexpr size_t WS_WUQT = 41 * MiB;
constexpr size_t WS_WUKVT = 42 * MiB;
constexpr size_t WS_WOUTT = 43 * MiB;
constexpr size_t WS_WSB = 45 * MiB;
constexpr size_t WS_SSQA = 46 * MiB;
constexpr size_t WS_SSQB = 47 * MiB;
constexpr size_t WS_CQ = 48 * MiB;
constexpr size_t WS_CKV = 56 * MiB;
constexpr size_t WS_Z = 62 * MiB;
constexpr size_t WS_QIMG = 126 * MiB;
constexpr size_t WS_KIMG = 150 * MiB;
constexpr size_t WS_VIMG = 174 * MiB;
constexpr size_t WS_AMIX = 190 * MiB;
constexpr size_t WS_END = 222 * MiB;

DI float bf2f(bf16_t b) { return __uint_as_float(((unsigned)b) << 16); }
DI bf16_t f2bf(float f) { unsigned u = __float_as_uint(f); return (bf16_t)((u + 0x7fffu + ((u >> 16) & 1u)) >> 16); }
DI float gelu_tanh(float x) {
    const float y = x * (0.7978845608028654f + 0.035677408136300125f * x * x);
    return x * __builtin_amdgcn_rcpf(1.f + __builtin_amdgcn_exp2f(-2.885390081777927f * y));
}
DI float silu(float x) { return x * __builtin_amdgcn_rcpf(1.f + __builtin_amdgcn_exp2f(-1.4426950408889634f * x)); }
DI float rsqrt_fast(float x) { return __builtin_amdgcn_rsqf(x); }
typedef float f2_t __attribute__((ext_vector_type(2)));
DI f2_t gelu2(f2_t x) {
    const f2_t y = x * __builtin_elementwise_fma(x * x, (f2_t)(-2.885390081777927f * 0.035677408136300125f), (f2_t)(-2.885390081777927f * 0.7978845608028654f));
    f2_t e; e.x = __builtin_amdgcn_exp2f(y.x); e.y = __builtin_amdgcn_exp2f(y.y); e = e + 1.f;
    f2_t r; r.x = __builtin_amdgcn_rcpf(e.x); r.y = __builtin_amdgcn_rcpf(e.y); return x * r; }
DI f2_t silu2(f2_t x) {
    const f2_t y = x * -1.4426950408889634f;
    f2_t e; e.x = __builtin_amdgcn_exp2f(y.x); e.y = __builtin_amdgcn_exp2f(y.y); e = e + 1.f;
    f2_t r; r.x = __builtin_amdgcn_rcpf(e.x); r.y = __builtin_amdgcn_rcpf(e.y); return x * r; }
DI f2_t bf2x(unsigned w) { f2_t v; v.x = __uint_as_float(w << 16); v.y = __uint_as_float(w & 0xffff0000u); return v; }

DI size_t cq_idx(int t, int k) { return ((((size_t)(t >> 5) * 32 + (k >> 3)) * 32 + (t & 31)) << 3) + (k & 7); }
DI size_t ckv_idx(int t, int k) { return ((((size_t)(t >> 5) * 20 + (k >> 3)) * 32 + (t & 31)) << 3) + (k & 7); }
DI size_t qimg_idx(int bh, int s, int d) {
    const int qb = s >> 5, r = s & 31, kk = d >> 4, e = d & 15, h = (e >> 2) & 1, j = 4 * (e >> 3) + (e & 3);
    return (((((size_t)bh * 128 + qb) * 6 + kk) * 64 + (h * 32 + r)) << 3) + j;
}
DI size_t kimg_idx(int bh, int s, int d) {
    const int tile = s >> 6, c = (s >> 5) & 1, r = s & 31, kk = d >> 4, e = d & 15, h = (e >> 2) & 1, j = 4 * (e >> 3) + (e & 3);
    return ((((((size_t)bh * 64 + tile) * 6 + kk) * 2 + c) * 64 + (h * 32 + r)) << 3) + j;
}
DI size_t vimg_idx(int bh, int s, int d) {
    const int tile = s >> 6, kin = s & 63, c = kin >> 5, s2 = (kin >> 4) & 1, e = kin & 15, h = (e >> 2) & 1, j = 4 * (e >> 3) + (e & 3), dt = d >> 5, r = d & 31;
    return (((((((size_t)bh * 64 + tile) * 2 + c) * 2 + s2) * 2 + dt) * 64 + (h * 32 + r)) << 3) + j;
}

struct Ptrs {
    const float *x; const int* pos; const float *g_in, *w_in, *g_ql, *w_uq, *g_kvl, *w_ukv, *g_qh, *g_kh, *g_vg, *w_s, *b_s, *g_oa, *g_ob, *w_out;
    float* out; unsigned char* ws;
};

typedef float f32x4_t __attribute__((ext_vector_type(4)));
DI void p1_fused_q_a(const f32x4_t (&acc)[2][2][4][2], int pm, int wr, int wc, int fr, int fq, LAS unsigned char* lds, const Ptrs* pp);
DI void p1_fused_kv_a(const f32x4_t (&acc)[2][2][4][2], int pm, int wr, int wc, int fr, int fq, LAS unsigned char* lds, const Ptrs* pp);
DI void p1_fused_q_b(int pm, LAS unsigned char* lds, const Ptrs* pp, int wid, int lane);
DI void p1_fused_kv_b(int pm, LAS unsigned char* lds, const Ptrs* pp, int wid, int lane);
namespace pg8 {
#define PG8_LAS __attribute__((address_space(3)))
typedef short bf16x8 __attribute__((ext_vector_type(8)));
typedef float f32x4 __attribute__((ext_vector_type(4)));
typedef unsigned u32x4 __attribute__((ext_vector_type(4)));
constexpr int BM = 256, BK = 64, HALF = 128, HTB = HALF * BK * 2  , STAGE_BYTES = 8 * HTB, NXCD = 8, WGM = 8;

__host__ __device__ __forceinline__ int lds_byte(int r, int c) { const int st = (r >> 4) * 2 + (c >> 5), rr = r & 15, cc = c & 31, ob = rr * 64 + cc * 2; return st * 1024 + (ob ^ (((ob >> 9) & 1) << 5)); }
__host__ __device__ __forceinline__ void stage_rc(int b, int& R, int& C) { const int st = b / 1024, sb = b % 1024, swz = sb ^ (((sb >> 9) & 1) << 5); R = (st >> 1) * 16 + swz / 64; C = (st & 1) * 32 + (swz % 64) / 2; }
__host__ __device__ __forceinline__ int perm32(int rho) { const int n = rho >> 4, i = rho & 15; return 8 * (i >> 2) + 4 * n + (i & 3); }

struct Unit { int pm, pn; };
struct Gemm { const bf16_t* A; const bf16_t* Bt; int M, N, K; };

struct StaticOrder {
    int nM, nN, nwg, G, c;
    __host__ __device__ void init(int M, int N, int G_, int c_) { nM = M / BM; nN = N / BM; nwg = nM * nN; G = G_; c = c_; }
    __host__ __device__ bool next(int i, Unit& u) const {
        const long L = (long)i * G + c; if (L >= nwg) return false;
        int wgid = (int)L; { const int q = nwg / NXCD, r = nwg % NXCD, xcd = wgid % NXCD, off = wgid / NXCD; wgid = (xcd < r ? xcd * (q + 1) : r * (q + 1) + (xcd - r) * q) + off; }
        const int nig = WGM * nN, gid = wgid / nig, fm = gid * WGM, gsz = (nM - fm) < WGM ? (nM - fm) : WGM;
        u.pm = fm + ((wgid % nig) % gsz); u.pn = (wgid % nig) / gsz; return true;
    }
    __device__ __forceinline__ void a_ready(const Unit&) const {}
    __device__ __forceinline__ void done(const Unit&) const {}
};
__device__ __forceinline__ unsigned cvt_pk_bf16(float lo, float hi) { unsigned r; asm volatile("v_cvt_pk_bf16_f32 %0, %1, %2" : "=v"(r) : "v"(lo), "v"(hi)); return r; }

struct OneUnit { int pm, pn;
    __device__ __forceinline__ bool next(int i, Unit& u) const { if (i) return false; u.pm = pm; u.pn = pn; return true; }
    __device__ __forceinline__ void a_ready(const Unit&) const {}
    __device__ __forceinline__ void done(const Unit&) const {}
};
struct P1Order { StaticOrder S;
    __host__ __device__ void init(int M, int N, int G_, int c_) { S.init(M, N, G_, c_); }
    __host__ __device__ bool next(int i, Unit& u) const {
        if (i < 2) return S.next(i, u);
        if (i == 2 && S.c >= 128) { S.next(1, u); u.pn += 2; return true; }
        return false; }
    __device__ __forceinline__ void a_ready(const Unit&) const {}
    __device__ __forceinline__ void done(const Unit&) const {}
};
struct EpiProj {
    static constexpr bool PERM = true, AFTER_DRAIN = false, HAS_MID = false, FUSE_LAST = true; static constexpr int MID_T = -1;
    bf16_t *Z; const PG8_LAS float* rtab; const Ptrs* pp;
    __device__ __forceinline__ bool fused_unit(const Unit& u) const { return u.pn == 4 || u.pn == 5; }
    __device__ __forceinline__ void fused(const f32x4 (&acc)[2][2][4][2], const Unit& u, int wr, int wc, int fr, int fq, PG8_LAS unsigned char* lds, int wid, int lane) const {
        if (u.pn == 4) p1_fused_q_a(acc, u.pm, wr, wc, fr, fq, lds, pp); else p1_fused_kv_a(acc, u.pm, wr, wc, fr, fq, lds, pp);
        asm volatile("s_waitcnt lgkmcnt(0)\n\ts_barrier" ::: "memory");
        if (u.pn == 4) p1_fused_q_b(u.pm, lds, pp, wid, lane); else p1_fused_kv_b(u.pm, lds, pp, wid, lane); }
    __device__ __forceinline__ void mid(f32x4 (&)[2][2][4][2], int, int, PG8_LAS unsigned char*) const {}
    __device__ __forceinline__ void operator()(const f32x4 (&acc)[2][2][4][2], const Unit& u, int wr, int wc, int fr, int fq) const {
        const int row0 = u.pm * BM + wr * 64 + fr;
        const int zc = (u.pn < 4 ? 512 + u.pn * BM : u.pn < 8 ? u.pn * BM : (u.pn - 8) * BM);
        float rsv[2][4];
#pragma unroll
        for (int ai = 0; ai < 2; ++ai)
#pragma unroll
            for (int m = 0; m < 4; ++m) rsv[ai][m] = rtab[wr * 64 + fr + ai * HALF + m * 16];
#pragma unroll
        for (int ai = 0; ai < 2; ++ai)
#pragma unroll
            for (int m = 0; m < 4; ++m) { const int row = row0 + ai * HALF + m * 16; const float rs = rsv[ai][m];
#pragma unroll
                for (int bj = 0; bj < 2; ++bj) { const int lc = bj * HALF + wc * 32 + 8 * fq;
                    const f32x4 v0 = acc[ai][bj][m][0] * rs, v1 = acc[ai][bj][m][1] * rs;
                    u32x4 w; w.x = cvt_pk_bf16(v0[0], v0[1]); w.y = cvt_pk_bf16(v0[2], v0[3]); w.z = cvt_pk_bf16(v1[0], v1[1]); w.w = cvt_pk_bf16(v1[2], v1[3]);
                    *(u32x4*)(Z + (size_t)row * 2048 + zc + lc) = w; } }

    }
};
struct EpiOut {
    static constexpr bool PERM = false, AFTER_DRAIN = true, HAS_MID = true, FUSE_LAST = false; static constexpr int MID_T = 8;
    __device__ __forceinline__ bool fused_unit(const Unit&) const { return false; }
    __device__ __forceinline__ void fused(const f32x4 (&acc)[2][2][4][2], const Unit& u, int wr, int wc, int fr, int fq, PG8_LAS unsigned char* lds, int wid, int lane) const {
        typedef float nt4 __attribute__((ext_vector_type(4)));
        const PG8_LAS float* rstdb = (const PG8_LAS float*)(lds + STAGE_BYTES + 1024);
#pragma unroll
        for (int ai = 0; ai < 2; ++ai) {
            const size_t g0 = (size_t)(u.pm * BM + ai * HALF + wid * 16) * 1024 + u.pn * BM + 4 * lane;
            typedef unsigned nt2 __attribute__((ext_vector_type(2)));
            nt2 xv[16];
#pragma unroll
            for (int i = 0; i < 16; ++i) xv[i] = __builtin_nontemporal_load((const nt2*)(xb + g0 + (size_t)i * 1024));
#pragma unroll
            for (int m = 0; m < 4; ++m) { const int r = wr * 64 + m * 16 + fr; const float rb = rstdb[ai * HALF + r];
#pragma unroll
                for (int bj = 0; bj < 2; ++bj)
#pragma unroll
                    for (int n = 0; n < 2; ++n) { const int c = bj * 32 + wc * 8 + n * 4 + fq;
                        *(PG8_LAS f32x4*)(lds + r * 1024 + ((c ^ (r & 15)) << 4)) = acc[ai][bj][m][n] * rb; } }
            asm volatile("s_waitcnt lgkmcnt(0)\n\ts_barrier" ::: "memory");
#pragma unroll
            for (int i = 0; i < 16; ++i) { const f32x4 v = *(const PG8_LAS f32x4*)(lds + (wid * 16 + i) * 1024 + ((lane ^ i) << 4));
                const f32x4 xr = {__builtin_bit_cast(float, xv[i].x << 16), __builtin_bit_cast(float, xv[i].x & 0xffff0000u), __builtin_bit_cast(float, xv[i].y << 16), __builtin_bit_cast(float, xv[i].y & 0xffff0000u)};
                __builtin_nontemporal_store(xr + v, (nt4*)(out + g0 + (size_t)i * 1024)); }
            if (ai == 0) asm volatile("s_waitcnt lgkmcnt(0)\n\ts_barrier" ::: "memory");
        }
    }
    const float* x; float* out; PG8_LAS unsigned char* ldsb; const bf16_t* xb;
    __device__ __forceinline__ void mid(f32x4 (&acc)[2][2][4][2], int wr, int fr, PG8_LAS unsigned char* lds) const {
        const PG8_LAS float* ratio = (const PG8_LAS float*)(lds + STAGE_BYTES);
#pragma unroll
        for (int ai = 0; ai < 2; ++ai)
#pragma unroll
            for (int m = 0; m < 4; ++m) { const float r = ratio[ai * HALF + wr * 64 + m * 16 + fr];
#pragma unroll
                for (int bj = 0; bj < 2; ++bj)
#pragma unroll
                    for (int n = 0; n < 2; ++n) acc[ai][bj][m][n] = acc[ai][bj][m][n] * r; }
    }
    __device__ __forceinline__ void operator()(const f32x4 (&acc)[2][2][4][2], const Unit& u, int wr, int wc, int fr, int fq) const {
        const PG8_LAS float* rstdb = (const PG8_LAS float*)(ldsb + STAGE_BYTES + 1024);
        const int row0 = u.pm * BM + wr * 64 + fr, col0 = u.pn * BM + wc * 32 + 4 * fq;
#pragma unroll
        for (int ai = 0; ai < 2; ++ai) {
            f32x4 xv[4][2][2]; float rb[4];
#pragma unroll
            for (int m = 0; m < 4; ++m) { rb[m] = rstdb[ai * HALF + wr * 64 + m * 16 + fr]; const size_t off = (size_t)(row0 + ai * HALF + m * 16) * 1024 + col0;
#pragma unroll
                for (int bj = 0; bj < 2; ++bj)
#pragma unroll
                    for (int n = 0; n < 2; ++n) xv[m][bj][n] = __builtin_nontemporal_load((const f32x4*)(x + off + bj * HALF + n * 16)); }
#pragma unroll
            for (int m = 0; m < 4; ++m) { const size_t off = (size_t)(row0 + ai * HALF + m * 16) * 1024 + col0;
#pragma unroll
                for (int bj = 0; bj < 2; ++bj)
#pragma unroll
                    for (int n = 0; n < 2; ++n) __builtin_nontemporal_store(xv[m][bj][n] + acc[ai][bj][m][n] * rb[m], (f32x4*)(out + off + bj * HALF + n * 16)); }
        }
    }
};
template <class Epi, class Sched, bool ALIGN_EPI = false, bool SP2 = false>
__device__ __forceinline__ void gemm_phase(PG8_LAS unsigned char* lds, const Gemm g, const Sched& S, const Epi& E) {
    const int tid = threadIdx.x, wid = __builtin_amdgcn_readfirstlane(tid >> 6), lane = tid & 63, wr = wid >> 2, wc = wid & 3, fr = lane & 15, fq = lane >> 4;
    const int K = g.K, nt = K / BK;
    unsigned voffA[2], voffB[2];
#pragma unroll
    for (int i = 0; i < 2; ++i) { int R, C; stage_rc(tid * 16 + i * 8192, R, C); const int Rb = Epi::PERM ? ((R & ~31) + perm32(R & 31)) : R;
        voffA[i] = (unsigned)(R * K + C) * 2u; voffB[i] = (unsigned)(Rb * K + C) * 2u; }
    const size_t kstep = (size_t)(BK * 2);
    const size_t hstep = (size_t)HALF * K * 2;
    const size_t tstep = 2 * hstep;
    const unsigned ldsw = (unsigned)wid * 1024u;
    const int aoff = lds_byte(wr * 64 + fr, fq * 8), boff = lds_byte(wc * 32 + fr, fq * 8);
#define PG8_SA(b, h) (((b) * 2 + (h)) * HTB)
#define PG8_SB(b, h) ((4 + (b) * 2 + (h)) * HTB)
#define PG8_STAGE(bufoff, gbase, voff) do { _Pragma("unroll") for (int _i = 0; _i < 2; ++_i) \
        __builtin_amdgcn_global_load_lds((const unsigned*)((const char*)(gbase) + (voff)[_i]), (PG8_LAS unsigned*)(lds + (bufoff) + ldsw + _i * 8192), 16, 0, 0); } while (0)
#define PG8_LDA(dst, b, h) do { _Pragma("unroll") for (int m = 0; m < 4; ++m) _Pragma("unroll") for (int k = 0; k < 2; ++k) dst[m][k] = *(const PG8_LAS bf16x8*)(lds + PG8_SA(b, h) + aoff + m * 2048 + k * 1024); } while (0)
#define PG8_LDB(dst, b, h) do { _Pragma("unroll") for (int n = 0; n < 2; ++n) _Pragma("unroll") for (int k = 0; k < 2; ++k) dst[n][k] = *(const PG8_LAS bf16x8*)(lds + PG8_SB(b, h) + boff + n * 2048 + k * 1024); } while (0)
#define PG8_MMA(ai, bj, At, Bt) do { __builtin_amdgcn_s_setprio(1); _Pragma("unroll") for (int m = 0; m < 4; ++m) _Pragma("unroll") for (int n = 0; n < 2; ++n) _Pragma("unroll") for (int k = 0; k < 2; ++k) \
        acc[ai][bj][m][n] = __builtin_amdgcn_mfma_f32_16x16x32_bf16(Bt[n][k], At[m][k], acc[ai][bj][m][n], 0, 0, 0); __builtin_amdgcn_s_setprio(0); } while (0)
#define PG8_WAIT_V(n) asm volatile("s_waitcnt vmcnt(" #n ")" ::: "memory")
#define PG8_WAIT_L(n) asm volatile("s_waitcnt lgkmcnt(" #n ")" ::: "memory")
#define PG8_BAR __builtin_amdgcn_s_barrier()
#define PG8_SCHED __builtin_amdgcn_sched_barrier(0)
    Unit cur, nxt; int ui = 0;
    if (!S.next(0, cur)) return;
    f32x4 acc[2][2][4][2];
#pragma unroll
    for (int a = 0; a < 2; ++a)
#pragma unroll
        for (int b = 0; b < 2; ++b)
#pragma unroll
            for (int m = 0; m < 4; ++m)
#pragma unroll
                for (int n = 0; n < 2; ++n) acc[a][b][m][n] = (f32x4){0.f, 0.f, 0.f, 0.f};
    bf16x8 At[4][2], B0[2][2], B1[2][2];
    const char* cA = (const char*)g.A + (size_t)cur.pm * tstep; const char* cB = (const char*)g.Bt + (size_t)cur.pn * tstep;
    S.a_ready(cur);
    if constexpr (SP2) {
        PG8_STAGE(PG8_SB(0, 0), cB, voffB); PG8_STAGE(PG8_SB(0, 1), cB + hstep, voffB); PG8_STAGE(PG8_SA(0, 0), cA, voffA); PG8_STAGE(PG8_SA(0, 1), cA + hstep, voffA);
        if (wr == 1) PG8_BAR;
        PG8_WAIT_V(2); PG8_BAR;
        PG8_STAGE(PG8_SB(1, 0), cB + kstep, voffB); PG8_STAGE(PG8_SA(1, 0), cA + kstep, voffA); PG8_STAGE(PG8_SB(1, 1), cB + hstep + kstep, voffB);
        PG8_WAIT_V(6); PG8_BAR;
    } else {
        PG8_STAGE(PG8_SB(0, 0), cB, voffB); PG8_STAGE(PG8_SA(0, 0), cA, voffA); PG8_STAGE(PG8_SB(0, 1), cB + hstep, voffB); PG8_STAGE(PG8_SA(0, 1), cA + hstep, voffA);
        if (wr == 1) PG8_BAR;
        PG8_WAIT_V(4); PG8_BAR;
        PG8_STAGE(PG8_SB(1, 0), cB + kstep, voffB); PG8_STAGE(PG8_SA(1, 0), cA + kstep, voffA); PG8_STAGE(PG8_SB(1, 1), cB + hstep + kstep, voffB);
        PG8_WAIT_V(6); PG8_BAR;
    }
    for (;;) {
        const bool has_next = S.next(ui + 1, nxt);
        const char* nA = has_next ? (const char*)g.A + (size_t)nxt.pm * tstep : cA; const char* nB = has_next ? (const char*)g.Bt + (size_t)nxt.pn * tstep : cB;
        for (int t = 0; t < nt; t += 2) {
            const bool last = (t == nt - 2);
            const char* a1 = cA + (size_t)(t + 1) * kstep;
            const char* a2 = last ? nA : cA + (size_t)(t + 2) * kstep; const char* b2 = last ? nB : cB + (size_t)(t + 2) * kstep;
            const char* a3 = a2 + kstep; const char* b3 = b2 + kstep;
            if (last && has_next) S.a_ready(nxt);
            if constexpr (Epi::HAS_MID) { if (t == Epi::MID_T) { PG8_SCHED; E.mid(acc, wr, fr, lds); PG8_SCHED; } }
            if constexpr (SP2) {
            PG8_LDB(B0, 0, 0); PG8_LDB(B1, 0, 1); PG8_SCHED; PG8_LDA(At, 0, 0); PG8_STAGE(PG8_SA(1, 1), a1 + hstep, voffA);
            PG8_WAIT_V(8); PG8_WAIT_L(0); PG8_BAR; PG8_MMA(0, 0, At, B0); PG8_MMA(0, 1, At, B1); PG8_BAR; PG8_SCHED;
            PG8_LDA(At, 0, 1); PG8_STAGE(PG8_SB(0, 0), b2, voffB); PG8_STAGE(PG8_SB(0, 1), b2 + hstep, voffB); PG8_STAGE(PG8_SA(0, 0), a2, voffA);
            PG8_WAIT_V(8); PG8_WAIT_L(0); PG8_BAR; PG8_MMA(1, 0, At, B0); PG8_MMA(1, 1, At, B1); PG8_BAR; PG8_SCHED;
            PG8_LDB(B0, 1, 0); PG8_LDB(B1, 1, 1); PG8_SCHED; PG8_LDA(At, 1, 0); PG8_STAGE(PG8_SA(0, 1), a2 + hstep, voffA);
            PG8_WAIT_V(8); PG8_WAIT_L(0); PG8_BAR; PG8_MMA(0, 0, At, B0); PG8_MMA(0, 1, At, B1); PG8_BAR; PG8_SCHED;
            PG8_LDA(At, 1, 1); PG8_STAGE(PG8_SB(1, 0), b3, voffB); PG8_STAGE(PG8_SB(1, 1), b3 + hstep, voffB); PG8_STAGE(PG8_SA(1, 0), a3, voffA);
            PG8_WAIT_V(8); PG8_WAIT_L(0); PG8_BAR; PG8_MMA(1, 0, At, B0); PG8_MMA(1, 1, At, B1); PG8_BAR; PG8_SCHED;
            } else {
            PG8_LDB(B0, 0, 0); PG8_SCHED; PG8_LDA(At, 0, 0); PG8_STAGE(PG8_SA(1, 1), a1 + hstep, voffA);
            PG8_WAIT_L(8); PG8_BAR; PG8_WAIT_L(0); PG8_MMA(0, 0, At, B0); PG8_BAR; PG8_SCHED;
            PG8_LDB(B1, 0, 1); PG8_STAGE(PG8_SB(0, 0), b2, voffB);
            PG8_BAR; PG8_WAIT_L(0); PG8_MMA(0, 1, At, B1); PG8_BAR;
            PG8_LDA(At, 0, 1); PG8_STAGE(PG8_SA(0, 0), a2, voffA);
            PG8_BAR; PG8_WAIT_L(0); PG8_MMA(1, 0, At, B0); PG8_BAR; PG8_SCHED;
            PG8_STAGE(PG8_SB(0, 1), b2 + hstep, voffB);
            PG8_WAIT_V(6); PG8_BAR; PG8_MMA(1, 1, At, B1); PG8_BAR;
            PG8_LDB(B0, 1, 0); PG8_SCHED; PG8_LDA(At, 1, 0); PG8_STAGE(PG8_SA(0, 1), a2 + hstep, voffA);
            PG8_WAIT_L(8); PG8_BAR; PG8_WAIT_L(0); PG8_MMA(0, 0, At, B0); PG8_BAR; PG8_SCHED;
            PG8_LDB(B1, 1, 1); PG8_STAGE(PG8_SB(1, 0), b3, voffB);
            PG8_BAR; PG8_WAIT_L(0); PG8_MMA(0, 1, At, B1); PG8_BAR;
            PG8_LDA(At, 1, 1); PG8_STAGE(PG8_SA(1, 0), a3, voffA);
            PG8_BAR; PG8_WAIT_L(0); PG8_MMA(1, 0, At, B0); PG8_BAR; PG8_SCHED;
            PG8_STAGE(PG8_SB(1, 1), b3 + hstep, voffB);
            PG8_WAIT_V(6); PG8_BAR; PG8_MMA(1, 1, At, B1); PG8_BAR;
            }
        }
        if constexpr (ALIGN_EPI) { if (wr == 0) PG8_BAR; }
        if constexpr (Epi::FUSE_LAST) { if (has_next || !E.fused_unit(cur)) E(acc, cur, wr, wc, fr, fq); S.done(cur); }
        else if constexpr (!Epi::AFTER_DRAIN) { E(acc, cur, wr, wc, fr, fq); S.done(cur); }
        if (!has_next) break;
#pragma unroll
        for (int a = 0; a < 2; ++a)
#pragma unroll
            for (int b = 0; b < 2; ++b)
#pragma unroll
                for (int m = 0; m < 4; ++m)
#pragma unroll
                    for (int n = 0; n < 2; ++n) acc[a][b][m][n] = (f32x4){0.f, 0.f, 0.f, 0.f};
        cur = nxt; cA = nA; cB = nB; ++ui;
        if constexpr (ALIGN_EPI) { if (wr == 1) PG8_BAR; }
    }
    PG8_WAIT_V(0);
    if constexpr (!ALIGN_EPI) { if (wr == 0) PG8_BAR; }
    PG8_BAR;
    if constexpr (Epi::FUSE_LAST) { if (E.fused_unit(cur)) E.fused(acc, cur, wr, wc, fr, fq, lds, wid, lane); }
    else if constexpr (Epi::AFTER_DRAIN) { E.fused(acc, cur, wr, wc, fr, fq, lds, wid, lane); S.done(cur); }
#undef PG8_SA
#undef PG8_SB
#undef PG8_STAGE
#undef PG8_LDA
#undef PG8_LDB
#undef PG8_MMA
#undef PG8_WAIT_V
#undef PG8_WAIT_L
#undef PG8_BAR
#undef PG8_SCHED
}
}


namespace att {
typedef short bf16x8 __attribute__((ext_vector_type(8)));
typedef float f32x16 __attribute__((ext_vector_type(16)));
typedef float f32x2_t __attribute__((ext_vector_type(2))); typedef __bf16 bf16x2_t __attribute__((ext_vector_type(2)));
DI unsigned cvtpk(float lo, float hi) { f32x2_t v = {lo, hi}; bf16x2_t b = __builtin_convertvector(v, bf16x2_t); return __builtin_bit_cast(unsigned, b); }
DI void glds16(const void* gsrc, unsigned lds_dst) { unsigned keep;
    asm volatile("s_mov_b32 %0, m0\n\ts_mov_b32 m0, %2\n\ts_nop 0\n\tglobal_load_lds_dwordx4 %1, off\n\ts_mov_b32 m0, %0" : "=&s"(keep) : "v"(gsrc), "s"(lds_dst) : "memory"); }
constexpr int SLOTB = 20480, KBYTES = 12288, VBYTES = 8192;
#define MFMA32(a, b, c) __builtin_amdgcn_mfma_f32_32x32x16_bf16((a), (b), (c), 0, 0, 0)
DI void attn_epi64(LAS unsigned char* stg, const Ptrs& p, const f32x16& o0, const f32x16& o1, float lsum, int bh, int q0, int lane) {
    asm volatile("" : "+v"(lane));
    const int r = lane & 31, h = lane >> 5, rw = lane >> 3, c8 = lane & 7;
    typedef unsigned u32x4g __attribute__((ext_vector_type(4)));
    const int b = bh >> 3, hd = bh & 7, t0 = b * SEQ + q0;
    u32x4g zld[4];
#pragma unroll
    for (int q = 0; q < 4; ++q) zld[q] = *(const u32x4g*)((const bf16_t*)(p.ws + WS_Z) + (size_t)(t0 + 8 * q + rw) * 2048 + hd * 64 + 8 * c8);
    lsum += __shfl_xor(lsum, 32);
    const float rl = __builtin_amdgcn_rcpf(lsum);
    float sq = 0.f;
#pragma unroll
    for (int dt = 0; dt < 2; ++dt)
#pragma unroll
        for (int g = 0; g < 4; ++g) { f32x4_t v4;
#pragma unroll
            for (int e = 0; e < 4; ++e) { v4[e] = (dt ? o1[4 * g + e] : o0[4 * g + e]) * rl; sq += v4[e] * v4[e]; }
            *(LAS f32x4_t*)(stg + r * 256 + (((8 * dt + 2 * g + h) ^ (r & 15)) << 4)) = v4; }
    sq += __shfl_xor(sq, 32);
    if (h == 0) ((float*)(p.ws + WS_SSQA))[(size_t)hd * T + t0 + r] = sq;
    asm volatile("s_waitcnt lgkmcnt(0)" ::: "memory");
#pragma unroll
    for (int q = 0; q < 4; ++q) { const int tl = 8 * q + rw;
        const f32x4_t m0 = *(const LAS f32x4_t*)(stg + tl * 256 + (((2 * c8) ^ (tl & 15)) << 4)), m1 = *(const LAS f32x4_t*)(stg + tl * 256 + (((2 * c8 + 1) ^ (tl & 15)) << 4));
        const u32x4g zz = zld[q];
        const f2_t a0 = (f2_t){m0[0], m0[1]} * silu2(bf2x(zz.x)), a1 = (f2_t){m0[2], m0[3]} * silu2(bf2x(zz.y)), a2 = (f2_t){m1[0], m1[1]} * silu2(bf2x(zz.z)), a3 = (f2_t){m1[2], m1[3]} * silu2(bf2x(zz.w));
        u32x4g w; w.x = cvtpk(a0.x, a0.y); w.y = cvtpk(a1.x, a1.y); w.z = cvtpk(a2.x, a2.y); w.w = cvtpk(a3.x, a3.y);
        *(u32x4g*)((bf16_t*)(p.ws + WS_AMIX) + (size_t)(t0 + tl) * 1024 + hd * 64 + 8 * c8) = w; }
    asm volatile("s_waitcnt lgkmcnt(0)" ::: "memory");
}
DI void attn_unit64(LAS unsigned char* lds, const Ptrs& p, int bh, int qb512, int wid, int lane) {
    const unsigned lds0 = (unsigned)(uintptr_t)lds;
    const unsigned char* Kg = p.ws + WS_KIMG + (size_t)bh * 64 * KBYTES + lane * 16;
    const unsigned char* Vg = p.ws + WS_VIMG + (size_t)bh * 64 * VBYTES + lane * 16;
    const bf16x8* Qg = (const bf16x8*)(p.ws + WS_QIMG + ((size_t)(bh * 128 + qb512 * 16 + 2 * wid) * 6 * 64 + lane) * 16);
    bf16x8 qa[6], qb[6];
#pragma unroll
    for (int kk = 0; kk < 6; ++kk) { qa[kk] = Qg[kk * 64]; qb[kk] = Qg[(6 + kk) * 64]; }
#define ATT_DMA(t, slotoff) do { const unsigned char* kt_ = Kg + (size_t)(t) * KBYTES; const unsigned char* vt_ = Vg + (size_t)(t) * VBYTES; \
        glds16(kt_ + wid * 1024, (unsigned)__builtin_amdgcn_readfirstlane(lds0 + (slotoff) + wid * 1024)); \
        if (wid < 4) { glds16(kt_ + (wid + 8) * 1024, (unsigned)__builtin_amdgcn_readfirstlane(lds0 + (slotoff) + (wid + 8) * 1024)); \
                       glds16(vt_ + (wid + 4) * 1024, (unsigned)__builtin_amdgcn_readfirstlane(lds0 + (slotoff) + KBYTES + (wid + 4) * 1024)); } \
        else glds16(vt_ + (wid - 4) * 1024, (unsigned)__builtin_amdgcn_readfirstlane(lds0 + (slotoff) + KBYTES + (wid - 4) * 1024)); } while (0)
#define ATT_WAIT_MINE() do { if (wid < 4) asm volatile("s_waitcnt vmcnt(3) lgkmcnt(0)\n\ts_barrier" ::: "memory"); else asm volatile("s_waitcnt vmcnt(2) lgkmcnt(0)\n\ts_barrier" ::: "memory"); } while (0)
#define ATT_WAIT_ALL() asm volatile("s_waitcnt vmcnt(0) lgkmcnt(0)\n\ts_barrier" ::: "memory")
#define SBAR() __builtin_amdgcn_sched_barrier(0)
#define EX(v) __builtin_amdgcn_exp2f(v)
#define LD(ptr) (*(const LAS bf16x8*)(ptr))
#define MF(a, b, c) MFMA32((a), (b), (c))
    ATT_DMA(0, 0); ATT_DMA(1, SLOTB); ATT_DMA(2, 2 * SLOTB); ATT_DMA(3, 3 * SLOTB);
    ATT_WAIT_ALL();
    f32x16 OA0, OA1, OB0, OB1, SA0, SA1, SB0, SB1, zz;
#pragma unroll
    for (int i = 0; i < 16; ++i) { OA0[i] = 0.f; OA1[i] = 0.f; OB0[i] = 0.f; OB1[i] = 0.f; zz[i] = 0.f; }
    float lsA = 0.f, lsB = 0.f;
    uint4 pA0_0, pA0_1, pA1_0, pA1_1, pB0_0, pB0_1, pB1_0, pB1_1;
    bf16x8 fr0, fr1, fr2, fr3;
    {
        const LAS unsigned char* kp0 = lds + lane * 16;
        SA0 = zz; SA1 = zz; SB0 = zz; SB1 = zz;
#pragma unroll
        for (int kk = 0; kk < 6; ++kk) { const bf16x8 k0 = LD(kp0 + (2 * kk) * 1024), k1 = LD(kp0 + (2 * kk + 1) * 1024);
            SA0 = MFMA32(k0, qa[kk], SA0); SA1 = MFMA32(k1, qa[kk], SA1); SB0 = MFMA32(k0, qb[kk], SB0); SB1 = MFMA32(k1, qb[kk], SB1); }
#pragma unroll
        for (int i = 0; i < 16; ++i) { SA0[i] = EX(SA0[i]); SB0[i] = EX(SB0[i]); lsA += SA0[i]; lsB += SB0[i]; }
        pA0_0 = make_uint4(cvtpk(SA0[0], SA0[1]), cvtpk(SA0[2], SA0[3]), cvtpk(SA0[4], SA0[5]), cvtpk(SA0[6], SA0[7]));
        pA0_1 = make_uint4(cvtpk(SA0[8], SA0[9]), cvtpk(SA0[10], SA0[11]), cvtpk(SA0[12], SA0[13]), cvtpk(SA0[14], SA0[15]));
        pB0_0 = make_uint4(cvtpk(SB0[0], SB0[1]), cvtpk(SB0[2], SB0[3]), cvtpk(SB0[4], SB0[5]), cvtpk(SB0[6], SB0[7]));
        pB0_1 = make_uint4(cvtpk(SB0[8], SB0[9]), cvtpk(SB0[10], SB0[11]), cvtpk(SB0[12], SB0[13]), cvtpk(SB0[14], SB0[15]));
        fr0 = LD(kp0 + SLOTB + 0 * 1024); fr1 = LD(kp0 + SLOTB + 2 * 1024);
        pA1_0 = pA0_0; pA1_1 = pA0_1; pB1_0 = pB0_0; pB1_1 = pB0_1; fr2 = fr0; fr3 = fr1;
    }
    int off_v = 0, off_k1 = SLOTB, off_k2 = 2 * SLOTB, off_d = 4 * SLOTB, off_d2 = 5 * SLOTB;
#define A64H_STEP(LAST, ODD) do { \
        if (!(ODD)) { if (t + 4 < 64) ATT_DMA(t + 4, off_d); if (t + 5 < 64) ATT_DMA(t + 5, off_d2); } \
        const LAS unsigned char* vp_ = lds + off_v + KBYTES + lane * 16; const LAS unsigned char* kp_ = lds + off_k1 + lane * 16; const LAS unsigned char* kn_ = lds + off_k2 + lane * 16; \
        float la_ = 0.f, lb_ = 0.f; SBAR(); \
        if (!(LAST)) SA0 = MF(fr0, qa[0], zz); fr2 = LD(kp_ + 4096); SA1[0] = EX(SA1[0]); SA1[1] = EX(SA1[1]); SA1[2] = EX(SA1[2]); SBAR(); \
        if (!(LAST)) SB0 = MF(fr0, qb[0], zz); SA1[3] = EX(SA1[3]); SA1[4] = EX(SA1[4]); SA1[5] = EX(SA1[5]); SBAR(); \
        if (!(LAST)) SA0 = MF(fr1, qa[1], SA0); fr3 = LD(kp_ + 6144); SA1[6] = EX(SA1[6]); SA1[7] = EX(SA1[7]); SA1[8] = EX(SA1[8]); SBAR(); \
        if (!(LAST)) SB0 = MF(fr1, qb[1], SB0); SA1[9] = EX(SA1[9]); SA1[10] = EX(SA1[10]); SA1[11] = EX(SA1[11]); SBAR(); \
        if (!(LAST)) SA0 = MF(fr2, qa[2], SA0); fr0 = LD(kp_ + 8192); SA1[12] = EX(SA1[12]); SA1[13] = EX(SA1[13]); SA1[14] = EX(SA1[14]); SBAR(); \
        if (!(LAST)) SB0 = MF(fr2, qb[2], SB0); SA1[15] = EX(SA1[15]); SB1[0] = EX(SB1[0]); SB1[1] = EX(SB1[1]); SBAR(); \
        if (!(LAST)) SA0 = MF(fr3, qa[3], SA0); fr1 = LD(kp_ + 10240); SB1[2] = EX(SB1[2]); SB1[3] = EX(SB1[3]); SB1[4] = EX(SB1[4]); SBAR(); \
        if (!(LAST)) SB0 = MF(fr3, qb[3], SB0); SB1[5] = EX(SB1[5]); SB1[6] = EX(SB1[6]); SB1[7] = EX(SB1[7]); SBAR(); \
        if (!(LAST)) SA0 = MF(fr0, qa[4], SA0); fr2 = LD(vp_ + 0); SB1[8] = EX(SB1[8]); SB1[9] = EX(SB1[9]); SBAR(); \
        if (!(LAST)) SB0 = MF(fr0, qb[4], SB0); SB1[10] = EX(SB1[10]); SB1[11] = EX(SB1[11]); SBAR(); \
        if (!(LAST)) SA0 = MF(fr1, qa[5], SA0); fr3 = LD(vp_ + 1024); SB1[12] = EX(SB1[12]); SB1[13] = EX(SB1[13]); SBAR(); \
        if (!(LAST)) SB0 = MF(fr1, qb[5], SB0); SB1[14] = EX(SB1[14]); SB1[15] = EX(SB1[15]); SBAR(); \
        OA0 = MF(fr2, __builtin_bit_cast(bf16x8, pA0_0), OA0); fr0 = LD(vp_ + 2048); pA1_0.x = cvtpk(SA1[0], SA1[1]); pA1_0.y = cvtpk(SA1[2], SA1[3]); la_ += SA1[0]; la_ += SA1[1]; la_ += SA1[2]; la_ += SA1[3]; asm volatile("" : "+v"(la_), "+v"(lb_)); SBAR(); \
        OB0 = MF(fr2, __builtin_bit_cast(bf16x8, pB0_0), OB0); pA1_0.z = cvtpk(SA1[4], SA1[5]); pA1_0.w = cvtpk(SA1[6], SA1[7]); la_ += SA1[4]; la_ += SA1[5]; la_ += SA1[6]; la_ += SA1[7]; asm volatile("" : "+v"(la_), "+v"(lb_)); SBAR(); \
        OA1 = MF(fr3, __builtin_bit_cast(bf16x8, pA0_0), OA1); fr1 = LD(vp_ + 3072); pA1_1.x = cvtpk(SA1[8], SA1[9]); pA1_1.y = cvtpk(SA1[10], SA1[11]); la_ += SA1[8]; la_ += SA1[9]; la_ += SA1[10]; la_ += SA1[11]; asm volatile("" : "+v"(la_), "+v"(lb_)); SBAR(); \
        OB1 = MF(fr3, __builtin_bit_cast(bf16x8, pB0_0), OB1); pA1_1.z = cvtpk(SA1[12], SA1[13]); pA1_1.w = cvtpk(SA1[14], SA1[15]); la_ += SA1[12]; la_ += SA1[13]; la_ += SA1[14]; la_ += SA1[15]; asm volatile("" : "+v"(la_), "+v"(lb_)); SBAR(); \
        OA0 = MF(fr0, __builtin_bit_cast(bf16x8, pA0_1), OA0); fr2 = LD(kp_ + 1024); pB1_0.x = cvtpk(SB1[0], SB1[1]); pB1_0.y = cvtpk(SB1[2], SB1[3]); lb_ += SB1[0]; lb_ += SB1[1]; lb_ += SB1[2]; lb_ += SB1[3]; asm volatile("" : "+v"(la_), "+v"(lb_)); SBAR(); \
        OB0 = MF(fr0, __builtin_bit_cast(bf16x8, pB0_1), OB0); pB1_0.z = cvtpk(SB1[4], SB1[5]); pB1_0.w = cvtpk(SB1[6], SB1[7]); lb_ += SB1[4]; lb_ += SB1[5]; lb_ += SB1[6]; lb_ += SB1[7]; asm volatile("" : "+v"(la_), "+v"(lb_)); SBAR(); \
        OA1 = MF(fr1, __builtin_bit_cast(bf16x8, pA0_1), OA1); fr3 = LD(kp_ + 3072); pB1_1.x = cvtpk(SB1[8], SB1[9]); pB1_1.y = cvtpk(SB1[10], SB1[11]); lb_ += SB1[8]; lb_ += SB1[9]; lb_ += SB1[10]; lb_ += SB1[11]; asm volatile("" : "+v"(la_), "+v"(lb_)); SBAR(); \
        OB1 = MF(fr1, __builtin_bit_cast(bf16x8, pB0_1), OB1); pB1_1.z = cvtpk(SB1[12], SB1[13]); pB1_1.w = cvtpk(SB1[14], SB1[15]); lb_ += SB1[12]; lb_ += SB1[13]; lb_ += SB1[14]; lb_ += SB1[15]; asm volatile("" : "+v"(la_), "+v"(lb_)); SBAR(); \
        if (!(LAST)) SA1 = MF(fr2, qa[0], zz); fr0 = LD(kp_ + 5120); if (!(LAST)) { SA0[0] = EX(SA0[0]); SA0[1] = EX(SA0[1]); SA0[2] = EX(SA0[2]); } SBAR(); \
        if (!(LAST)) SB1 = MF(fr2, qb[0], zz); if (!(LAST)) { SA0[3] = EX(SA0[3]); SA0[4] = EX(SA0[4]); SA0[5] = EX(SA0[5]); } SBAR(); \
        if (!(LAST)) SA1 = MF(fr3, qa[1], SA1); fr1 = LD(kp_ + 7168); if (!(LAST)) { SA0[6] = EX(SA0[6]); SA0[7] = EX(SA0[7]); SA0[8] = EX(SA0[8]); } SBAR(); \
        if (!(LAST)) SB1 = MF(fr3, qb[1], SB1); if (!(LAST)) { SA0[9] = EX(SA0[9]); SA0[10] = EX(SA0[10]); SA0[11] = EX(SA0[11]); } SBAR(); \
        if (!(LAST)) SA1 = MF(fr0, qa[2], SA1); fr2 = LD(kp_ + 9216); if (!(LAST)) { SA0[12] = EX(SA0[12]); SA0[13] = EX(SA0[13]); SA0[14] = EX(SA0[14]); } SBAR(); \
        if (!(LAST)) SB1 = MF(fr0, qb[2], SB1); if (!(LAST)) { SA0[15] = EX(SA0[15]); SB0[0] = EX(SB0[0]); SB0[1] = EX(SB0[1]); } SBAR(); \
        if (!(LAST)) SA1 = MF(fr1, qa[3], SA1); fr3 = LD(kp_ + 11264); if (!(LAST)) { SB0[2] = EX(SB0[2]); SB0[3] = EX(SB0[3]); SB0[4] = EX(SB0[4]); } SBAR(); \
        if (!(LAST)) SB1 = MF(fr1, qb[3], SB1); if (!(LAST)) { SB0[5] = EX(SB0[5]); SB0[6] = EX(SB0[6]); SB0[7] = EX(SB0[7]); } SBAR(); \
        if (!(LAST)) SA1 = MF(fr2, qa[4], SA1); fr0 = LD(vp_ + 4096); if (!(LAST)) { SB0[8] = EX(SB0[8]); SB0[9] = EX(SB0[9]); } SBAR(); \
        if (!(LAST)) SB1 = MF(fr2, qb[4], SB1); if (!(LAST)) { SB0[10] = EX(SB0[10]); SB0[11] = EX(SB0[11]); } SBAR(); \
        if (!(LAST)) SA1 = MF(fr3, qa[5], SA1); fr1 = LD(vp_ + 5120); if (!(LAST)) { SB0[12] = EX(SB0[12]); SB0[13] = EX(SB0[13]); } SBAR(); \
        if (!(LAST)) SB1 = MF(fr3, qb[5], SB1); if (!(LAST)) { SB0[14] = EX(SB0[14]); SB0[15] = EX(SB0[15]); } SBAR(); \
        OA0 = MF(fr0, __builtin_bit_cast(bf16x8, pA1_0), OA0); fr2 = LD(vp_ + 6144); if (!(LAST)) { pA0_0.x = cvtpk(SA0[0], SA0[1]); pA0_0.y = cvtpk(SA0[2], SA0[3]); la_ += SA0[0]; la_ += SA0[1]; la_ += SA0[2]; la_ += SA0[3]; asm volatile("" : "+v"(la_), "+v"(lb_), "+v"(pA0_0.x), "+v"(pA0_0.y)); } SBAR(); \
        OB0 = MF(fr0, __builtin_bit_cast(bf16x8, pB1_0), OB0); if (!(LAST)) { pA0_0.z = cvtpk(SA0[4], SA0[5]); pA0_0.w = cvtpk(SA0[6], SA0[7]); la_ += SA0[4]; la_ += SA0[5]; la_ += SA0[6]; la_ += SA0[7]; asm volatile("" : "+v"(la_), "+v"(lb_), "+v"(pA0_0.z), "+v"(pA0_0.w)); } SBAR(); \
        OA1 = MF(fr1, __builtin_bit_cast(bf16x8, pA1_0), OA1); fr3 = LD(vp_ + 7168); if (!(LAST)) { pA0_1.x = cvtpk(SA0[8], SA0[9]); pA0_1.y = cvtpk(SA0[10], SA0[11]); la_ += SA0[8]; la_ += SA0[9]; la_ += SA0[10]; la_ += SA0[11]; asm volatile("" : "+v"(la_), "+v"(lb_), "+v"(pA0_1.x), "+v"(pA0_1.y)); } SBAR(); \
        OB1 = MF(fr1, __builtin_bit_cast(bf16x8, pB1_0), OB1); if (!(LAST)) { pA0_1.z = cvtpk(SA0[12], SA0[13]); pA0_1.w = cvtpk(SA0[14], SA0[15]); la_ += SA0[12]; la_ += SA0[13]; la_ += SA0[14]; la_ += SA0[15]; asm volatile("" : "+v"(la_), "+v"(lb_), "+v"(pA0_1.z), "+v"(pA0_1.w)); } SBAR(); \
        OA0 = MF(fr2, __builtin_bit_cast(bf16x8, pA1_1), OA0); if (!(LAST) || 20 < 20) fr0 = LD(kn_ + 0); if (!(LAST)) { pB0_0.x = cvtpk(SB0[0], SB0[1]); pB0_0.y = cvtpk(SB0[2], SB0[3]); lb_ += SB0[0]; lb_ += SB0[1]; lb_ += SB0[2]; lb_ += SB0[3]; asm volatile("" : "+v"(la_), "+v"(lb_), "+v"(pB0_0.x), "+v"(pB0_0.y)); } SBAR(); \
        OB0 = MF(fr2, __builtin_bit_cast(bf16x8, pB1_1), OB0); if (!(LAST)) { pB0_0.z = cvtpk(SB0[4], SB0[5]); pB0_0.w = cvtpk(SB0[6], SB0[7]); lb_ += SB0[4]; lb_ += SB0[5]; lb_ += SB0[6]; lb_ += SB0[7]; asm volatile("" : "+v"(la_), "+v"(lb_), "+v"(pB0_0.z), "+v"(pB0_0.w)); } SBAR(); \
        OA1 = MF(fr3, __builtin_bit_cast(bf16x8, pA1_1), OA1); if (!(LAST) || 21 < 20) fr1 = LD(kn_ + 2048); if (!(LAST)) { pB0_1.x = cvtpk(SB0[8], SB0[9]); pB0_1.y = cvtpk(SB0[10], SB0[11]); lb_ += SB0[8]; lb_ += SB0[9]; lb_ += SB0[10]; lb_ += SB0[11]; asm volatile("" : "+v"(la_), "+v"(lb_), "+v"(pB0_1.x), "+v"(pB0_1.y)); } SBAR(); \
        OB1 = MF(fr3, __builtin_bit_cast(bf16x8, pB1_1), OB1); if (!(LAST)) { pB0_1.z = cvtpk(SB0[12], SB0[13]); pB0_1.w = cvtpk(SB0[14], SB0[15]); lb_ += SB0[12]; lb_ += SB0[13]; lb_ += SB0[14]; lb_ += SB0[15]; asm volatile("" : "+v"(la_), "+v"(lb_), "+v"(pB0_1.z), "+v"(pB0_1.w)); } SBAR(); \
        lsA += la_; lsB += lb_; \
        if (ODD) ATT_WAIT_ALL(); \
        off_v = off_k1; off_k1 = off_k2; off_k2 = (off_k2 == 5 * SLOTB) ? 0 : off_k2 + SLOTB; off_d = off_d2; off_d2 = (off_d2 == 5 * SLOTB) ? 0 : off_d2 + SLOTB; \
    } while (0)
    int t = 0;
    for (; t < 62; t += 2) { A64H_STEP(false, false); A64H_STEP(false, true); }
    A64H_STEP(false, false); A64H_STEP(true, true);
    const int q0 = qb512 * 512 + wid * 64;
    attn_epi64(lds + wid * 8192, p, OA0, OA1, lsA, bh, q0, lane);
    attn_epi64(lds + wid * 8192, p, OB0, OB1, lsB, bh, q0 + 32, lane);
    asm volatile("s_waitcnt vmcnt(0) lgkmcnt(0)\n\ts_barrier" ::: "memory");
#undef ATT_DMA
#undef ATT_WAIT_MINE
#undef ATT_WAIT_ALL
#undef A64H_STEP
#undef SBAR
#undef EX
#undef LD
#undef MF
}
DI void attn_phase64(LAS unsigned char* lds, const Ptrs& p, int vcu, int G) {
    const int lane = threadIdx.x & 63, wid = __builtin_amdgcn_readfirstlane(threadIdx.x >> 6);
    for (int U = vcu; U < 256; U += G) attn_unit64(lds, p, U >> 3, U & 7, wid, lane);
}
}


namespace p2 {
typedef short bf16x8 __attribute__((ext_vector_type(8)));
typedef short s16x4 __attribute__((ext_vector_type(4)));
typedef unsigned u32x4v __attribute__((ext_vector_type(4)));
typedef float f32x16 __attribute__((ext_vector_type(16)));
using att::cvtpk; using att::glds16;
DI int crow(int i, int h) { return (i & 3) + 8 * (i >> 2) + 4 * h; }
DI float lo16(unsigned u) { return __uint_as_float(u << 16); }
DI float hi16(unsigned u) { return __uint_as_float(u & 0xffff0000u); }
DI float frag_ssq(const bf16x8& f) { const uint4 u = __builtin_bit_cast(uint4, f); float s = 0.f;
    s += lo16(u.x) * lo16(u.x) + hi16(u.x) * hi16(u.x); s += lo16(u.y) * lo16(u.y) + hi16(u.y) * hi16(u.y);
    s += lo16(u.z) * lo16(u.z) + hi16(u.z) * hi16(u.z); s += lo16(u.w) * lo16(u.w) + hi16(u.w) * hi16(u.w); return s; }
DI bf16x8 frag_scale(const bf16x8& f, float sc) { const uint4 u = __builtin_bit_cast(uint4, f); uint4 o;
    o.x = cvtpk(lo16(u.x) * sc, hi16(u.x) * sc); o.y = cvtpk(lo16(u.y) * sc, hi16(u.y) * sc); o.z = cvtpk(lo16(u.z) * sc, hi16(u.z) * sc); o.w = cvtpk(lo16(u.w) * sc, hi16(u.w) * sc);
    return __builtin_bit_cast(bf16x8, o); }
DI uint4 pack8(const f32x16& a, int g, float sc, const float (&gv)[16]) {
    float v[8];
#pragma unroll
    for (int j = 0; j < 8; ++j) v[j] = a[8 * g + j] * sc * gv[8 * g + j];
    uint4 o; o.x = cvtpk(v[0], v[1]); o.y = cvtpk(v[2], v[3]); o.z = cvtpk(v[4], v[5]); o.w = cvtpk(v[6], v[7]); return o;
}
DI uint4 pack8n(const f32x16& a, int g, float sc) {
    uint4 o; o.x = cvtpk(a[8 * g + 0] * sc, a[8 * g + 1] * sc); o.y = cvtpk(a[8 * g + 2] * sc, a[8 * g + 3] * sc); o.z = cvtpk(a[8 * g + 4] * sc, a[8 * g + 5] * sc); o.w = cvtpk(a[8 * g + 6] * sc, a[8 * g + 7] * sc); return o;
}
DI s16x4 vtr(const LAS unsigned char* q) { return __builtin_bit_cast(s16x4, __builtin_amdgcn_ds_read_tr16_b64_v4i16((LAS s16x4*)q)); }
DI void glds16s(const void* sbase, unsigned voff, unsigned lds_dst) { unsigned keep;
    asm volatile("s_mov_b32 %0, m0\n\ts_mov_b32 m0, %3\n\ts_nop 0\n\tglobal_load_lds_dwordx4 %1, %2\n\ts_mov_b32 m0, %0" : "=&s"(keep) : "v"(voff), "s"(sbase), "s"(lds_dst) : "memory"); }
template <int NP8> DI void dma_copy(const unsigned char* gsrc, unsigned lds_dst, int wid, int lane) {
    const unsigned voff = (unsigned)(wid * 1024 + lane * 16);
#pragma unroll
    for (int i = 0; i < NP8; ++i) glds16s(gsrc + (size_t)i * 8192, voff, (unsigned)__builtin_amdgcn_readfirstlane(lds_dst + (i * 8 + wid) * 1024));
}
#define P2_BAR_V(N) asm volatile("s_waitcnt vmcnt(" #N ") lgkmcnt(0)\n\ts_barrier" ::: "memory")

DI void q_head(const Ptrs& p, const LAS unsigned char* wb, const bf16x8 (&cf)[16], float rq, const float (&cs)[8], const float (&sn)[8], int bh, int qblk, int lane) {
    const int h = lane >> 5;
    f32x16 acc[3];
#pragma unroll
    for (int nt = 0; nt < 3; ++nt) {
#pragma unroll
        for (int i = 0; i < 16; ++i) acc[nt][i] = 0.f;
#pragma unroll
        for (int ks = 0; ks < 16; ++ks) acc[nt] = MFMA32(*(const LAS bf16x8*)(wb + (nt * 16 + ks) * 1024 + lane * 16), cf[ks], acc[nt]);
    }
#pragma unroll
    for (int nt = 0; nt < 3; ++nt)
#pragma unroll
        for (int i = 0; i < 16; ++i) acc[nt][i] *= rq;
#pragma unroll
    for (int i = 0; i < 8; ++i) { const float a = acc[2][i], bb = acc[2][i + 8]; acc[2][i] = a * cs[i] - bb * sn[i]; acc[2][i + 8] = bb * cs[i] + a * sn[i]; }
    float sh = 0.f;
#pragma unroll
    for (int nt = 0; nt < 3; ++nt)
#pragma unroll
        for (int i = 0; i < 16; ++i) sh += acc[nt][i] * acc[nt][i];
    sh += __shfl_xor(sh, 32);
    const float rh = QSCALE * rsqrt_fast(sh * (1.f / 96.f) + EPS);
    uint4* dst = (uint4*)(p.ws + WS_QIMG) + ((size_t)(bh * 128 + qblk) * 6) * 64 + lane;
#pragma unroll
    for (int nt = 0; nt < 3; ++nt)
#pragma unroll
        for (int g = 0; g < 2; ++g) dst[(2 * nt + g) * 64] = pack8n(acc[nt], g, rh);
}
DI void kv_head(const Ptrs& p, const LAS unsigned char* wb, const bf16x8 (&cf)[8], const f32x16& kpe, float sspe, const float (&gk)[3][16], int bh, int tile, int c, int lane) {
    const int h = lane >> 5;
    f32x16 acc[2];
#pragma unroll
    for (int nt = 0; nt < 2; ++nt) {
#pragma unroll
        for (int i = 0; i < 16; ++i) acc[nt][i] = 0.f;
#pragma unroll
        for (int ks = 0; ks < 8; ++ks) acc[nt] = MFMA32(*(const LAS bf16x8*)(wb + (nt * 8 + ks) * 1024 + lane * 16), cf[ks], acc[nt]);
    }
    float sk = sspe;
#pragma unroll
    for (int nt = 0; nt < 2; ++nt)
#pragma unroll
        for (int i = 0; i < 16; ++i) sk += acc[nt][i] * acc[nt][i];
    sk += __shfl_xor(sk, 32);
    const float rk = rsqrt_fast(sk * (1.f / 96.f) + EPS);
    uint4* kd = (uint4*)(p.ws + WS_KIMG) + (size_t)(bh * 64 + tile) * 6 * 2 * 64 + c * 64 + lane;
#pragma unroll
    for (int nt = 0; nt < 2; ++nt)
#pragma unroll
        for (int g = 0; g < 2; ++g) kd[(2 * nt + g) * 128] = pack8(acc[nt], g, rk, gk[nt]);
#pragma unroll
    for (int g = 0; g < 2; ++g) kd[(4 + g) * 128] = pack8(kpe, g, rk, gk[2]);
    uint4* vd = (uint4*)(p.ws + WS_VIMG) + (size_t)(bh * 64 + tile) * 8 * 64 + c * 4 * 64 + lane;
#pragma unroll
    for (int dt = 0; dt < 2; ++dt) {
        f32x16 av;
#pragma unroll
        for (int i = 0; i < 16; ++i) av[i] = 0.f;
#pragma unroll
        for (int ks = 0; ks < 8; ++ks) av = MFMA32(cf[ks], *(const LAS bf16x8*)(wb + ((2 + dt) * 8 + ks) * 1024 + lane * 16), av);
#pragma unroll
        for (int s = 0; s < 2; ++s) { uint4 o; o.x = cvtpk(av[8 * s + 0], av[8 * s + 1]); o.y = cvtpk(av[8 * s + 2], av[8 * s + 3]); o.z = cvtpk(av[8 * s + 4], av[8 * s + 5]); o.w = cvtpk(av[8 * s + 6], av[8 * s + 7]);
            vd[(s * 2 + dt) * 64] = o; }
    }
}
DI uint4 pack8l(const f32x16& a, int g, float sc, const LAS float* G) {
    const f32x4_t g0 = *(const LAS f32x4_t*)(G + 16 * g), g1 = *(const LAS f32x4_t*)(G + 16 * g + 8);
    uint4 o; o.x = cvtpk(a[8 * g + 0] * sc * g0[0], a[8 * g + 1] * sc * g0[1]); o.y = cvtpk(a[8 * g + 2] * sc * g0[2], a[8 * g + 3] * sc * g0[3]);
    o.z = cvtpk(a[8 * g + 4] * sc * g1[0], a[8 * g + 5] * sc * g1[1]); o.w = cvtpk(a[8 * g + 6] * sc * g1[2], a[8 * g + 7] * sc * g1[3]); return o;
}
DI void kv_head_l(const Ptrs& p, const LAS unsigned char* wb, const bf16x8 (&cf)[8], const f32x16& kpe, float sspe, const LAS float* G, int bh, int tile, int c, int lane) {
    f32x16 acc[2];
#pragma unroll
    for (int nt = 0; nt < 2; ++nt) {
#pragma unroll
        for (int i = 0; i < 16; ++i) acc[nt][i] = 0.f;
#pragma unroll
        for (int ks = 0; ks < 8; ++ks) acc[nt] = MFMA32(*(const LAS bf16x8*)(wb + (nt * 8 + ks) * 1024 + lane * 16), cf[ks], acc[nt]);
    }
    float sk = sspe;
#pragma unroll
    for (int nt = 0; nt < 2; ++nt)
#pragma unroll
        for (int i = 0; i < 16; ++i) sk += acc[nt][i] * acc[nt][i];
    sk += __shfl_xor(sk, 32);
    const float rk = rsqrt_fast(sk * (1.f / 96.f) + EPS);
    uint4* kd = (uint4*)(p.ws + WS_KIMG) + (size_t)(bh * 64 + tile) * 6 * 2 * 64 + c * 64 + lane;
#pragma unroll
    for (int nt = 0; nt < 2; ++nt)
#pragma unroll
        for (int g = 0; g < 2; ++g) kd[(2 * nt + g) * 128] = pack8l(acc[nt], g, rk, G + 32 * nt);
#pragma unroll
    for (int g = 0; g < 2; ++g) kd[(4 + g) * 128] = pack8l(kpe, g, rk, G + 64);
    uint4* vd = (uint4*)(p.ws + WS_VIMG) + (size_t)(bh * 64 + tile) * 8 * 64 + c * 4 * 64 + lane;
#pragma unroll
    for (int dt = 0; dt < 2; ++dt) {
        f32x16 av;
#pragma unroll
        for (int i = 0; i < 16; ++i) av[i] = 0.f;
#pragma unroll
        for (int ks = 0; ks < 8; ++ks) av = MFMA32(cf[ks], *(const LAS bf16x8*)(wb + ((2 + dt) * 8 + ks) * 1024 + lane * 16), av);
#pragma unroll
        for (int s = 0; s < 2; ++s) { uint4 o; o.x = cvtpk(av[8 * s + 0], av[8 * s + 1]); o.y = cvtpk(av[8 * s + 2], av[8 * s + 3]); o.z = cvtpk(av[8 * s + 4], av[8 * s + 5]); o.w = cvtpk(av[8 * s + 6], av[8 * s + 7]);
            vd[(s * 2 + dt) * 64] = o; }
    }
}
template <bool DO_QKV, bool DO_GMLP>
DI void wg_item(LAS unsigned char* lds, const Ptrs& p, int tg, int hp, int wid, int lane) {
    const int r = lane & 31, h = lane >> 5;
    const unsigned lds0 = (unsigned)(uintptr_t)lds, ldsA = lds0, ldsB = lds0 + 65536;
    const LAS unsigned char* bufA = lds; const LAS unsigned char* bufB = lds + 65536;
    const unsigned char* WqF = p.ws + WS_WUQT; const unsigned char* WkvF = p.ws + WS_WUKVT; const unsigned char* WsF = p.ws + WS_WSB;
    const int hA = 2 * hp, tb = tg * 8 + wid, t = tb * 32 + r, b = t >> 12, s0 = (tb * 32) & 4095, qblk = s0 >> 5, tile = s0 >> 6, c = (s0 >> 5) & 1;
    if constexpr (DO_QKV) {
    const bf16_t* CQ = (const bf16_t*)(p.ws + WS_CQ);
    bf16x8 cf[16];
#pragma unroll
    for (int ks = 0; ks < 16; ++ks) cf[ks] = *(const bf16x8*)(CQ + (((size_t)(tb * 32 + 2 * ks + h) * 32 + r) << 3));
    float cs[8], sn[8];
    { const float* ct = (const float*)(p.ws + WS_COS) + t * 16; const float* st = (const float*)(p.ws + WS_SIN) + t * 16;
#pragma unroll
      for (int i = 0; i < 8; ++i) { cs[i] = ct[crow(i, h)]; sn[i] = st[crow(i, h)]; } }
    dma_copy<6>(WqF + (size_t)hA * 49152, ldsA, wid, lane);
    dma_copy<6>(WqF + (size_t)(hA + 1) * 49152, ldsB, wid, lane);
    float ss = 0.f;
#pragma unroll
    for (int ks = 0; ks < 16; ++ks) ss += frag_ssq(cf[ks]);
    ss += __shfl_xor(ss, 32);
    const float rq = rsqrt_fast(ss * (1.f / 256.f) + EPS);
    P2_BAR_V(6);
    q_head(p, bufA, cf, rq, cs, sn, b * 8 + hA, qblk, lane);
    P2_BAR_V(0);
    dma_copy<8>(WkvF + (size_t)hA * 32768, ldsA, wid, lane);
    q_head(p, bufB, cf, rq, cs, sn, b * 8 + hA + 1, qblk, lane);
    const bf16_t* CKV = (const bf16_t*)(p.ws + WS_CKV);
    bf16x8 kf[8]; float ssk = 0.f;
#pragma unroll
    for (int ks = 0; ks < 8; ++ks) { kf[ks] = *(const bf16x8*)(CKV + (((size_t)(tb * 20 + 2 * ks + h) * 32 + r) << 3)); ssk += frag_ssq(kf[ks]); }
    ssk += __shfl_xor(ssk, 32);
    const float rkv = rsqrt_fast(ssk * (1.f / 128.f) + EPS);
#pragma unroll
    for (int ks = 0; ks < 8; ++ks) kf[ks] = frag_scale(kf[ks], rkv);
    f32x16 kpe; float sspe = 0.f;
    {
        float kr[16];
#pragma unroll
        for (int g = 0; g < 4; ++g) { const uint2 w = *(const uint2*)(CKV + (((size_t)(tb * 20 + 16 + g) * 32 + r) << 3) + 4 * h);
            kr[4 * g + 0] = lo16(w.x); kr[4 * g + 1] = hi16(w.x); kr[4 * g + 2] = lo16(w.y); kr[4 * g + 3] = hi16(w.y); }
#pragma unroll
        for (int i = 0; i < 8; ++i) { const float a = kr[i], bb = kr[i + 8];
            kpe[i] = a * cs[i] - bb * sn[i]; kpe[i + 8] = bb * cs[i] + a * sn[i]; sspe += kpe[i] * kpe[i] + kpe[i + 8] * kpe[i + 8]; }
    }
    float gk[3][16];
#pragma unroll
    for (int nt = 0; nt < 3; ++nt)
#pragma unroll
        for (int i = 0; i < 16; ++i) gk[nt][i] = p.g_kh[32 * nt + crow(i, h)] * p.g_qh[32 * nt + crow(i, h)];
    P2_BAR_V(0);
    if constexpr (DO_GMLP) dma_copy<8>(WsF + (size_t)hA * 32768, ldsB, wid, lane);
    kv_head(p, bufA, kf, kpe, sspe, gk, b * 8 + hA, tile, c, lane);
    kv_head(p, bufA + 32768, kf, kpe, sspe, gk, b * 8 + hA + 1, tile, c, lane);
    P2_BAR_V(0);
    } else { if constexpr (DO_GMLP) dma_copy<8>(WsF + (size_t)hA * 32768, ldsB, wid, lane); }
    if constexpr (DO_GMLP) {
    const bf16_t* Z = (const bf16_t*)(p.ws + WS_Z);
    const int pair = wid >> 1, cl = pair >> 1, hl = pair & 1, hd = hA + hl, tc0 = (2 * tg + cl) * 128;
    const int rw = lane >> 3, c8 = lane & 7;
    typedef unsigned u32x4g __attribute__((ext_vector_type(4)));
    {
        const int j0 = 64 * (wid & 1);
        u32x4g vraw[8];
#pragma unroll
        for (int i = 0; i < 8; ++i) vraw[i] = *(const u32x4g*)(Z + (size_t)(tc0 + j0 + 8 * i + rw) * 2048 + 1024 + hd * 64 + 8 * c8);
        f2_t gg[4];
#pragma unroll
        for (int e = 0; e < 4; ++e) { gg[e].x = p.g_vg[hd * 64 + 8 * c8 + 2 * e]; gg[e].y = p.g_vg[hd * 64 + 8 * c8 + 2 * e + 1]; }
        LAS unsigned char* img = lds + pair * 16384 + (c8 >> 2) * 8192 + (c8 & 3) * 16;
#pragma unroll
        for (int i = 0; i < 8; ++i) { const u32x4g u = vraw[i];
            const f2_t g0 = gelu2(bf2x(u.x)), g1 = gelu2(bf2x(u.y)), g2 = gelu2(bf2x(u.z)), g3 = gelu2(bf2x(u.w));
            const f2_t s2 = __builtin_elementwise_fma(g3, g3, __builtin_elementwise_fma(g2, g2, __builtin_elementwise_fma(g1, g1, g0 * g0)));
            float sg = s2.x + s2.y;
            sg += __shfl_xor(sg, 1); sg += __shfl_xor(sg, 2); sg += __shfl_xor(sg, 4);
            const float rv = rsqrt_fast(sg * (1.f / 64.f) + EPS);
            const f2_t o0 = g0 * (gg[0] * rv), o1 = g1 * (gg[1] * rv), o2 = g2 * (gg[2] * rv), o3 = g3 * (gg[3] * rv);
            u32x4v o; o.x = cvtpk(o0.x, o0.y); o.y = cvtpk(o1.x, o1.y); o.z = cvtpk(o2.x, o2.y); o.w = cvtpk(o3.x, o3.y);
            *(LAS u32x4v*)(img + (j0 + 8 * i + rw) * 64) = o; }
    }
    u32x4g uld[2][4], zld[2][4];
#pragma unroll
    for (int ii = 0; ii < 2; ++ii)
#pragma unroll
        for (int q = 0; q < 4; ++q) { const bf16_t* zr = Z + (size_t)(tc0 + 32 * (2 * (wid & 1) + ii) + 8 * q + rw) * 2048 + hd * 64 + 8 * c8;
            uld[ii][q] = *(const u32x4g*)(zr + 512); zld[ii][q] = *(const u32x4g*)(zr + 1536); }
    P2_BAR_V(0);
    {
        bf16x8 vf[8][2];
        { const int q = (lane & 15) >> 2, pp = lane & 3, blk = (lane >> 4) & 1;
          const LAS unsigned char* base = bufA + pair * 16384 + (8 * h + q) * 64 + (16 * blk + 4 * pp) * 2;
#pragma unroll
          for (int ks = 0; ks < 8; ++ks)
#pragma unroll
              for (int nt = 0; nt < 2; ++nt) { const s16x4 lo = vtr(base + nt * 8192 + ks * 1024), hi = vtr(base + nt * 8192 + ks * 1024 + 256);
                  vf[ks][nt] = __builtin_shufflevector(lo, hi, 0, 1, 2, 3, 4, 5, 6, 7); } }
        asm volatile("s_waitcnt lgkmcnt(0)\n\ts_barrier" ::: "memory");
        LAS unsigned char* stg = lds + wid * 8192;
#pragma unroll
        for (int ii = 0; ii < 2; ++ii) { const int it = 2 * (wid & 1) + ii;
            f32x16 acc[2];
#pragma unroll
            for (int i = 0; i < 16; ++i) { acc[0][i] = 0.f; acc[1][i] = 0.f; }
            const LAS unsigned char* wsb = bufB + hl * 32768 + it * 8192 + lane * 16;
#pragma unroll
            for (int ks = 0; ks < 8; ++ks) { const bf16x8 wf = *(const LAS bf16x8*)(wsb + ks * 1024); acc[0] = MFMA32(vf[ks][0], wf, acc[0]); acc[1] = MFMA32(vf[ks][1], wf, acc[1]); }
#pragma unroll
            for (int nt = 0; nt < 2; ++nt)
#pragma unroll
                for (int g = 0; g < 4; ++g) { const f32x4_t v4 = {acc[nt][4 * g + 0], acc[nt][4 * g + 1], acc[nt][4 * g + 2], acc[nt][4 * g + 3]};
                    *(LAS f32x4_t*)(stg + r * 256 + (((8 * nt + 2 * g + h) ^ (r & 15)) << 4)) = v4; }
            asm volatile("s_waitcnt lgkmcnt(0)" ::: "memory");
#pragma unroll
            for (int q = 0; q < 4; ++q) { const int tl = 8 * q + rw, tt = tc0 + 32 * it + tl; const float bs = p.b_s[hd * 128 + 32 * it + tl];
                const f32x4_t m0 = *(const LAS f32x4_t*)(stg + tl * 256 + (((2 * c8) ^ (tl & 15)) << 4)), m1 = *(const LAS f32x4_t*)(stg + tl * 256 + (((2 * c8 + 1) ^ (tl & 15)) << 4));
                const u32x4g uu = uld[ii][q], zz = zld[ii][q];
                const f2_t mm[4] = {{m0[0], m0[1]}, {m0[2], m0[3]}, {m1[0], m1[1]}, {m1[2], m1[3]}};
                const unsigned uw[4] = {uu.x, uu.y, uu.z, uu.w}, zw[4] = {zz.x, zz.y, zz.z, zz.w};
                f2_t a[4], sq2 = {0.f, 0.f};
#pragma unroll
                for (int e = 0; e < 4; ++e) { const f2_t o = gelu2(bf2x(uw[e])) * (mm[e] + bs); sq2 = __builtin_elementwise_fma(o, o, sq2); a[e] = o * silu2(bf2x(zw[e])); }
                float sq = sq2.x + sq2.y;
                sq += __shfl_xor(sq, 1); sq += __shfl_xor(sq, 2); sq += __shfl_xor(sq, 4);
                u32x4g w; w.x = cvtpk(a[0].x, a[0].y); w.y = cvtpk(a[1].x, a[1].y); w.z = cvtpk(a[2].x, a[2].y); w.w = cvtpk(a[3].x, a[3].y);
                *(u32x4g*)((bf16_t*)(p.ws + WS_AMIX) + (size_t)tt * 1024 + 512 + hd * 64 + 8 * c8) = w;
                if (c8 == 0) ((float*)(p.ws + WS_SSQB))[(size_t)hd * T + tt] = sq; }
        }
    }
    P2_BAR_V(0);
    }
}
#undef P2_BAR_V
}


typedef unsigned f_u32x2 __attribute__((ext_vector_type(2)));
#define F_BAR_V(N) asm volatile("s_waitcnt vmcnt(" #N ") lgkmcnt(0)\n\ts_barrier" ::: "memory")
#define F_BAR_L() asm volatile("s_waitcnt lgkmcnt(0)\n\ts_barrier" ::: "memory")
DI void p1_fused_q_a(const f32x4_t (&acc)[2][2][4][2], int pm, int wr, int wc, int fr, int fq, LAS unsigned char* lds, const Ptrs* pp) {
    using namespace p2;
    const Ptrs& p = *pp;
    const LAS float* rsx = (const LAS float*)(lds + 131072 + 4096 + 2048);
    LAS float* tab = (LAS float*)(lds + 131072);
#pragma unroll
    for (int ai = 0; ai < 2; ++ai)
#pragma unroll
        for (int m = 0; m < 4; ++m) {
            const int row = ai * 128 + wr * 64 + m * 16 + fr; const float rs = rsx[row]; float part = 0.f;
#pragma unroll
            for (int bj = 0; bj < 2; ++bj) { const f32x4_t v0 = acc[ai][bj][m][0] * rs, v1 = acc[ai][bj][m][1] * rs;
                part += (v0[0] * v0[0] + v0[1] * v0[1]) + (v0[2] * v0[2] + v0[3] * v0[3]) + (v1[0] * v1[0] + v1[1] * v1[1]) + (v1[2] * v1[2] + v1[3] * v1[3]);
                u32x4v w; w.x = cvtpk(v0[0], v0[1]); w.y = cvtpk(v0[2], v0[3]); w.z = cvtpk(v1[0], v1[1]); w.w = cvtpk(v1[2], v1[3]);
                const int chunk = 16 * bj + 4 * wc + fq;
                *(LAS u32x4v*)(lds + ((((row >> 5) * 16 + (chunk >> 1)) * 64 + (chunk & 1) * 32 + (row & 31)) << 4)) = w; }
            part += __shfl_xor(part, 16); part += __shfl_xor(part, 32);
            if (fq == 0) tab[row * 4 + wc] = part;
        }
}
DI void p1_fused_q_b(int pm, LAS unsigned char* lds, const Ptrs* pp, int wid, int lane) {
    using namespace p2;
    const Ptrs& p = *pp;
    const int r = lane & 31, h = lane >> 5;
    const LAS float* tab = (const LAS float*)(lds + 131072);
    bf16x8 cf[16];
#pragma unroll
    for (int ks = 0; ks < 16; ++ks) cf[ks] = *(const LAS bf16x8*)(lds + (((wid * 16 + ks) * 64 + lane) << 4));
    const int row = 32 * wid + r, t = pm * 256 + row, b = t >> 12, s0 = (pm * 256 + 32 * wid) & 4095, qblk = s0 >> 5;
    const float rq = rsqrt_fast((tab[row * 4] + tab[row * 4 + 1] + tab[row * 4 + 2] + tab[row * 4 + 3]) * (1.f / 256.f) + EPS);
    float cs[8], sn[8];
    { const float* ct = (const float*)(p.ws + WS_COS) + t * 16; const float* st = (const float*)(p.ws + WS_SIN) + t * 16;
#pragma unroll
      for (int i = 0; i < 8; ++i) { cs[i] = ct[crow(i, h)]; sn[i] = st[crow(i, h)]; } }
    F_BAR_L();
    const unsigned lds0 = (unsigned)(uintptr_t)lds, ldsA = lds0, ldsB = lds0 + 65536;
    const LAS unsigned char* bufA = lds; const LAS unsigned char* bufB = lds + 65536;
    const unsigned char* WqF = p.ws + WS_WUQT;
    dma_copy<6>(WqF, ldsA, wid, lane);
    dma_copy<6>(WqF + 49152, ldsB, wid, lane);
#pragma nounroll
    for (int hp = 0; hp < 4; ++hp) {
        F_BAR_V(6);
        q_head(p, bufA, cf, rq, cs, sn, b * 8 + 2 * hp, qblk, lane);
        F_BAR_V(0);
        if (hp < 3) dma_copy<6>(WqF + (size_t)(2 * hp + 2) * 49152, ldsA, wid, lane);
        q_head(p, bufB, cf, rq, cs, sn, b * 8 + 2 * hp + 1, qblk, lane);
        F_BAR_L();
        if (hp < 3) dma_copy<6>(WqF + (size_t)(2 * hp + 3) * 49152, ldsB, wid, lane);
    }
    F_BAR_V(0);
}
DI void p1_fused_kv_a(const f32x4_t (&acc)[2][2][4][2], int pm, int wr, int wc, int fr, int fq, LAS unsigned char* lds, const Ptrs* pp) {
    using namespace p2;
    const Ptrs& p = *pp;
    const LAS float* rsx = (const LAS float*)(lds + 131072 + 4096 + 2048);
    LAS float* tab = (LAS float*)(lds + 131072);
#pragma unroll
    for (int ai = 0; ai < 2; ++ai)
#pragma unroll
        for (int m = 0; m < 4; ++m) {
            const int row = ai * 128 + wr * 64 + m * 16 + fr; const float rs = rsx[row];
            { const f32x4_t v0 = acc[ai][0][m][0] * rs, v1 = acc[ai][0][m][1] * rs;
              float part = (v0[0] * v0[0] + v0[1] * v0[1]) + (v0[2] * v0[2] + v0[3] * v0[3]) + (v1[0] * v1[0] + v1[1] * v1[1]) + (v1[2] * v1[2] + v1[3] * v1[3]);
              u32x4v w; w.x = cvtpk(v0[0], v0[1]); w.y = cvtpk(v0[2], v0[3]); w.z = cvtpk(v1[0], v1[1]); w.w = cvtpk(v1[2], v1[3]);
              const int chunk = 4 * wc + fq;
              *(LAS u32x4v*)(lds + ((((row >> 5) * 8 + (chunk >> 1)) * 64 + (chunk & 1) * 32 + (row & 31)) << 4)) = w;
              part += __shfl_xor(part, 16); part += __shfl_xor(part, 32);
              if (fq == 0) tab[row * 4 + wc] = part; }
            if (wc == 0) { const f32x4_t v0 = acc[ai][1][m][0] * rs, v1 = acc[ai][1][m][1] * rs;
              u32x4v w; w.x = cvtpk(v0[0], v0[1]); w.y = cvtpk(v0[2], v0[3]); w.z = cvtpk(v1[0], v1[1]); w.w = cvtpk(v1[2], v1[3]);
              *(LAS u32x4v*)(lds + 65536 + ((((row >> 5) * 4 + fq) * 32 + (row & 31)) << 4)) = w; }
        }
}
DI void p1_fused_kv_b(int pm, LAS unsigned char* lds, const Ptrs* pp, int wid, int lane) {
    using namespace p2;
    const Ptrs& p = *pp;
    const int r = lane & 31, h = lane >> 5;
    LAS float* tab = (LAS float*)(lds + 131072);
    bf16x8 kf[8];
#pragma unroll
    for (int ks = 0; ks < 8; ++ks) kf[ks] = *(const LAS bf16x8*)(lds + (((wid * 8 + ks) * 64 + lane) << 4));
    const int row = 32 * wid + r, t = pm * 256 + row, b = t >> 12, s0 = (pm * 256 + 32 * wid) & 4095, tile = s0 >> 6, c = (s0 >> 5) & 1;
    const float rkv = rsqrt_fast((tab[row * 4] + tab[row * 4 + 1] + tab[row * 4 + 2] + tab[row * 4 + 3]) * (1.f / 128.f) + EPS);
#pragma unroll
    for (int ks = 0; ks < 8; ++ks) kf[ks] = frag_scale(kf[ks], rkv);
    f32x16 kpe; float sspe = 0.f;
    {
        float kr[16];
#pragma unroll
        for (int g = 0; g < 4; ++g) { const f_u32x2 w = *(const LAS f_u32x2*)(lds + 65536 + (((wid * 4 + g) * 32 + r) << 4) + 8 * h);
            kr[4 * g + 0] = lo16(w.x); kr[4 * g + 1] = hi16(w.x); kr[4 * g + 2] = lo16(w.y); kr[4 * g + 3] = hi16(w.y); }
        const float* ct = (const float*)(p.ws + WS_COS) + t * 16; const float* st = (const float*)(p.ws + WS_SIN) + t * 16;
#pragma unroll
        for (int i = 0; i < 8; ++i) { const float a = kr[i], bb = kr[i + 8], cc = ct[crow(i, h)], sv = st[crow(i, h)];
            kpe[i] = a * cc - bb * sv; kpe[i + 8] = bb * cc + a * sv; sspe += kpe[i] * kpe[i] + kpe[i + 8] * kpe[i + 8]; }
    }
    const float gprod = (wid == 0 && lane < 48) ? p.g_kh[lane] * p.g_qh[lane] : 0.f, gprod2 = (wid == 0 && lane < 48) ? p.g_kh[lane + 48] * p.g_qh[lane + 48] : 0.f;
    F_BAR_L();
    if (wid == 0 && lane < 48) { tab[lane] = gprod; tab[lane + 48] = gprod2; }
    const LAS float* G = tab + 4 * h;
    const unsigned lds0 = (unsigned)(uintptr_t)lds, ldsA = lds0, ldsB = lds0 + 65536;
    const LAS unsigned char* bufA = lds; const LAS unsigned char* bufB = lds + 65536;
    const unsigned char* WkvF = p.ws + WS_WUKVT;
    dma_copy<8>(WkvF, ldsA, wid, lane);
    dma_copy<8>(WkvF + 65536, ldsB, wid, lane);
#pragma nounroll
    for (int hq = 0; hq < 2; ++hq) {
        F_BAR_V(8);
        kv_head_l(p, bufA, kf, kpe, sspe, G, b * 8 + 4 * hq, tile, c, lane);
        kv_head_l(p, bufA + 32768, kf, kpe, sspe, G, b * 8 + 4 * hq + 1, tile, c, lane);
        F_BAR_V(0);
        if (hq == 0) dma_copy<8>(WkvF + 2 * 65536, ldsA, wid, lane);
        kv_head_l(p, bufB, kf, kpe, sspe, G, b * 8 + 4 * hq + 2, tile, c, lane);
        kv_head_l(p, bufB + 32768, kf, kpe, sspe, G, b * 8 + 4 * hq + 3, tile, c, lane);
        F_BAR_L();
        if (hq == 0) dma_copy<8>(WkvF + 3 * 65536, ldsB, wid, lane);
    }
    F_BAR_V(0);
}
#undef F_BAR_V
#undef F_BAR_L

#define FB_V(k)      (0x5EED0000u + (unsigned)(k))
#define FB_OK(f, k)  ((((f) & 0xFFFFF0FFu) - FB_V(k)) <= 1u)
#define FB_SPIN_CAP  (1u << 22)
__device__ __forceinline__ unsigned xb_ld(unsigned* p)              { return __hip_atomic_load(p, __ATOMIC_RELAXED, __HIP_MEMORY_SCOPE_AGENT); }
__device__ __forceinline__ void xb_st(unsigned* p, unsigned v)      { __hip_atomic_store(p, v, __ATOMIC_RELAXED, __HIP_MEMORY_SCOPE_AGENT); }
__device__ __forceinline__ unsigned xb_xcc_id() { return (unsigned)__builtin_amdgcn_s_getreg((3 << 11) | 20) & 0xFu; }
__device__ __forceinline__ void flag_barrier(unsigned* bar, volatile LAS unsigned* st, int k) {
    asm volatile("s_waitcnt vmcnt(0)" ::: "memory");
    __syncthreads();
    if (threadIdx.x < 64) {
        const unsigned lane = threadIdx.x, bx = blockIdx.x, x = xb_xcc_id();
        __builtin_amdgcn_s_waitcnt(0);
        if (lane == 0) xb_st(&bar[bx], FB_V(k) | (x << 8));
        unsigned f0, f1, f2, f3, sp = 0u, m; bool leader;
        if (k == 0) {
            for (;;) {
                f0 = xb_ld(&bar[lane]); f1 = xb_ld(&bar[64 + lane]); f2 = xb_ld(&bar[128 + lane]); f3 = xb_ld(&bar[192 + lane]);
                if (__all(FB_OK(f0, k) && FB_OK(f1, k) && FB_OK(f2, k) && FB_OK(f3, k))) break;
                __builtin_amdgcn_s_sleep(2);
                if (++sp > FB_SPIN_CAP) break;
            }
            const unsigned x0 = (f0 >> 8) & 15u, x1 = (f1 >> 8) & 15u, x2 = (f2 >> 8) & 15u, x3 = (f3 >> 8) & 15u;
            const bool lower = (x0 == x && lane < bx) || (x1 == x && 64u + lane < bx) || (x2 == x && 128u + lane < bx) || (x3 == x && 192u + lane < bx);
            leader = !__any(lower);
            m = (1u << x0) | (1u << x1) | (1u << x2) | (1u << x3);
#pragma unroll
            for (int o = 1; o < 64; o <<= 1) m |= __shfl_xor(m, o);
            st[16 + lane] = (x0 == x ? 1u : 0u) | (x1 == x ? 2u : 0u) | (x2 == x ? 4u : 0u) | (x3 == x ? 8u : 0u);
            if (lane == 0) { st[0] = leader ? 1u : 0u; st[1] = m; }
        } else {
            leader = st[0] != 0u; m = st[1];
            if (leader) {
                const unsigned loc = st[16 + lane];
                for (;;) {
                    f0 = (loc & 1u) ? xb_ld(&bar[lane]) : FB_V(k); f1 = (loc & 2u) ? xb_ld(&bar[64 + lane]) : FB_V(k); f2 = (loc & 4u) ? xb_ld(&bar[128 + lane]) : FB_V(k); f3 = (loc & 8u) ? xb_ld(&bar[192 + lane]) : FB_V(k);
                    if (__all(FB_OK(f0, k) && FB_OK(f1, k) && FB_OK(f2, k) && FB_OK(f3, k))) break;
                    __builtin_amdgcn_s_sleep(1);
                    if (++sp > FB_SPIN_CAP) break;
                }
            }
        }
        if (leader) {
            __builtin_amdgcn_fence(__ATOMIC_RELEASE, "agent");
            asm volatile("s_waitcnt vmcnt(0)" ::: "memory");
            if (lane == 0) xb_st(&bar[256 + x], FB_V(k));
        }
        for (sp = 0u;;) {
            const unsigned t = lane < 16u ? xb_ld(&bar[256 + lane]) : 0u;
            const bool need = lane < 16u && ((m >> lane) & 1u);
            if (__all(!need || FB_OK(t, k))) break;
            __builtin_amdgcn_s_sleep(2);
            if (++sp > FB_SPIN_CAP) break;
        }
        __builtin_amdgcn_fence(__ATOMIC_ACQUIRE, "agent");
        asm volatile("s_waitcnt vmcnt(0)" ::: "memory");
    }
    __syncthreads();
}

constexpr int LDS_BYTES = 147456;
constexpr int NPHASE = 5;
constexpr int MISC_OFF = 131072 + 4096;
struct Args { Ptrs p; int ph_lo, ph_hi; };

DI size_t frag_off(int n, int k, int K) { return ((((size_t)(n >> 5) * (K >> 4) + (k >> 4)) * 64 + ((k >> 3) & 1) * 32 + (n & 31)) << 3) + (k & 7); }
template <bool FRAG>
DI void p0_transpose_item(const float* W, int K, int Nsrc, const float* gain, bf16_t* WT, int dst_row0, LAS float* scr, int k0, int n0, int lane) {
#pragma unroll 8
    for (int i = 0; i < 32; ++i) { const int kk = 2 * i + (lane >> 5); scr[kk * 33 + (lane & 31)] = W[(size_t)(k0 + kk) * Nsrc + n0 + (lane & 31)] * gain[k0 + kk]; }
    asm volatile("s_waitcnt lgkmcnt(0)" ::: "memory");
#pragma unroll
    for (int j = 0; j < 4; ++j) {
        const int c = FRAG ? (lane >> 5) + 2 * j : (lane & 7), n = FRAG ? (lane & 31) : (lane >> 3) + 8 * j; const LAS float* s = scr + (8 * c) * 33 + n;
        uint4 o; o.x = f2bf(s[0 * 33]) | ((unsigned)f2bf(s[1 * 33]) << 16); o.y = f2bf(s[2 * 33]) | ((unsigned)f2bf(s[3 * 33]) << 16);
        o.z = f2bf(s[4 * 33]) | ((unsigned)f2bf(s[5 * 33]) << 16); o.w = f2bf(s[6 * 33]) | ((unsigned)f2bf(s[7 * 33]) << 16);
        if (FRAG) *(uint4*)(WT + frag_off(dst_row0 + n, k0 + 8 * c, K)) = o; else *(uint4*)(WT + (size_t)(dst_row0 + n) * K + k0 + 8 * c) = o; }
    asm volatile("s_waitcnt lgkmcnt(0)" ::: "memory");
}
DI void p0_prologue(const Ptrs& p, LAS unsigned char* lds, int vcu, int G) {
    const int tid = threadIdx.x, lane = tid & 63, wave = __builtin_amdgcn_readfirstlane(tid >> 6);
    const int gw = vcu * 8 + wave, NGW = G * 8;
    LAS float* scr = (LAS float*)(lds + wave * 16384);
    bf16_t* WinT = (bf16_t*)(p.ws + WS_WINT); bf16_t* WuqT = (bf16_t*)(p.ws + WS_WUQT); bf16_t* WukvT = (bf16_t*)(p.ws + WS_WUKVT);
    bf16_t* WoutT = (bf16_t*)(p.ws + WS_WOUTT); bf16_t* Wsb = (bf16_t*)(p.ws + WS_WSB);
    {
    bf16_t* xb = (bf16_t*)(p.ws + WS_XB); float* rs = (float*)(p.ws + WS_RSTDX);
    for (int row = gw; row < T; row += NGW) {
        typedef float f32x4v __attribute__((ext_vector_type(4)));
        const f32x4v* xr = (const f32x4v*)(p.x + (size_t)row * DM) + lane;
        float s = 0.f; f32x4v v[4];
#pragma unroll
        for (int j = 0; j < 4; ++j) { v[j] = __builtin_nontemporal_load(xr + 64 * j); s += v[j].x * v[j].x + v[j].y * v[j].y + v[j].z * v[j].z + v[j].w * v[j].w; }
#pragma unroll
        for (int o = 1; o < 64; o <<= 1) s += __shfl_xor(s, o);
        if (lane == 0) rs[row] = rsqrt_fast(s * (1.f / DM) + EPS);
        uint2* o8 = (uint2*)(xb + (size_t)row * DM) + lane;
#pragma unroll
        for (int j = 0; j < 4; ++j) { uint2 w; w.x = f2bf(v[j].x) | ((unsigned)f2bf(v[j].y) << 16); w.y = f2bf(v[j].z) | ((unsigned)f2bf(v[j].w) << 16); o8[64 * j] = w; }
    }
    }
    constexpr int I_IN = 16 * 77, I_UQ = 4 * 24, I_UKV = 2 * 32, I_OUT = 16 * 32, NITEMS = I_IN + I_UQ + I_UKV + I_OUT;
    for (int it = gw; it < NITEMS; it += NGW) {
        int r = it;
        if (r < I_IN) { const int kb = r / 77, nb = r % 77; p0_transpose_item<false>(p.w_in, 1024, 2464, p.g_in, WinT, nb < 8 ? 1024 + 32 * nb : nb < 13 ? 1280 + 32 * (nb - 8) : nb < 29 ? 2048 + 32 * (nb - 13) : nb < 61 ? 32 * (nb - 29) : 1536 + 32 * (nb - 61), scr, 64 * kb, 32 * nb, lane);   continue; } r -= I_IN;
        if (r < I_UQ) { const int kb = r / 24, nb = r % 24; p0_transpose_item<true>(p.w_uq, 256, 768, p.g_ql, WuqT, 32 * nb, scr, 64 * kb, 32 * nb, lane); continue; } r -= I_UQ;
        if (r < I_UKV) { const int kb = r / 32, nb = r % 32; p0_transpose_item<true>(p.w_ukv, 128, 1024, p.g_kvl, WukvT, 32 * nb, scr, 64 * kb, 32 * nb, lane); continue; } r -= I_UKV;
        { const int kb = r / 32, nb = r % 32; p0_transpose_item<false>(p.w_out, 1024, 1024, kb < 8 ? p.g_oa : p.g_ob - 512, WoutT, 32 * nb, scr, 64 * kb, 32 * nb, lane); }
    }
    const size_t gid = (size_t)vcu * 512 + tid, gsz = (size_t)G * 512;
    for (size_t i = gid; i < (size_t)96 * 1024 / 8; i += gsz) ((uint4*)(WinT + (size_t)1440 * 1024))[i] = make_uint4(0u, 0u, 0u, 0u);
    for (size_t i = gid; i < (size_t)8 * 128 * 16; i += gsz) { const int n = (int)(i >> 4), kc = (int)(i & 15); const float4 a = *(const float4*)(p.w_s + (size_t)n * 128 + 8 * kc), bq = *(const float4*)(p.w_s + (size_t)n * 128 + 8 * kc + 4);
        uint4 o; o.x = f2bf(a.x) | ((unsigned)f2bf(a.y) << 16); o.y = f2bf(a.z) | ((unsigned)f2bf(a.w) << 16); o.z = f2bf(bq.x) | ((unsigned)f2bf(bq.y) << 16); o.w = f2bf(bq.z) | ((unsigned)f2bf(bq.w) << 16);
        *(uint4*)(Wsb + frag_off(n, 8 * kc, 128)) = o; }
    float* ct = (float*)(p.ws + WS_COS); float* st = (float*)(p.ws + WS_SIN);
    for (size_t i = gid; i < (size_t)T * 16; i += gsz) { const int t = (int)(i >> 4), f = (int)(i & 15);
        const float invf = 1.0f / powf(10000.0f, (float)(2 * f) / 32.0f);
        const float ang = (float)p.pos[t] * invf;
        const double rev = (double)ang * 0.15915494309189535; const float fr = (float)(rev - rint(rev));
        ct[i] = __builtin_amdgcn_cosf(fr); st[i] = __builtin_amdgcn_sinf(fr); }
}

__global__ void __launch_bounds__(512, 2) mega(Args a) {
    extern __shared__ __attribute__((aligned(16))) unsigned char lds_all[];
    LAS unsigned char* lds = (LAS unsigned char*)lds_all;
    cg::grid_group grid = cg::this_grid();
    const Ptrs& p = a.p;
#define GRID_BAR(k) flag_barrier((unsigned*)(p.ws + WS_CTL) + 1024, (volatile LAS unsigned*)(lds + MISC_OFF), (k))
    if (a.ph_lo > 1000) grid.sync();
    const int lo = a.ph_lo, hi = a.ph_hi, G = gridDim.x, bx = blockIdx.x;
    const int vcu = (G % 8 == 0) ? (bx % 8) * (G / 8) + bx / 8 : bx;
#define IN(k) (lo <= (k) && (k) < hi)
#define BOTH(k) (IN(k) && IN((k) + 1))
    if (IN(0)) { p0_prologue(p, lds, vcu, G); if (BOTH(0)) GRID_BAR(0); }
    if (IN(1)) {
        {
        __syncthreads();
        pg8::Gemm g{(const bf16_t*)(p.ws + WS_XB), (const bf16_t*)(p.ws + WS_WINT), T, NP + 512, DM}; pg8::P1Order S; S.init(T, NP, G, bx);
        { pg8::Unit u0; S.next(0, u0); if (threadIdx.x < 256) ((LAS float*)(lds + MISC_OFF + 2048))[threadIdx.x] = ((const float*)(p.ws + WS_RSTDX))[u0.pm * 256 + threadIdx.x];
          asm volatile("s_waitcnt vmcnt(0) lgkmcnt(0)" ::: "memory"); __syncthreads(); }
        pg8::EpiProj E{(bf16_t*)(p.ws + WS_Z), (const LAS float*)(lds + MISC_OFF + 2048), &p};
        pg8::gemm_phase<pg8::EpiProj, pg8::P1Order, true, true>(lds, g, S, E);
        }
        if (BOTH(1)) GRID_BAR(1);
    }
    if (IN(2)) {
        const int lane = threadIdx.x & 63, wid = __builtin_amdgcn_readfirstlane(threadIdx.x >> 6);
        __syncthreads();
        p2::wg_item<false, true>(lds, p, 8 * (bx & 7) + ((bx >> 3) & 7), bx >> 6, wid, lane);
        asm volatile("s_waitcnt vmcnt(0) lgkmcnt(0)" ::: "memory");
    }
    if (IN(3)) { __syncthreads(); att::attn_phase64(lds, p, vcu, G); if (BOTH(3)) GRID_BAR(2); }
    if (IN(4)) {
        {
        __syncthreads();
        pg8::StaticOrder S; S.init(T, DM, G, bx); pg8::Unit u0;
        if (S.next(0, u0) && threadIdx.x < 256) {
            const float* ssqa = (const float*)(p.ws + WS_SSQA); const float* ssqb = (const float*)(p.ws + WS_SSQB); const int t = u0.pm * 256 + threadIdx.x;
            float sa = 0.f, sb = 0.f;
#pragma unroll
            for (int h = 0; h < 8; ++h) { sa += ssqa[(size_t)h * T + t]; sb += ssqb[(size_t)h * T + t]; }
            const float ra = rsqrt_fast(sa * (1.f / 512.f) + EPS), rb = rsqrt_fast(sb * (1.f / 512.f) + EPS);
            ((LAS float*)(lds + pg8::STAGE_BYTES))[threadIdx.x] = ra / rb; ((LAS float*)(lds + pg8::STAGE_BYTES + 1024))[threadIdx.x] = rb;
        }
        asm volatile("s_waitcnt vmcnt(0) lgkmcnt(0)" ::: "memory"); __syncthreads();
        pg8::Gemm g{(const bf16_t*)(p.ws + WS_AMIX), (const bf16_t*)(p.ws + WS_WOUTT), T, DM, DM};
        pg8::EpiOut E{p.x, p.out, lds, (const bf16_t*)(p.ws + WS_XB)};
        pg8::gemm_phase<pg8::EpiOut, pg8::StaticOrder, false, true>(lds, g, S, E);
        }
    }
#undef IN
#undef BOTH
}

static int g_grid = 0;
static void launch_mega(const Ptrs& p, int lo, int hi, hipStream_t stream) {
    if (g_grid == 0) {
        int dev = 0, cus = 0, per_cu = 0;
        hipGetDevice(&dev); hipDeviceGetAttribute(&cus, hipDeviceAttributeMultiprocessorCount, dev);
        hipFuncSetAttribute((const void*)mega, hipFuncAttributeMaxDynamicSharedMemorySize, LDS_BYTES);
        hipOccupancyMaxActiveBlocksPerMultiprocessor(&per_cu, (const void*)mega, 512, LDS_BYTES);
        g_grid = cus;
        if (per_cu < 1 || cus != 256) { fprintf(stderr, "mega: built for 256 CUs x 1 resident workgroup; device has %d CUs, occupancy query says %d per CU; nothing launched\n", cus, per_cu); g_grid = -1; }
    }
    if (g_grid < 0) return;
    Args a{}; a.p = p; a.ph_lo = lo; a.ph_hi = hi;
    void* args[] = {&a};
    hipError_t e = hipLaunchCooperativeKernel((const void*)mega, dim3(g_grid), dim3(512), args, LDS_BYTES, stream);
    if (e != hipSuccess) fprintf(stderr, "cooperative launch failed: %s (grid %d)\n", hipGetErrorString(e), g_grid);
}
extern "C" void kernel_launch(void* const* d_in, const int* in_sizes, int n_in, void* d_out, int out_size, void* d_ws, size_t ws_size, hipStream_t stream) {
    if (n_in != 16 || out_size != T * DM || ws_size < WS_END) { fprintf(stderr, "kernel_launch: unexpected shapes n_in %d out %d ws %zu\n", n_in, out_size, ws_size); return; }
    Ptrs p{};
    p.x = (const float*)d_in[0]; p.pos = (const int*)d_in[1]; p.g_in = (const float*)d_in[2]; p.w_in = (const float*)d_in[3]; p.g_ql = (const float*)d_in[4]; p.w_uq = (const float*)d_in[5];
    p.g_kvl = (const float*)d_in[6]; p.w_ukv = (const float*)d_in[7]; p.g_qh = (const float*)d_in[8]; p.g_kh = (const float*)d_in[9]; p.g_vg = (const float*)d_in[10]; p.w_s = (const float*)d_in[11];
    p.b_s = (const float*)d_in[12]; p.g_oa = (const float*)d_in[13]; p.g_ob = (const float*)d_in[14]; p.w_out = (const float*)d_in[15];
    p.out = (float*)d_out; p.ws = (unsigned char*)d_ws;
    launch_mega(p, 0, 5, stream);
}
```
